# Optimizing an MI355X kernel written in HIP

```python
import math
import jax, jax.numpy as jnp
from jax import lax
import numpy as np

D_MODEL = 2048
BATCH = 4
SEQ = 4096
DEPTH = 1

CHUNK = 64
PLE_DIM = 256
EPS = 1e-6
A_HEADS = 8
A_HEAD_DIM = 128
A_WIDTH = A_HEADS * A_HEAD_DIM
IDX_HEADS = 16
IDX_DIM = 64
TOPK_MAX = 256
R_HEADS = 8
R_KEY_DIM = 128
R_VAL_DIM = 128
R_WIDTH = R_HEADS * R_VAL_DIM
ROPE_BASE = 10000.0
N_BUCKETS = 32
MAX_DISTANCE = 128

SPLITS = (A_WIDTH, A_WIDTH, A_WIDTH, A_WIDTH,
          IDX_HEADS * IDX_DIM, IDX_DIM, IDX_HEADS,
          R_HEADS * R_KEY_DIM, R_HEADS * R_KEY_DIM,
          R_WIDTH, R_WIDTH,
          D_MODEL, D_MODEL)
IN_WIDTH = int(sum(SPLITS))
SPLIT_POINTS = tuple(int(s) for s in np.cumsum(SPLITS)[:-1])

kernel_name = 'hybrid_dsa_retention_gated_block'


def rmsnorm(x, g):
    xf = x.astype(jnp.float32)
    y = xf * lax.rsqrt(jnp.mean(xf * xf, axis=-1, keepdims=True) + EPS) * g.astype(jnp.float32)
    return y.astype(x.dtype)


def plain_layernorm(x):
    xf = x.astype(jnp.float32)
    mu = jnp.mean(xf, axis=-1, keepdims=True)
    var = jnp.mean((xf - mu) ** 2, axis=-1, keepdims=True)
    return ((xf - mu) * lax.rsqrt(var + EPS)).astype(x.dtype)


def rope(x, positions):
    half = x.shape[-1] // 2
    inv_freq = ROPE_BASE ** (-jnp.arange(half, dtype=jnp.float32) / half)
    ang = positions[:, :, None].astype(jnp.float32) * inv_freq
    cos = jnp.cos(ang)[:, :, None, :]
    sin = jnp.sin(ang)[:, :, None, :]
    xf = x.astype(jnp.float32)
    x1, x2 = xf[..., :half], xf[..., half:]
    return jnp.concatenate([x1 * cos - x2 * sin, x1 * sin + x2 * cos], axis=-1).astype(x.dtype)


def t5_bucket(rel):
    half = N_BUCKETS // 2
    max_exact = half // 2
    ret = jnp.where(rel > 0, half, 0)
    n = jnp.abs(rel)
    nf = jnp.maximum(n, 1).astype(jnp.float32)
    large = max_exact + (jnp.log(nf / max_exact) / math.log(MAX_DISTANCE / max_exact)
                         * (half - max_exact)).astype(jnp.int32)
    large = jnp.minimum(large, half - 1)
    return ret + jnp.where(n < max_exact, n, large)


def dsa_mixer(q, k, v, qi, ki, w, positions, rel_table):
    B, L = q.shape[0], q.shape[1]
    nc = L // CHUNK
    topk = min(TOPK_MAX, L // 4)
    scale = A_HEAD_DIM ** -0.5
    gather = jax.vmap(lambda t, i: t[i])

    def blocks(t):
        return t.reshape((B, nc, CHUNK) + t.shape[2:]).swapaxes(0, 1)

    def one_chunk(args):
        c, q_c, qi_c, w_c, pos_c = args
        limit = (c + 1) * CHUNK
        score = jnp.einsum('bqhd,bsd->bqsh', qi_c, ki)
        index = jnp.einsum('bqsh,bqh->bqs', jax.nn.relu(score), w_c).astype(jnp.float32)
        admissible = jnp.arange(L) < limit
        index = jnp.where(admissible[None, None, :], index, -jnp.inf)
        _, sel = lax.top_k(index, topk)
        sel_ok = sel < limit
        k_sel = gather(k, sel)
        v_sel = gather(v, sel)
        pos_sel = gather(positions, sel)
        bias = rel_table.astype(jnp.float32)[t5_bucket(pos_sel - pos_c[:, :, None])]
        logits = jnp.einsum('bqhd,bqkhd->bqkh', q_c, k_sel).astype(jnp.float32) * scale + bias
        logits = jnp.where(sel_ok[..., None], logits, -jnp.inf)
        probs = jax.nn.softmax(logits, axis=2).astype(v.dtype)
        return jnp.einsum('bqkh,bqkhd->bqhd', probs, v_sel)

    out = lax.map(one_chunk, (jnp.arange(nc), blocks(q), blocks(qi), blocks(w), blocks(positions)))
    return out.swapaxes(0, 1).reshape(B, L, A_WIDTH)


def retention_mixer(q, k, v, gn_gain):
    B, L = q.shape[0], q.shape[1]
    nc = L // CHUNK
    dt = v.dtype
    qf, kf, vf = q.astype(jnp.float32), k.astype(jnp.float32), v.astype(jnp.float32)
    log_g = jnp.log(1.0 - 2.0 ** (-5.0 - jnp.arange(R_HEADS, dtype=jnp.float32)))
    pos = jnp.arange(CHUNK, dtype=jnp.float32)
    dist = jnp.abs(pos[:, None] - pos[None, :])
    intra_decay = jnp.exp(log_g[:, None, None] * dist)
    to_end = jnp.exp(log_g[None, :] * (CHUNK - 1.0 - pos)[:, None])
    from_start = jnp.exp(log_g[None, :] * (pos + 1.0)[:, None])
    chunk_decay = jnp.exp(log_g * CHUNK)
    qc = qf.reshape(B, nc, CHUNK, R_HEADS, R_KEY_DIM)
    kc = kf.reshape(B, nc, CHUNK, R_HEADS, R_KEY_DIM)
    vc = vf.reshape(B, nc, CHUNK, R_HEADS, R_VAL_DIM)
    scores = jnp.einsum('bnqhd,bnkhd->bnhqk', qc, kc) * intra_decay
    intra = jnp.einsum('bnhqk,bnkhe->bnqhe', scores, vc)
    kv = jnp.einsum('bnkhd,bnkhe->nbhde', kc * to_end[:, :, None], vc)

    def step(state, kv_c):
        return state * chunk_decay[None, :, None, None] + kv_c, state

    _, prev = lax.scan(step, jnp.zeros(kv.shape[1:], jnp.float32), kv)
    cross = jnp.einsum('bnqhd,nbhde->bnqhe', qc * from_start[:, :, None], prev)
    y = (intra + cross).reshape(B, L, R_HEADS, R_VAL_DIM)
    mu = jnp.mean(y, axis=-1, keepdims=True)
    var = jnp.mean((y - mu) ** 2, axis=-1, keepdims=True)
    y = ((y - mu) * lax.rsqrt(var + EPS)).reshape(B, L, R_WIDTH) * gn_gain.astype(jnp.float32)
    return y.astype(dt)


def hybrid_layer(x, p_i, positions, w_in, norm_gain, w_a_out, w_b_out, w_o, ret_gn_gain,
                 w_ple, w_ple_gate, rel_bias):
    B, L = x.shape[0], x.shape[1]
    h = rmsnorm(x, norm_gain)
    proj = h @ w_in
    (aq, ak, av, az, iq, ik, iw, rq, rk, rv, rz, ga, gb) = jnp.split(proj, SPLIT_POINTS, axis=-1)
    aq = aq.reshape(B, L, A_HEADS, A_HEAD_DIM)
    ak = ak.reshape(B, L, A_HEADS, A_HEAD_DIM)
    av = av.reshape(B, L, A_HEADS, A_HEAD_DIM)
    iq = iq.reshape(B, L, IDX_HEADS, IDX_DIM) * (IDX_DIM ** -0.5)
    ik = plain_layernorm(ik)
    iw = iw * (IDX_HEADS ** -0.5)
    a_out = dsa_mixer(aq, ak, av, iq, ik, iw, positions, rel_bias) * jax.nn.silu(az)
    rq = rope(rq.reshape(B, L, R_HEADS, R_KEY_DIM), positions)
    rk = rope(rk.reshape(B, L, R_HEADS, R_KEY_DIM), positions) * (R_KEY_DIM ** -0.5)
    rv = rv.reshape(B, L, R_HEADS, R_VAL_DIM)
    b_out = retention_mixer(rq, rk, rv, ret_gn_gain) * jax.nn.silu(rz)
    merged = jax.nn.sigmoid(ga) * (a_out @ w_a_out) + jax.nn.sigmoid(gb) * (b_out @ w_b_out)
    r = x + merged @ w_o
    return r + (p_i @ w_ple) * jax.nn.sigmoid(r @ w_ple_gate)


def setup_inputs(seed: int = 0) -> dict:
    key = jax.random.key(seed)
    ks = jax.random.split(key, 14)
    f32 = jnp.float32
    x = jax.random.normal(ks[0], (BATCH, SEQ, D_MODEL), f32)
    p = jax.random.normal(ks[1], (DEPTH, BATCH, SEQ, PLE_DIM), f32)
    offsets = jax.random.randint(ks[2], (BATCH, 1), 0, 64) * CHUNK
    positions = (offsets + jnp.arange(SEQ)[None, :]).astype(jnp.int32)
    w_in = jax.random.normal(ks[3], (DEPTH, D_MODEL, IN_WIDTH), f32) * D_MODEL ** -0.5
    norm_gain = 1.0 + 0.02 * jax.random.normal(ks[4], (DEPTH, D_MODEL), f32)
    w_a_out = jax.random.normal(ks[5], (DEPTH, A_WIDTH, D_MODEL), f32) * A_WIDTH ** -0.5
    w_b_out = jax.random.normal(ks[6], (DEPTH, R_WIDTH, D_MODEL), f32) * R_WIDTH ** -0.5
    w_o = jax.random.normal(ks[7], (DEPTH, D_MODEL, D_MODEL), f32) * D_MODEL ** -0.5
    ret_gn_gain = 1.0 + 0.02 * jax.random.normal(ks[8], (DEPTH, R_WIDTH), f32)
    w_ple = jax.random.normal(ks[9], (DEPTH, PLE_DIM, D_MODEL), f32) * PLE_DIM ** -0.5
    w_ple_gate = jax.random.normal(ks[10], (DEPTH, D_MODEL, D_MODEL), f32) * D_MODEL ** -0.5
    rel_bias = 0.5 * jax.random.normal(ks[11], (N_BUCKETS, A_HEADS), f32)
    final_gain = 1.0 + 0.02 * jax.random.normal(ks[12], (D_MODEL,), f32)
    return {'x': x, 'p': p, 'positions': positions, 'w_in': w_in, 'norm_gain': norm_gain,
            'w_a_out': w_a_out, 'w_b_out': w_b_out, 'w_o': w_o, 'ret_gn_gain': ret_gn_gain,
            'w_ple': w_ple, 'w_ple_gate': w_ple_gate, 'rel_bias': rel_bias,
            'final_gain': final_gain}


def reference(x, p, positions, w_in, norm_gain, w_a_out, w_b_out, w_o, ret_gn_gain,
              w_ple, w_ple_gate, rel_bias, final_gain):
    for i in range(DEPTH):
        x = hybrid_layer(x, p[i], positions, w_in[i], norm_gain[i], w_a_out[i], w_b_out[i],
                         w_o[i], ret_gn_gain[i], w_ple[i], w_ple_gate[i], rel_bias)
    return rmsnorm(x, final_gain)
```

```cpp
#include <hip/hip_runtime.h>
#include <hip/hip_cooperative_groups.h>
#include <cstdio>
#include <cstdint>
namespace cg = cooperative_groups;

#define LAS __attribute__((address_space(3)))
typedef unsigned short bf16_t;
typedef short bf16x8 __attribute__((ext_vector_type(8)));
typedef float f32x4 __attribute__((ext_vector_type(4)));
typedef float f32x2 __attribute__((ext_vector_type(2)));
typedef unsigned u32x4 __attribute__((ext_vector_type(4)));
typedef unsigned u32x2 __attribute__((ext_vector_type(2)));

constexpr int DM = 2048, NB = 4, SEQ = 4096, MTOK = NB * SEQ, CHUNK = 64, PLE = 256;
constexpr int NWIN = 13392, NWIN_PAD = 13568;
constexpr float EPS = 1e-6f;

constexpr size_t MiB = 1u << 20;
constexpr size_t WS_CTL = 0;
constexpr size_t WS_WIN = 1 * MiB;
constexpr size_t WS_WA = 54 * MiB;
constexpr size_t WS_WB = 58 * MiB;
constexpr size_t WS_WO = 62 * MiB;
constexpr size_t WS_WPG = 70 * MiB;
constexpr size_t WS_WPLE = 78 * MiB;
constexpr size_t WS_PB = 79 * MiB;
constexpr size_t WS_ROPE = 87 * MiB;
constexpr size_t WS_IK = 95 * MiB;
constexpr size_t WS_IW = 97 * MiB;
constexpr size_t WS_MASK = 98 * MiB;
constexpr size_t WS_AK = 106 * MiB;
constexpr size_t WS_AV = 138 * MiB;
constexpr size_t WS_AZ = 170 * MiB;
constexpr size_t WS_RQ = 202 * MiB;
constexpr size_t WS_RK = 234 * MiB;
constexpr size_t WS_RV = 266 * MiB;
constexpr size_t WS_RZ = 298 * MiB;
constexpr size_t WS_GA = 330 * MiB;
constexpr size_t WS_GB = 394 * MiB;
constexpr size_t WS_BO = 458 * MiB;
constexpr size_t WS_END = 490 * MiB;
constexpr size_t DO_H = 0, DO_KVT = 0, DO_IQ = 64 * MiB, DO_AQ = 96 * MiB, DO_AO = DO_IQ;
constexpr size_t WS_T = WS_AK, WS_MG = WS_RK, WS_RB = WS_GA, WS_U = WS_GB;

typedef __bf16 bf16x2_t __attribute__((ext_vector_type(2)));
__device__ __forceinline__ unsigned cvt_pk_bf16(float lo, float hi) { f32x2 v = {lo, hi}; bf16x2_t b = __builtin_convertvector(v, bf16x2_t); return __builtin_bit_cast(unsigned, b); }
__device__ __forceinline__ unsigned f2bf(float f) { unsigned u = __builtin_bit_cast(unsigned, f); return (u + 0x7fffu + ((u >> 16) & 1u)) >> 16; }
__device__ __forceinline__ unsigned pk2(float lo, float hi) { return f2bf(lo) | (f2bf(hi) << 16); }
__device__ __forceinline__ float bf2f(unsigned short h) { return __builtin_bit_cast(float, (unsigned)h << 16); }
__device__ __forceinline__ float sigmoidf_(float z) { return 1.0f / (1.0f + __expf(-z)); }
__device__ __forceinline__ float siluf_(float z) { return z / (1.0f + __expf(-z)); }
__device__ __forceinline__ float wave_sum(float v) {
#pragma unroll
    for (int o = 1; o < 64; o <<= 1) v += __shfl_xor(v, o);
    return v;
}
#define LDS_WAIT() asm volatile("s_waitcnt lgkmcnt(0)" ::: "memory")

namespace pg8 {
constexpr int BM = 256, BK = 64, HALF = 128, HTB = HALF * BK * 2, STAGE_BYTES = 8 * HTB, NXCD = 8, WGM = 8;
__host__ __device__ __forceinline__ int lds_byte(int r, int c) { const int st = (r >> 4) * 2 + (c >> 5), rr = r & 15, cc = c & 31, ob = rr * 64 + cc * 2; return st * 1024 + (ob ^ (((ob >> 9) & 1) << 5)); }
__host__ __device__ __forceinline__ void stage_rc(int b, int& R, int& C) { const int st = b / 1024, sb = b % 1024, swz = sb ^ (((sb >> 9) & 1) << 5); R = (st >> 1) * 16 + swz / 64; C = (st & 1) * 32 + (swz % 64) / 2; }
__host__ __device__ __forceinline__ int perm32(int rho) { const int n = rho >> 4, i = rho & 15; return 8 * (i >> 2) + 4 * n + (i & 3); }
struct Unit { int pm, pn; };
struct Gemm { const bf16_t* A; const bf16_t* Bt; int M, N, K; };
struct StaticOrder {
    int nM, nN, nwg, G, c;
    __host__ __device__ void init(int M, int N, int G_, int c_) { nM = M / BM; nN = N / BM; nwg = nM * nN; G = G_; c = c_; }
    __host__ __device__ bool next(int i, Unit& u) const {
        const long L = (long)i * G + c; if (L >= nwg) return false;
        int wgid = (int)L; { const int q = nwg / NXCD, r = nwg % NXCD, xcd = wgid % NXCD, off = wgid / NXCD; wgid = (xcd < r ? xcd * (q + 1) : r * (q + 1) + (xcd - r) * q) + off; }
        const int nig = WGM * nN, gid = wgid / nig, fm = gid * WGM, gsz = (nM - fm) < WGM ? (nM - fm) : WGM;
        u.pm = fm + ((wgid % nig) % gsz); u.pn = (wgid % nig) / gsz; return true;
    }
    __device__ __forceinline__ void a_ready(const Unit&) const {}
    __device__ __forceinline__ void done(const Unit&) const {}
};

template <class Epi, class Sched, bool ALIGN_EPI = true>
__device__ __forceinline__ void gemm_phase(LAS unsigned char* lds, const Gemm g, const Sched& S, const Epi& E) {
    const int tid = threadIdx.x, wid = __builtin_amdgcn_readfirstlane(tid >> 6), lane = tid & 63, wr = wid >> 2, wc = wid & 3, fr = lane & 15, fq = lane >> 4;
    const int K = g.K, nt = K / BK;
    unsigned voffA[2], voffB[2];
#pragma unroll
    for (int i = 0; i < 2; ++i) { int R, C; stage_rc(tid * 16 + i * 8192, R, C); const int Rb = Epi::PERM ? ((R & ~31) + perm32(R & 31)) : R;
        voffA[i] = (unsigned)(R * K + C) * 2u; voffB[i] = (unsigned)(Rb * K + C) * 2u; }
    const size_t kstep = (size_t)(BK * 2);
    const size_t hstep = (size_t)HALF * K * 2;
    const size_t tstep = 2 * hstep;
    const unsigned ldsw = (unsigned)wid * 1024u;
    const int aoff = lds_byte(wr * 64 + fr, fq * 8), boff = lds_byte(wc * 32 + fr, fq * 8);
#define PG8_SA(b, h) (((b) * 2 + (h)) * HTB)
#define PG8_SB(b, h) ((4 + (b) * 2 + (h)) * HTB)
#define PG8_STAGE(bufoff, gbase, voff) do { _Pragma("unroll") for (int _i = 0; _i < 2; ++_i) \
        __builtin_amdgcn_global_load_lds((const unsigned*)((const char*)(gbase) + (voff)[_i]), (LAS unsigned*)(lds + (bufoff) + ldsw + _i * 8192), 16, 0, 0); } while (0)
#define PG8_LDA(dst, b, h) do { _Pragma("unroll") for (int m = 0; m < 4; ++m) _Pragma("unroll") for (int k = 0; k < 2; ++k) dst[m][k] = *(const LAS bf16x8*)(lds + PG8_SA(b, h) + aoff + m * 2048 + k * 1024); } while (0)
#define PG8_LDB(dst, b, h) do { _Pragma("unroll") for (int n = 0; n < 2; ++n) _Pragma("unroll") for (int k = 0; k < 2; ++k) dst[n][k] = *(const LAS bf16x8*)(lds + PG8_SB(b, h) + boff + n * 2048 + k * 1024); } while (0)
#define PG8_MMA(ai, bj, At, Bt) do { __builtin_amdgcn_s_setprio(1); _Pragma("unroll") for (int m = 0; m < 4; ++m) _Pragma("unroll") for (int n = 0; n < 2; ++n) _Pragma("unroll") for (int k = 0; k < 2; ++k) \
        acc[ai][bj][m][n] = __builtin_amdgcn_mfma_f32_16x16x32_bf16(Bt[n][k], At[m][k], acc[ai][bj][m][n], 0, 0, 0); __builtin_amdgcn_s_setprio(0); } while (0)
#define PG8_WAIT_V(n) asm volatile("s_waitcnt vmcnt(" #n ")" ::: "memory")
#define PG8_WAIT_L(n) asm volatile("s_waitcnt lgkmcnt(" #n ")" ::: "memory")
#define PG8_BAR __builtin_amdgcn_s_barrier()
#define PG8_SCHED __builtin_amdgcn_sched_barrier(0)
    Unit cur, nxt; int ui = 0;
    if (!S.next(0, cur)) return;
    f32x4 acc[2][2][4][2];
#pragma unroll
    for (int a = 0; a < 2; ++a)
#pragma unroll
        for (int b = 0; b < 2; ++b)
#pragma unroll
            for (int m = 0; m < 4; ++m)
#pragma unroll
                for (int n = 0; n < 2; ++n) acc[a][b][m][n] = (f32x4){0.f, 0.f, 0.f, 0.f};
    bf16x8 At[4][2], B0[2][2], B1[2][2];
    const char* cA = (const char*)g.A + (size_t)cur.pm * tstep; const char* cB = (const char*)g.Bt + (size_t)cur.pn * tstep;
    S.a_ready(cur);
    PG8_STAGE(PG8_SB(0, 0), cB, voffB); PG8_STAGE(PG8_SB(0, 1), cB + hstep, voffB); PG8_STAGE(PG8_SA(0, 0), cA, voffA); PG8_STAGE(PG8_SA(0, 1), cA + hstep, voffA);
    if (wr == 1) PG8_BAR;
    PG8_WAIT_V(2); PG8_BAR;
    PG8_STAGE(PG8_SB(1, 0), cB + kstep, voffB); PG8_STAGE(PG8_SA(1, 0), cA + kstep, voffA); PG8_STAGE(PG8_SB(1, 1), cB + hstep + kstep, voffB);
    PG8_WAIT_V(6); PG8_BAR;
    for (;;) {
        const bool has_next = S.next(ui + 1, nxt);
        const char* nA = has_next ? (const char*)g.A + (size_t)nxt.pm * tstep : cA; const char* nB = has_next ? (const char*)g.Bt + (size_t)nxt.pn * tstep : cB;
#pragma unroll 1
        for (int t = 0; t < nt; t += 2) {
            const bool last = (t == nt - 2);
            const char* a1 = cA + (size_t)(t + 1) * kstep;
            const char* a2 = last ? nA : cA + (size_t)(t + 2) * kstep; const char* b2 = last ? nB : cB + (size_t)(t + 2) * kstep;
            const char* a3 = a2 + kstep; const char* b3 = b2 + kstep;
            if (last && has_next) S.a_ready(nxt);
            PG8_LDB(B0, 0, 0); PG8_LDB(B1, 0, 1); PG8_SCHED; PG8_LDA(At, 0, 0); PG8_STAGE(PG8_SA(1, 1), a1 + hstep, voffA);
            PG8_WAIT_V(8); PG8_WAIT_L(0); PG8_BAR; PG8_MMA(0, 0, At, B0); PG8_MMA(0, 1, At, B1); PG8_BAR; PG8_SCHED;
            PG8_LDA(At, 0, 1); PG8_STAGE(PG8_SB(0, 0), b2, voffB); PG8_STAGE(PG8_SB(0, 1), b2 + hstep, voffB); PG8_STAGE(PG8_SA(0, 0), a2, voffA);
            PG8_WAIT_V(8); PG8_WAIT_L(0); PG8_BAR; PG8_MMA(1, 0, At, B0); PG8_MMA(1, 1, At, B1); PG8_BAR; PG8_SCHED;
            PG8_LDB(B0, 1, 0); PG8_LDB(B1, 1, 1); PG8_SCHED; PG8_LDA(At, 1, 0); PG8_STAGE(PG8_SA(0, 1), a2 + hstep, voffA);
            PG8_WAIT_V(8); PG8_WAIT_L(0); PG8_BAR; PG8_MMA(0, 0, At, B0); PG8_MMA(0, 1, At, B1); PG8_BAR; PG8_SCHED;
            PG8_LDA(At, 1, 1); PG8_STAGE(PG8_SB(1, 0), b3, voffB); PG8_STAGE(PG8_SB(1, 1), b3 + hstep, voffB); PG8_STAGE(PG8_SA(1, 0), a3, voffA);
            PG8_WAIT_V(8); PG8_WAIT_L(0); PG8_BAR; PG8_MMA(1, 0, At, B0); PG8_MMA(1, 1, At, B1); PG8_BAR; PG8_SCHED;
        }
        if constexpr (ALIGN_EPI) { if (wr == 0) PG8_BAR; }
        E(acc, cur, wr, wc, fr, fq);
        if (!has_next) break;
#pragma unroll
        for (int a = 0; a < 2; ++a)
#pragma unroll
            for (int b = 0; b < 2; ++b)
#pragma unroll
                for (int m = 0; m < 4; ++m)
#pragma unroll
                    for (int n = 0; n < 2; ++n) acc[a][b][m][n] = (f32x4){0.f, 0.f, 0.f, 0.f};
        cur = nxt; cA = nA; cB = nB; ++ui;
        if constexpr (ALIGN_EPI) { if (wr == 1) PG8_BAR; }
    }
    PG8_WAIT_V(0);
    if constexpr (!ALIGN_EPI) { if (wr == 0) PG8_BAR; }
    PG8_BAR;
#undef PG8_SA
#undef PG8_SB
#undef PG8_STAGE
#undef PG8_LDA
#undef PG8_LDB
#undef PG8_MMA
#undef PG8_WAIT_V
#undef PG8_WAIT_L
#undef PG8_BAR
#undef PG8_SCHED
}
}

typedef f32x4 AccT[2][2][4][2];
template <class Fn> __device__ __forceinline__ void epi_foreach(const AccT& acc, const pg8::Unit& u, int wr, int wc, int fr, int fq, Fn&& f) {
    asm volatile("" : "+v"(fr), "+v"(fq));
#pragma unroll
    for (int ai = 0; ai < 2; ++ai)
#pragma unroll
        for (int m = 0; m < 4; ++m)
#pragma unroll
            for (int bj = 0; bj < 2; ++bj) {
                f(u.pm * 256 + ai * 128 + wr * 64 + m * 16 + fr, u.pn * 256 + bj * 128 + wc * 32 + 8 * fq, acc[ai][bj][m][0], acc[ai][bj][m][1]);
                asm volatile("" ::: "memory"); }
}

template <int ldc> struct EpiPlainBf16 {
    static constexpr bool PERM = true;
    bf16_t* O;
    __device__ __forceinline__ void operator()(const AccT& acc, const pg8::Unit& u, int wr, int wc, int fr, int fq) const {
        epi_foreach(acc, u, wr, wc, fr, fq, [&](int row, int col, f32x4 v0, f32x4 v1) {
            u32x4 w; w.x = cvt_pk_bf16(v0[0], v0[1]); w.y = cvt_pk_bf16(v0[2], v0[3]); w.z = cvt_pk_bf16(v1[0], v1[1]); w.w = cvt_pk_bf16(v1[2], v1[3]);
            *(u32x4*)(O + (size_t)row * ldc + col) = w; });
    }
};
struct EpiGate {
    static constexpr bool PERM = true;
    const float* R; const bf16_t* U; float* O;
    __device__ __forceinline__ void operator()(const AccT& acc, const pg8::Unit& u, int wr, int wc, int fr, int fq) const {
        epi_foreach(acc, u, wr, wc, fr, fq, [&](int row, int col, f32x4 v0, f32x4 v1) {
            const size_t off = (size_t)row * DM + col;
            const f32x4 r0 = *(const f32x4*)(R + off), r1 = *(const f32x4*)(R + off + 4);
            const u32x4 uu = *(const u32x4*)(U + off);
            f32x4 o0, o1;
            o0[0] = r0[0] + bf2f((unsigned short)(uu.x & 0xffff)) * sigmoidf_(v0[0]); o0[1] = r0[1] + bf2f((unsigned short)(uu.x >> 16)) * sigmoidf_(v0[1]);
            o0[2] = r0[2] + bf2f((unsigned short)(uu.y & 0xffff)) * sigmoidf_(v0[2]); o0[3] = r0[3] + bf2f((unsigned short)(uu.y >> 16)) * sigmoidf_(v0[3]);
            o1[0] = r1[0] + bf2f((unsigned short)(uu.z & 0xffff)) * sigmoidf_(v1[0]); o1[1] = r1[1] + bf2f((unsigned short)(uu.z >> 16)) * sigmoidf_(v1[1]);
            o1[2] = r1[2] + bf2f((unsigned short)(uu.w & 0xffff)) * sigmoidf_(v1[2]); o1[3] = r1[3] + bf2f((unsigned short)(uu.w >> 16)) * sigmoidf_(v1[3]);
            *(f32x4*)(O + off) = o0; *(f32x4*)(O + off + 4) = o1; });
    }
};

template <bool HAS_T> struct EpiMerge {
    static constexpr bool PERM = true;
    const bf16_t* T; const bf16_t* Gt; bf16_t* O;
    __device__ __forceinline__ void operator()(const AccT& acc, const pg8::Unit& u, int wr, int wc, int fr, int fq) const {
        epi_foreach(acc, u, wr, wc, fr, fq, [&](int row, int col, f32x4 v0, f32x4 v1) {
            const size_t off = (size_t)row * DM + col;
            const u32x4 gg = *(const u32x4*)(Gt + off);
            float o[8];
            o[0] = bf2f((unsigned short)(gg.x & 0xffff)) * v0[0]; o[1] = bf2f((unsigned short)(gg.x >> 16)) * v0[1];
            o[2] = bf2f((unsigned short)(gg.y & 0xffff)) * v0[2]; o[3] = bf2f((unsigned short)(gg.y >> 16)) * v0[3];
            o[4] = bf2f((unsigned short)(gg.z & 0xffff)) * v1[0]; o[5] = bf2f((unsigned short)(gg.z >> 16)) * v1[1];
            o[6] = bf2f((unsigned short)(gg.w & 0xffff)) * v1[2]; o[7] = bf2f((unsigned short)(gg.w >> 16)) * v1[3];
            if constexpr (HAS_T) { const u32x4 tt = *(const u32x4*)(T + off);
                o[0] += bf2f((unsigned short)(tt.x & 0xffff)); o[1] += bf2f((unsigned short)(tt.x >> 16)); o[2] += bf2f((unsigned short)(tt.y & 0xffff)); o[3] += bf2f((unsigned short)(tt.y >> 16));
                o[4] += bf2f((unsigned short)(tt.z & 0xffff)); o[5] += bf2f((unsigned short)(tt.z >> 16)); o[6] += bf2f((unsigned short)(tt.w & 0xffff)); o[7] += bf2f((unsigned short)(tt.w >> 16)); }
            u32x4 w; w.x = cvt_pk_bf16(o[0], o[1]); w.y = cvt_pk_bf16(o[2], o[3]); w.z = cvt_pk_bf16(o[4], o[5]); w.w = cvt_pk_bf16(o[6], o[7]);
            *(u32x4*)(O + off) = w; });
    }
};
struct EpiResid {
    static constexpr bool PERM = true;
    const float* X; float* O32; bf16_t* O16;
    __device__ __forceinline__ void operator()(const AccT& acc, const pg8::Unit& u, int wr, int wc, int fr, int fq) const {
        epi_foreach(acc, u, wr, wc, fr, fq, [&](int row, int col, f32x4 v0, f32x4 v1) {
            const size_t off = (size_t)row * DM + col;
            const f32x4 r0 = *(const f32x4*)(X + off) + v0, r1 = *(const f32x4*)(X + off + 4) + v1;
            *(f32x4*)(O32 + off) = r0; *(f32x4*)(O32 + off + 4) = r1;
            u32x4 w; w.x = cvt_pk_bf16(r0[0], r0[1]); w.y = cvt_pk_bf16(r0[2], r0[3]); w.z = cvt_pk_bf16(r1[0], r1[1]); w.w = cvt_pk_bf16(r1[2], r1[3]);
            *(u32x4*)(O16 + off) = w; });
    }
};
__device__ __forceinline__ size_t hm_off(int row, int hh, int d) { return ((size_t)(row & ~4095) * 8 + (size_t)hh * 4096 + (size_t)(row & 4095)) * 128 + d; }
__device__ __forceinline__ u32x4 pack8f(const float* o) { u32x4 w; w.x = cvt_pk_bf16(o[0], o[1]); w.y = cvt_pk_bf16(o[2], o[3]); w.z = cvt_pk_bf16(o[4], o[5]); w.w = cvt_pk_bf16(o[6], o[7]); return w; }
struct EpiProj {
    static constexpr bool PERM = true;
    unsigned char* ws; unsigned char* dout;
    __device__ __forceinline__ void operator()(const AccT& acc, const pg8::Unit& u, int wr, int wc, int fr, int fq) const {
        const int pn = u.pn;
        if (pn < 12 || (pn >= 29 && pn < 33)) {
            bf16_t* base; int tl;
            if (pn < 4) { base = (bf16_t*)(dout + DO_AQ); tl = pn; } else if (pn < 8) { base = (bf16_t*)(ws + WS_AK); tl = pn - 4; }
            else if (pn < 12) { base = (bf16_t*)(ws + WS_AV); tl = pn - 8; } else { base = (bf16_t*)(ws + WS_RV); tl = pn - 29; }
            epi_foreach(acc, u, wr, wc, fr, fq, [&](int row, int col, f32x4 v0, f32x4 v1) {
                const int colt = col & 255; const float o[8] = {v0[0], v0[1], v0[2], v0[3], v1[0], v1[1], v1[2], v1[3]};
                *(u32x4*)(base + hm_off(row, 2 * tl + (colt >> 7), colt & 127)) = pack8f(o); });
        } else if (pn == 20) {
            asm volatile("" : "+v"(fr), "+v"(fq));
            if (wc == 0) {
                bf16_t* IK = (bf16_t*)(ws + WS_IK);
#pragma unroll
                for (int ai = 0; ai < 2; ++ai)
#pragma unroll
                    for (int m = 0; m < 4; ++m) {
                        const int row = u.pm * 256 + ai * 128 + wr * 64 + m * 16 + fr;
                        float x[16];
#pragma unroll
                        for (int j = 0; j < 4; ++j) { x[j] = acc[ai][0][m][0][j]; x[4 + j] = acc[ai][0][m][1][j]; x[8 + j] = acc[ai][1][m][0][j]; x[12 + j] = acc[ai][1][m][1][j]; }
                        float sum = 0.f;
#pragma unroll
                        for (int j = 0; j < 16; ++j) sum += x[j];
                        sum += __shfl_xor(sum, 16); sum += __shfl_xor(sum, 32);
                        const float mu = sum * (1.0f / 64.0f); float q = 0.f;
#pragma unroll
                        for (int j = 0; j < 16; ++j) { x[j] -= mu; q += x[j] * x[j]; }
                        q += __shfl_xor(q, 16); q += __shfl_xor(q, 32);
                        const float rs = 1.0f / sqrtf(q * (1.0f / 64.0f) + EPS);
#pragma unroll
                        for (int j = 0; j < 16; ++j) x[j] *= rs;
                        *(u32x4*)(IK + (size_t)row * 64 + 8 * fq) = pack8f(x); *(u32x4*)(IK + (size_t)row * 64 + 32 + 8 * fq) = pack8f(x + 8);
                        asm volatile("" ::: "memory");
                    }
            } else if (wc == 1) {
                float* IW = (float*)(ws + WS_IW);
                if (fq < 2) {
#pragma unroll
                    for (int ai = 0; ai < 2; ++ai)
#pragma unroll
                        for (int m = 0; m < 4; ++m) {
                            const int row = u.pm * 256 + ai * 128 + wr * 64 + m * 16 + fr;
                            *(f32x4*)(IW + (size_t)row * 16 + 8 * fq) = acc[ai][0][m][0] * 0.25f; *(f32x4*)(IW + (size_t)row * 16 + 8 * fq + 4) = acc[ai][0][m][1] * 0.25f;
                        }
                }
            }
        } else if (pn >= 21 && pn < 29) {
            asm volatile("" : "+v"(fr), "+v"(fq));
            const bool isk = pn >= 25; const int tl = isk ? pn - 25 : pn - 21; const float sc = isk ? 0.08838834764831845f : 1.0f;
            bf16_t* base = (bf16_t*)(ws + (isk ? WS_RK : WS_RQ)); const f32x4* rope = (const f32x4*)(ws + WS_ROPE);
            const int hh = 2 * tl + (wc >> 1), d0 = 32 * (wc & 1) + 8 * fq;
#pragma unroll
            for (int ai = 0; ai < 2; ++ai)
#pragma unroll
                for (int m = 0; m < 4; ++m) {
                    const int row = u.pm * 256 + ai * 128 + wr * 64 + m * 16 + fr;
                    const f32x4* rp = rope + ((size_t)row * 64 + d0) / 2;
                    float x1[8], x2[8], y1[8], y2[8];
#pragma unroll
                    for (int j = 0; j < 4; ++j) { x1[j] = acc[ai][0][m][0][j]; x1[4 + j] = acc[ai][0][m][1][j]; x2[j] = acc[ai][1][m][0][j]; x2[4 + j] = acc[ai][1][m][1][j]; }
#pragma unroll
                    for (int jj = 0; jj < 4; ++jj) { const f32x4 cs = rp[jj];
                        y1[2 * jj] = (x1[2 * jj] * cs[0] - x2[2 * jj] * cs[1]) * sc; y2[2 * jj] = (x1[2 * jj] * cs[1] + x2[2 * jj] * cs[0]) * sc;
                        y1[2 * jj + 1] = (x1[2 * jj + 1] * cs[2] - x2[2 * jj + 1] * cs[3]) * sc; y2[2 * jj + 1] = (x1[2 * jj + 1] * cs[3] + x2[2 * jj + 1] * cs[2]) * sc; }
                    const size_t o = hm_off(row, hh, d0);
                    *(u32x4*)(base + o) = pack8f(y1); *(u32x4*)(base + o + 64) = pack8f(y2);
                    asm volatile("" ::: "memory");
                }
        } else {
            bf16_t* base; int ld, c0, act;
            if (pn < 16) { base = (bf16_t*)(ws + WS_AZ); ld = 1024; c0 = (pn - 12) * 256; act = 0; }
            else if (pn < 20) { base = (bf16_t*)(dout + DO_IQ); ld = 1024; c0 = (pn - 16) * 256; act = 1; }
            else if (pn < 37) { base = (bf16_t*)(ws + WS_RZ); ld = 1024; c0 = (pn - 33) * 256; act = 0; }
            else if (pn < 45) { base = (bf16_t*)(ws + WS_GA); ld = 2048; c0 = (pn - 37) * 256; act = 2; }
            else { base = (bf16_t*)(ws + WS_GB); ld = 2048; c0 = (pn - 45) * 256; act = 2; }
            epi_foreach(acc, u, wr, wc, fr, fq, [&](int row, int col, f32x4 v0, f32x4 v1) {
                float o[8] = {v0[0], v0[1], v0[2], v0[3], v1[0], v1[1], v1[2], v1[3]};
#pragma unroll
                for (int j = 0; j < 8; ++j) o[j] = act == 0 ? siluf_(o[j]) : (act == 1 ? o[j] * 0.125f : sigmoidf_(o[j]));
                *(u32x4*)(base + (size_t)row * ld + c0 + (col & 255)) = pack8f(o); });
        }
    }
};

constexpr int NWAVES = 8, NTHREADS = 512;
constexpr int LDS_BYTES = 147456;
struct Args {
    const float* x; const float* p; const int* pos; const float* w_in; const float* norm_gain; const float* w_a; const float* w_b; const float* w_o;
    const float* gn_gain; const float* w_ple; const float* w_pg; const float* rel_bias; const float* final_gain;
    float* out; unsigned char* ws; int ph_lo, ph_hi; int coop, pad;
};
struct Frame { LAS unsigned char* lds; int tid, lane, wave, G, vcu; };
__device__ __forceinline__ void frame_ids(Frame& F) { int t = threadIdx.x; asm volatile("" : "+v"(t)); F.tid = t; F.lane = t & 63; F.wave = __builtin_amdgcn_readfirstlane(t >> 6); }

__device__ __forceinline__ void transpose_item(const float* W, int K, int N, int src_c0, int cnt, bf16_t* WT, int dst_r0, int k0, LAS float* scr, int lane) {
    const int c = lane & 31;
#pragma unroll 8
    for (int i = 0; i < 32; ++i) { const int kk = 2 * i + (lane >> 5); float v = 0.f; if (src_c0 >= 0 && c < cnt) v = W[(size_t)(k0 + kk) * N + src_c0 + c]; scr[kk * 33 + c] = v; }
    LDS_WAIT(); asm volatile("" ::: "memory");
    const int c8 = lane & 7;
#pragma unroll
    for (int j = 0; j < 4; ++j) { const int n = (lane >> 3) + 8 * j; const LAS float* s = scr + (8 * c8) * 33 + n;
        u32x4 o; o.x = pk2(s[0 * 33], s[1 * 33]); o.y = pk2(s[2 * 33], s[3 * 33]); o.z = pk2(s[4 * 33], s[5 * 33]); o.w = pk2(s[6 * 33], s[7 * 33]);
        *(u32x4*)(WT + (size_t)(dst_r0 + n) * K + k0 + 8 * c8) = o; }
    LDS_WAIT(); asm volatile("" ::: "memory");
}
__device__ __forceinline__ int win_src(int blk, int& cnt) {
    const int tile = blk >> 3, sb = blk & 7; cnt = 32;
    if (tile < 20) return tile * 256 + 32 * sb;
    if (tile == 20) { if (sb == 0) return 5120; if (sb == 4) return 5152; if (sb == 1) { cnt = 16; return 5184; } return -1; }
    if (tile < 29) { const int rk = tile >= 25, tl = rk ? tile - 25 : tile - 21, bj = sb >> 2, wc = sb & 3;
        return (rk ? 6224 : 5200) + (2 * tl + (wc >> 1)) * 128 + bj * 64 + 32 * (wc & 1); }
    if (tile < 37) return 7248 + (tile - 29) * 256 + 32 * sb;
    return 9296 + (tile - 37) * 256 + 32 * sb;
}
__device__ __forceinline__ void p0_prologue(const Args& a, Frame& F) {
    LAS float* scr = (LAS float*)(F.lds + F.wave * 16384);
    const int gw = F.vcu * NWAVES + F.wave, NGW = F.G * NWAVES;
    unsigned char* ws = a.ws;
    constexpr int KB_IN = DM / 64;
    constexpr int I_IN = KB_IN * (NWIN_PAD / 32);
    constexpr int I_A = (1024 / 64) * (DM / 32);
    constexpr int I_O = (DM / 64) * (DM / 32);
    constexpr int I_PLE = (PLE / 64) * (DM / 32);
    constexpr int NITEMS = I_IN + 2 * I_A + 2 * I_O + I_PLE;
    for (int it = gw; it < NITEMS; it += NGW) {
        int r = it;
        if (r < I_IN) { const int blk = r / KB_IN, kb = r % KB_IN; int cnt; const int src = win_src(blk, cnt);
            transpose_item(a.w_in, DM, NWIN, src, cnt, (bf16_t*)(ws + WS_WIN), blk * 32, kb * 64, scr, F.lane); continue; } r -= I_IN;
        if (r < I_A) { const int blk = r / 16, kb = r % 16; transpose_item(a.w_a, 1024, DM, blk * 32, 32, (bf16_t*)(ws + WS_WA), blk * 32, kb * 64, scr, F.lane); continue; } r -= I_A;
        if (r < I_A) { const int blk = r / 16, kb = r % 16; transpose_item(a.w_b, 1024, DM, blk * 32, 32, (bf16_t*)(ws + WS_WB), blk * 32, kb * 64, scr, F.lane); continue; } r -= I_A;
        if (r < I_O) { const int blk = r / 32, kb = r % 32; transpose_item(a.w_o, DM, DM, blk * 32, 32, (bf16_t*)(ws + WS_WO), blk * 32, kb * 64, scr, F.lane); continue; } r -= I_O;
        if (r < I_O) { const int blk = r / 32, kb = r % 32; transpose_item(a.w_pg, DM, DM, blk * 32, 32, (bf16_t*)(ws + WS_WPG), blk * 32, kb * 64, scr, F.lane); continue; } r -= I_O;
        { const int blk = r / 4, kb = r % 4; transpose_item(a.w_ple, PLE, DM, blk * 32, 32, (bf16_t*)(ws + WS_WPLE), blk * 32, kb * 64, scr, F.lane); }
    }
    bf16_t* H = (bf16_t*)((unsigned char*)a.out + DO_H); bf16_t* PB = (bf16_t*)(ws + WS_PB);
    for (int m = gw; m < MTOK; m += NGW) {
        const f32x4* xr = (const f32x4*)(a.x + (size_t)m * DM) + F.lane; const f32x4* gr = (const f32x4*)a.norm_gain + F.lane;
        f32x4 v[8]; float s = 0.f;
#pragma unroll
        for (int j = 0; j < 8; ++j) { v[j] = xr[64 * j]; s += (v[j][0] * v[j][0] + v[j][1] * v[j][1]) + (v[j][2] * v[j][2] + v[j][3] * v[j][3]); }
        const float rstd = 1.0f / sqrtf(wave_sum(s) * (1.0f / DM) + EPS);
        u32x2* o8 = (u32x2*)(H + (size_t)m * DM) + F.lane;
#pragma unroll
        for (int j = 0; j < 8; ++j) { const f32x4 g = gr[64 * j]; u32x2 w; w.x = pk2(v[j][0] * rstd * g[0], v[j][1] * rstd * g[1]); w.y = pk2(v[j][2] * rstd * g[2], v[j][3] * rstd * g[3]); o8[64 * j] = w; }
        const f32x4 pv = *((const f32x4*)(a.p + (size_t)m * PLE) + F.lane);
        u32x2 w; w.x = pk2(pv[0], pv[1]); w.y = pk2(pv[2], pv[3]); *((u32x2*)(PB + (size_t)m * PLE) + F.lane) = w;
    }
    f32x2* rope = (f32x2*)(ws + WS_ROPE);
    for (int e = (F.vcu * NTHREADS + F.tid); e < MTOK * 64; e += F.G * NTHREADS) {
        const int m = e >> 6, i = e & 63;
        const float invf = exp2f(-(float)i * (1.0f / 64.0f) * 13.287712379549449f);
        const float ang = (float)a.pos[m] * invf;
        const double ad = (double)ang;
        rope[e] = (f32x2){(float)cos(ad), (float)sin(ad)};
    }
}
__device__ __forceinline__ void p_final_norm(const Args& a, Frame& F) {
    const int gw = F.vcu * NWAVES + F.wave, NGW = F.G * NWAVES;
    for (int m = gw; m < MTOK; m += NGW) {
        f32x4* xr = (f32x4*)(a.out + (size_t)m * DM) + F.lane; const f32x4* gr = (const f32x4*)a.final_gain + F.lane;
        f32x4 v[8]; float s = 0.f;
#pragma unroll
        for (int j = 0; j < 8; ++j) { v[j] = xr[64 * j]; s += (v[j][0] * v[j][0] + v[j][1] * v[j][1]) + (v[j][2] * v[j][2] + v[j][3] * v[j][3]); }
        const float rstd = 1.0f / sqrtf(wave_sum(s) * (1.0f / DM) + EPS);
#pragma unroll
        for (int j = 0; j < 8; ++j) { const f32x4 g = gr[64 * j]; xr[64 * j] = (f32x4){v[j][0] * rstd * g[0], v[j][1] * rstd * g[1], v[j][2] * rstd * g[2], v[j][3] * rstd * g[3]}; }
    }
}

namespace att {
typedef short s16x4 __attribute__((ext_vector_type(4)));
typedef float f32x16 __attribute__((ext_vector_type(16)));
#define KSWZ(row, colB) ((row) * 256 + ((colB) ^ (((row) & 7) << 4)))
#define SBAR() __builtin_amdgcn_sched_barrier(0)
__device__ __forceinline__ int v_st(int k, int c) { const int kk = (k & ~0xC) | ((k & 4) << 1) | ((k & 8) >> 1); return ((kk >> 3) * 4 + (c >> 5)) * 512 + ((kk & 7) * 32 + (c & 31)) * 2; }
__device__ __forceinline__ int v_rd_base(int lane) { return ((lane & 3) << 3) | (((lane >> 2) & 3) << 6) | (((lane >> 4) & 1) << 5) | (((lane >> 5) & 1) << 8); }
constexpr int v_rd_off(int d0, int ks, int half) { return d0 * 512 + ks * 4096 + half * 2048; }
__device__ __forceinline__ int crow(int r, int hi) { return (r & 3) + 8 * (r >> 2) + 4 * hi; }
#define TRRD(dst, vb, off) asm volatile("ds_read_b64_tr_b16 %0, %1 offset:%2" : "=&v"(dst) : "v"(vb), "i"(off) : "memory")
#define TRRDV(dst, addr) asm volatile("ds_read_b64_tr_b16 %0, %1" : "=&v"(dst) : "v"(addr) : "memory")
__device__ __forceinline__ void qkt(f32x16& p0, f32x16& p1, const LAS unsigned char* Kb, int r32, int hi, const bf16x8* qr) {
    p0 = f32x16{}; p1 = f32x16{};
    const LAS unsigned char* kb[4];
#pragma unroll
    for (int dd = 0; dd < 4; ++dd) kb[dd] = Kb + KSWZ(r32, (dd * 16 + hi * 8) * 2);
#pragma unroll
    for (int d0 = 0; d0 < 8; ++d0) { const LAS unsigned char* a = kb[d0 & 3] + (d0 >> 2) * 128;
        const bf16x8 b0 = *(const LAS bf16x8*)a; const bf16x8 b1 = *(const LAS bf16x8*)(a + 32 * 256);
        p0 = __builtin_amdgcn_mfma_f32_32x32x16_bf16(b0, qr[d0], p0, 0, 0, 0);
        p1 = __builtin_amdgcn_mfma_f32_32x32x16_bf16(b1, qr[d0], p1, 0, 0, 0); }
}
template <int VOFF>
__device__ __forceinline__ void pv_tile(f32x16* o, int vb, bf16x8 pa0, bf16x8 pa1, bf16x8 pa2, bf16x8 pa3) {
#define PV_D0(d0) do { s16x4 l0, l1, l2, l3, h0, h1, h2, h3; constexpr int b_ = VOFF + v_rd_off(d0, 0, 0); \
        TRRD(l0, vb, b_); TRRD(h0, vb, b_ + 2048); TRRD(l1, vb, b_ + 4096); TRRD(h1, vb, b_ + 6144); TRRD(l2, vb, b_ + 8192); TRRD(h2, vb, b_ + 10240); TRRD(l3, vb, b_ + 12288); TRRD(h3, vb, b_ + 14336); \
        asm volatile("s_waitcnt lgkmcnt(0)" ::: "memory"); SBAR(); \
        o[d0] = __builtin_amdgcn_mfma_f32_32x32x16_bf16(pa0, (bf16x8){l0[0], l0[1], l0[2], l0[3], h0[0], h0[1], h0[2], h0[3]}, o[d0], 0, 0, 0); \
        o[d0] = __builtin_amdgcn_mfma_f32_32x32x16_bf16(pa1, (bf16x8){l1[0], l1[1], l1[2], l1[3], h1[0], h1[1], h1[2], h1[3]}, o[d0], 0, 0, 0); \
        o[d0] = __builtin_amdgcn_mfma_f32_32x32x16_bf16(pa2, (bf16x8){l2[0], l2[1], l2[2], l2[3], h2[0], h2[1], h2[2], h2[3]}, o[d0], 0, 0, 0); \
        o[d0] = __builtin_amdgcn_mfma_f32_32x32x16_bf16(pa3, (bf16x8){l3[0], l3[1], l3[2], l3[3], h3[0], h3[1], h3[2], h3[3]}, o[d0], 0, 0, 0); } while (0)
    PV_D0(0); PV_D0(1); PV_D0(2); PV_D0(3);
#undef PV_D0
}
__device__ __forceinline__ void pack_p(const f32x16& p0, const f32x16& p1, bf16x8& pa0, bf16x8& pa1, bf16x8& pa2, bf16x8& pa3) {
#define PK4(P, B_, OUT) do { const unsigned a0 = cvt_pk_bf16(P[B_+0], P[B_+1]), a1 = cvt_pk_bf16(P[B_+2], P[B_+3]); \
        const unsigned b0 = cvt_pk_bf16(P[B_+4], P[B_+5]), b1 = cvt_pk_bf16(P[B_+6], P[B_+7]); \
        auto r0 = __builtin_amdgcn_permlane32_swap(a0, b0, false, false); auto r1 = __builtin_amdgcn_permlane32_swap(a1, b1, false, false); \
        u32x4 w = {r0[0], r1[0], r0[1], r1[1]}; OUT = __builtin_bit_cast(bf16x8, w); } while (0)
    PK4(p0, 0, pa0); PK4(p0, 8, pa1); PK4(p1, 0, pa2); PK4(p1, 8, pa3);
#undef PK4
}
}

__device__ __forceinline__ float ret_log2g(int h) { return log2f(1.0f - exp2f(-5.0f - (float)h)); }
__device__ __forceinline__ void p_ret_kv(const Args& a, Frame& F) {
    using namespace att;
    const bf16_t* RK = (const bf16_t*)(a.ws + WS_RK); const bf16_t* RV = (const bf16_t*)(a.ws + WS_RV); bf16_t* KVT = (bf16_t*)((unsigned char*)a.out + DO_KVT);
    LAS unsigned char* Kl = F.lds; LAS unsigned char* Vl = F.lds + 16384;
    const int tid = F.tid, lane = F.lane, wid = F.wave, r32 = lane & 31, hi = lane >> 5;
    const int sr = tid >> 4, sc = (tid & 15) * 8;
    const int a0 = wid >> 1, dp = (wid & 1) * 2;
    const int vbK = (int)(uintptr_t)Kl + v_rd_base(lane), vbV = (int)(uintptr_t)Vl + v_rd_base(lane);
    for (int item = F.vcu; item < NB * 8 * 64; item += F.G) {
        const int bh = item >> 6, n = item & 63, h = bh & 7;
        const float lg = ret_log2g(h);
        const size_t rowbase = ((size_t)bh * SEQ + (size_t)n * 64) * 128;
#pragma unroll
        for (int i = 0; i < 2; ++i) { const int t = sr + 32 * i;
            const u32x4 kq = *(const u32x4*)(RK + rowbase + (size_t)t * 128 + sc); const u32x4 vq = *(const u32x4*)(RV + rowbase + (size_t)t * 128 + sc);
            const float w = exp2f((float)(63 - t) * lg);
            float kf[8]; kf[0] = bf2f((unsigned short)(kq.x & 0xffff)) * w; kf[1] = bf2f((unsigned short)(kq.x >> 16)) * w; kf[2] = bf2f((unsigned short)(kq.y & 0xffff)) * w; kf[3] = bf2f((unsigned short)(kq.y >> 16)) * w;
            kf[4] = bf2f((unsigned short)(kq.z & 0xffff)) * w; kf[5] = bf2f((unsigned short)(kq.z >> 16)) * w; kf[6] = bf2f((unsigned short)(kq.w & 0xffff)) * w; kf[7] = bf2f((unsigned short)(kq.w >> 16)) * w;
            *(LAS u32x4*)(Kl + v_st(t, sc)) = pack8f(kf); *(LAS u32x4*)(Vl + v_st(t, sc)) = vq; }
        __syncthreads();
        f32x16 acc[2] = {};
#pragma unroll
        for (int ks = 0; ks < 4; ++ks) {
            s16x4 al, ah, b0l, b0h, b1l, b1h;
            TRRDV(al, vbK + v_rd_off(a0, ks, 0)); TRRDV(ah, vbK + v_rd_off(a0, ks, 1));
            TRRDV(b0l, vbV + v_rd_off(dp, ks, 0)); TRRDV(b0h, vbV + v_rd_off(dp, ks, 1));
            TRRDV(b1l, vbV + v_rd_off(dp + 1, ks, 0)); TRRDV(b1h, vbV + v_rd_off(dp + 1, ks, 1));
            asm volatile("s_waitcnt lgkmcnt(0)" ::: "memory"); SBAR();
            const bf16x8 af = (bf16x8){al[0], al[1], al[2], al[3], ah[0], ah[1], ah[2], ah[3]};
            acc[0] = __builtin_amdgcn_mfma_f32_32x32x16_bf16(af, (bf16x8){b0l[0], b0l[1], b0l[2], b0l[3], b0h[0], b0h[1], b0h[2], b0h[3]}, acc[0], 0, 0, 0);
            acc[1] = __builtin_amdgcn_mfma_f32_32x32x16_bf16(af, (bf16x8){b1l[0], b1l[1], b1l[2], b1l[3], b1h[0], b1h[1], b1h[2], b1h[3]}, acc[1], 0, 0, 0);
        }
        bf16_t* dst = KVT + (size_t)item * 16384;
#pragma unroll
        for (int e = 0; e < 2; ++e)
#pragma unroll
            for (int g = 0; g < 4; ++g) { u32x2 w; w.x = cvt_pk_bf16(acc[e][4 * g], acc[e][4 * g + 1]); w.y = cvt_pk_bf16(acc[e][4 * g + 2], acc[e][4 * g + 3]);
                *(u32x2*)(dst + (size_t)(32 * (dp + e) + r32) * 128 + 32 * a0 + 8 * g + 4 * hi) = w; }
        __syncthreads();
    }
}
__device__ __forceinline__ void p_ret_scan(const Args& a, Frame& F) {
    bf16_t* KVT = (bf16_t*)((unsigned char*)a.out + DO_KVT);
    for (int idx = F.vcu * NTHREADS + F.tid; idx < 32 * 2048; idx += F.G * NTHREADS) {
        const int bh = idx >> 11, e8 = idx & 2047, h = bh & 7;
        const float dec = exp2f(64.0f * ret_log2g(h));
        float st[8] = {0.f, 0.f, 0.f, 0.f, 0.f, 0.f, 0.f, 0.f};
        u32x4* p = (u32x4*)(KVT + (size_t)bh * 64 * 16384 + (size_t)e8 * 8);
#pragma unroll 4
        for (int n = 0; n < 64; ++n) {
            const u32x4 kv = p[(size_t)n * 2048];
            p[(size_t)n * 2048] = pack8f(st);
            st[0] = st[0] * dec + bf2f((unsigned short)(kv.x & 0xffff)); st[1] = st[1] * dec + bf2f((unsigned short)(kv.x >> 16));
            st[2] = st[2] * dec + bf2f((unsigned short)(kv.y & 0xffff)); st[3] = st[3] * dec + bf2f((unsigned short)(kv.y >> 16));
            st[4] = st[4] * dec + bf2f((unsigned short)(kv.z & 0xffff)); st[5] = st[5] * dec + bf2f((unsigned short)(kv.z >> 16));
            st[6] = st[6] * dec + bf2f((unsigned short)(kv.w & 0xffff)); st[7] = st[7] * dec + bf2f((unsigned short)(kv.w >> 16));
        }
    }
}
__device__ __forceinline__ void p_ret_out(const Args& a, Frame& F) {
    using namespace att;
    const bf16_t* RQ = (const bf16_t*)(a.ws + WS_RQ); const bf16_t* RK = (const bf16_t*)(a.ws + WS_RK); const bf16_t* RV = (const bf16_t*)(a.ws + WS_RV);
    const bf16_t* RZ = (const bf16_t*)(a.ws + WS_RZ); const bf16_t* KVT = (const bf16_t*)((const unsigned char*)a.out + DO_KVT); bf16_t* BO = (bf16_t*)(a.ws + WS_BO);
    const int tid = F.tid, lane = F.lane, wid = F.wave, r32 = lane & 31, hi = lane >> 5;
    const int pr = wid >> 1, qblk = wid & 1, lt = tid & 127;
    LAS unsigned char* Kl = F.lds + pr * 32768; LAS unsigned char* Vl = Kl + 16384;
    const int vb = (int)(uintptr_t)Vl + v_rd_base(lane);
    for (int it0 = F.vcu * 4; it0 < NB * 8 * 64; it0 += F.G * 4) {
        const int item = it0 + pr, bh = item >> 6, n = item & 63, h = bh & 7, b = bh >> 3;
        const float lg = ret_log2g(h);
        const size_t rowbase = ((size_t)bh * SEQ + (size_t)n * 64) * 128;
#pragma unroll
        for (int i = 0; i < 8; ++i) { const int c = lt + 128 * i, t = c >> 4, sc = (c & 15) * 8;
            *(LAS u32x4*)(Kl + KSWZ(t, sc * 2)) = *(const u32x4*)(RK + rowbase + (size_t)t * 128 + sc);
            *(LAS u32x4*)(Vl + v_st(t, sc)) = *(const u32x4*)(RV + rowbase + (size_t)t * 128 + sc); }
        bf16x8 qr[8];
#pragma unroll
        for (int d0 = 0; d0 < 8; ++d0) qr[d0] = *(const bf16x8*)(RQ + rowbase + (size_t)(32 * qblk + r32) * 128 + d0 * 16 + hi * 8);
        __syncthreads();
        f32x16 p0, p1;
        qkt(p0, p1, Kl, r32, hi, qr);
        const int iq = 32 * qblk + r32;
#pragma unroll
        for (int r = 0; r < 16; ++r) { const int j0 = crow(r, hi), j1 = j0 + 32;
            const int e0 = (iq > j0 ? iq - j0 : j0 - iq) - iq - 1, e1 = (iq > j1 ? iq - j1 : j1 - iq) - iq - 1;
            p0[r] *= exp2f((float)e0 * lg); p1[r] *= exp2f((float)e1 * lg); }
        bf16x8 pa0, pa1, pa2, pa3;
        pack_p(p0, p1, pa0, pa1, pa2, pa3);
        f32x16 o[4] = {};
        SBAR();
        pv_tile<0>(o, vb, pa0, pa1, pa2, pa3);
        const bf16_t* ST = KVT + (size_t)item * 16384;
#pragma unroll
        for (int d0 = 0; d0 < 4; ++d0)
#pragma unroll
            for (int kk = 0; kk < 8; ++kk) { const bf16x8 sf = *(const bf16x8*)(ST + (size_t)(32 * d0 + r32) * 128 + 16 * kk + 8 * hi);
                o[d0] = __builtin_amdgcn_mfma_f32_32x32x16_bf16(qr[kk], sf, o[d0], 0, 0, 0); }
        float gain[4];
#pragma unroll
        for (int d0 = 0; d0 < 4; ++d0) gain[d0] = a.gn_gain[h * 128 + 32 * d0 + r32];
#pragma unroll
        for (int r = 0; r < 16; ++r) { const int il = 32 * qblk + crow(r, hi); const float fs = exp2f((float)(il + 1) * lg);
            float y0 = o[0][r] * fs, y1 = o[1][r] * fs, y2 = o[2][r] * fs, y3 = o[3][r] * fs;
            float s1 = (y0 + y1) + (y2 + y3), s2 = (y0 * y0 + y1 * y1) + (y2 * y2 + y3 * y3);
#pragma unroll
            for (int k = 1; k < 32; k <<= 1) { s1 += __shfl_xor(s1, k); s2 += __shfl_xor(s2, k); }
            const float mu = s1 * (1.0f / 128.0f); const float var = fmaxf(s2 * (1.0f / 128.0f) - mu * mu, 0.f); const float rs = 1.0f / sqrtf(var + EPS);
            const size_t m = (size_t)b * SEQ + (size_t)n * 64 + il;
            const bf16_t* rz = RZ + m * 1024 + h * 128 + r32; bf16_t* bo = BO + m * 1024 + h * 128 + r32;
            const float v0 = (y0 - mu) * rs * gain[0] * bf2f(rz[0]), v1 = (y1 - mu) * rs * gain[1] * bf2f(rz[32]), v2 = (y2 - mu) * rs * gain[2] * bf2f(rz[64]), v3 = (y3 - mu) * rs * gain[3] * bf2f(rz[96]);
            const float n0 = __shfl_xor(v0, 1), n1 = __shfl_xor(v1, 1), n2 = __shfl_xor(v2, 1), n3 = __shfl_xor(v3, 1);
            if ((r32 & 1) == 0) { *(unsigned*)(bo) = cvt_pk_bf16(v0, n0); *(unsigned*)(bo + 32) = cvt_pk_bf16(v1, n1); *(unsigned*)(bo + 64) = cvt_pk_bf16(v2, n2); *(unsigned*)(bo + 96) = cvt_pk_bf16(v3, n3); }
        }
        __syncthreads();
    }
}

__device__ __forceinline__ void p_index(const Args& a, Frame& F) {
    using namespace att;
    const bf16_t* IQ = (const bf16_t*)((const unsigned char*)a.out + DO_IQ); const bf16_t* IK = (const bf16_t*)(a.ws + WS_IK); const float* IW = (const float*)(a.ws + WS_IW);
    unsigned* MASK = (unsigned*)(a.ws + WS_MASK);
    LAS unsigned* hist = (LAS unsigned*)F.lds; LAS float* part = (LAS float*)(F.lds + 8192); LAS int* misc = (LAS int*)(F.lds + 8448); LAS float* miscf = (LAS float*)(F.lds + 8448);
    LAS float* cand = (LAS float*)(F.lds + 8704);
    constexpr int NBIN = 1024, CAP = 256;
    const int tid = F.tid, lane = F.lane, wid = F.wave, r32 = lane & 31, hi = lane >> 5;
    const float NINF = -__builtin_inff(), PINF = __builtin_inff();
    for (int round = 0; round * F.G < 1024; ++round) {
        const int j = round * F.G + ((round & 1) ? F.G - 1 - F.vcu : F.vcu);
        if (j >= 1024) continue;
        const int c = 63 - (j >> 4), sub = j & 15, b = sub >> 2, pg = sub & 3;
        const int m0 = b * SEQ + 64 * c, ntile = 2 * (c + 1), ntw = (c >> 2) + 1;
        const bool need_sel = c >= 4;
        for (int pp = 0; pp < 8; ++pp) {
            const int p = pg * 8 + pp;
            const int qrow = m0 + 2 * p + hi;
            bf16x8 af[4];
            { const int aq_ = (r32 >> 2) & 1, ah_ = (r32 & 3) + 4 * (r32 >> 3);
#pragma unroll
              for (int ks = 0; ks < 4; ++ks) af[ks] = *(const bf16x8*)(IQ + (size_t)(m0 + 2 * p + aq_) * 1024 + ah_ * 64 + 16 * ks + 8 * hi); }
            float wq[16];
#pragma unroll
            for (int q4 = 0; q4 < 4; ++q4) { const f32x4 w4 = *(const f32x4*)(IW + (size_t)qrow * 16 + 4 * q4); wq[4 * q4] = w4[0]; wq[4 * q4 + 1] = w4[1]; wq[4 * q4 + 2] = w4[2]; wq[4 * q4 + 3] = w4[3]; }
            float v[16];
#pragma unroll
            for (int tt = 0; tt < 16; ++tt) {
                v[tt] = NINF;
                if (tt < ntw) { const int t = wid + 8 * tt;
                    if (t < ntile) {
                        const bf16_t* kp = IK + (size_t)(b * SEQ + 32 * t + r32) * 64 + 8 * hi;
                        f32x16 cc = {};
#pragma unroll
                        for (int ks = 0; ks < 4; ++ks) cc = __builtin_amdgcn_mfma_f32_32x32x16_bf16(af[ks], *(const bf16x8*)(kp + 16 * ks), cc, 0, 0, 0);
                        float idx = 0.f;
#pragma unroll
                        for (int r = 0; r < 16; ++r) idx += fmaxf(cc[r], 0.f) * wq[r];
                        v[tt] = idx; } }
            }
            float T = NINF; int bstar = -1; bool ovf = false; float mn = 0.f, scale = 0.f;
            if (need_sel) {
                float lmn = PINF, lmx = NINF;
#pragma unroll
                for (int tt = 0; tt < 16; ++tt) { lmx = fmaxf(lmx, v[tt]); lmn = fminf(lmn, v[tt] == NINF ? PINF : v[tt]); }
#pragma unroll
                for (int k = 1; k < 32; k <<= 1) { lmx = fmaxf(lmx, __shfl_xor(lmx, k)); lmn = fminf(lmn, __shfl_xor(lmn, k)); }
                if (r32 == 0) { part[(wid * 2 + hi) * 2] = lmn; part[(wid * 2 + hi) * 2 + 1] = lmx; }
#pragma unroll
                for (int k = 0; k < 4; ++k) hist[tid + 512 * k] = 0u;
                if (tid < 2) misc[4 + tid] = 0;
                __syncthreads();
                float mx = NINF; mn = PINF;
#pragma unroll
                for (int w8 = 0; w8 < 8; ++w8) { mn = fminf(mn, part[(w8 * 2 + hi) * 2]); mx = fmaxf(mx, part[(w8 * 2 + hi) * 2 + 1]); }
                scale = (mx > mn) ? (float)NBIN / (mx - mn) : 0.f;
#pragma unroll
                for (int tt = 0; tt < 16; ++tt) if (v[tt] != NINF) { int bin = (int)((v[tt] - mn) * scale); bin = bin > NBIN - 1 ? NBIN - 1 : (bin < 0 ? 0 : bin);
                    __hip_atomic_fetch_add(hist + hi * NBIN + bin, 1u, __ATOMIC_RELAXED, __HIP_MEMORY_SCOPE_WORKGROUP); }
                __syncthreads();
                if (wid < 2) {
                    unsigned cnt[16]; unsigned sum = 0;
#pragma unroll
                    for (int k = 0; k < 16; ++k) { cnt[k] = hist[wid * NBIN + 16 * lane + k]; sum += cnt[k]; }
                    unsigned suf = sum;
#pragma unroll
                    for (int k = 1; k < 64; k <<= 1) { const unsigned o = __shfl_down(suf, k); if (lane + k < 64) suf += o; }
                    const unsigned above = suf - sum;
                    if (above < 256u && suf >= 256u) { unsigned run = above; int bs = 16 * lane; unsigned ca = above; bool found = false;
#pragma unroll
                        for (int k = 15; k >= 0; --k) { if (!found) { if (run + cnt[k] >= 256u) { bs = 16 * lane + k; ca = run; found = true; } else run += cnt[k]; } }
                        misc[wid] = bs; misc[2 + wid] = (int)ca; }
                }
                __syncthreads();
                bstar = misc[hi];
#pragma unroll
                for (int tt = 0; tt < 16; ++tt) if (v[tt] != NINF) { int bin = (int)((v[tt] - mn) * scale); bin = bin > NBIN - 1 ? NBIN - 1 : (bin < 0 ? 0 : bin);
                    if (bin == bstar) { const int pos = __hip_atomic_fetch_add(misc + 4 + hi, 1, __ATOMIC_RELAXED, __HIP_MEMORY_SCOPE_WORKGROUP); if (pos < CAP) cand[hi * CAP + pos] = v[tt]; } }
                __syncthreads();
                if (wid < 2) {
                    const int n = misc[4 + wid], kk = 256 - misc[2 + wid];
                    if (n <= CAP) {
                        float ci[4]; int rk[4];
#pragma unroll
                        for (int k = 0; k < 4; ++k) { const int i = lane + 64 * k; ci[k] = i < n ? cand[wid * CAP + i] : NINF; rk[k] = 0; }
                        for (int jj = 0; jj < n; ++jj) { const float cj = cand[wid * CAP + jj];
#pragma unroll
                            for (int k = 0; k < 4; ++k) rk[k] += (cj > ci[k] || (cj == ci[k] && jj < lane + 64 * k)) ? 1 : 0; }
#pragma unroll
                        for (int k = 0; k < 4; ++k) if (lane + 64 * k < n && rk[k] == kk - 1) miscf[6 + wid] = ci[k];
                    } else if (lane == 0) miscf[6 + wid] = NINF;
                    if (lane == 0) misc[8 + wid] = n > CAP ? 1 : 0;
                }
                __syncthreads();
                T = miscf[6 + hi]; ovf = misc[8 + hi] != 0;
            }
#pragma unroll
            for (int tt = 0; tt < 16; ++tt) if (tt < ntw) { const int t = wid + 8 * tt;
                bool sel = v[tt] != NINF;
                if (need_sel && sel) { if (ovf) { int bin = (int)((v[tt] - mn) * scale); bin = bin > NBIN - 1 ? NBIN - 1 : (bin < 0 ? 0 : bin); sel = bin >= bstar; } else sel = v[tt] >= T; }
                const unsigned long long bal = __ballot(sel);
                if (r32 == 0) MASK[(size_t)qrow * 128 + t] = hi ? (unsigned)(bal >> 32) : (unsigned)bal; }
        }
    }
}

__device__ __forceinline__ int t5_bucket(int rel) {
    const int n = rel < 0 ? -rel : rel; int bkt;
    if (n < 8) bkt = n; else { int k = (31 - __builtin_clz((unsigned)(n * n))) - 6; bkt = 8 + k; if (bkt > 15) bkt = 15; }
    return bkt + (rel > 0 ? 16 : 0);
}
__device__ __forceinline__ void attn_unit(const Args& a, Frame& F, int b, int h, int qb) {
    using namespace att;
    LAS unsigned char* Kl = F.lds; LAS unsigned char* Vl = F.lds + 32768;
    int tid = threadIdx.x; asm volatile("" : "+v"(tid));
    const int lane = tid & 63, wid = __builtin_amdgcn_readfirstlane(tid >> 6), r32 = lane & 31, hi = lane >> 5;
    LAS float* wsf = (LAS float*)(F.lds + 65536) + wid * 64; LAS float* BT = (LAS float*)(F.lds + 65536 + 2048);
    constexpr float LOG2E = 1.4426950408889634f, C2 = 0.08838834764831845f * LOG2E;
    const float NINF = -__builtin_inff();
    if (tid < 256) { const int rel = tid - 192; BT[tid] = (a.rel_bias[t5_bucket(rel) * 8 + h] - a.rel_bias[15 * 8 + h]) * LOG2E; }
    const size_t hb = ((size_t)(b * 8 + h) * SEQ) * 128;
    const bf16_t* AQh = (const bf16_t*)((const unsigned char*)a.out + DO_AQ) + hb; const bf16_t* AKh = (const bf16_t*)(a.ws + WS_AK) + hb; const bf16_t* AVh = (const bf16_t*)(a.ws + WS_AV) + hb;
    const int qpos = 256 * qb + 32 * wid + r32, cw = 4 * qb + (wid >> 1);
    const unsigned* MKb = (const unsigned*)(a.ws + WS_MASK) + (size_t)(b * SEQ + 256 * qb) * 128;
    const unsigned mko = (unsigned)(32 * wid + r32) * 128u;
    bf16x8 qr[8];
    { const unsigned qo = (unsigned)qpos * 128u + hi * 8u;
#pragma unroll
      for (int d0 = 0; d0 < 8; ++d0) qr[d0] = *(const bf16x8*)(AQh + qo + d0 * 16); }
    const int sr = tid >> 4, sc = (tid & 15) * 8, kws = KSWZ(sr, sc * 2), vs0 = v_st(sr, sc), vs1 = v_st(32 + sr, sc);
    const unsigned so = (unsigned)sr * 128u + sc;
    const int vb = (int)(uintptr_t)Vl + v_rd_base(lane);
    const int NT = 4 * (qb + 1);
    u32x4 k0, k1, v0, v1; u32x2 mw, mwn;
    { k0 = *(const u32x4*)(AKh + so); k1 = *(const u32x4*)(AKh + so + 32 * 128); v0 = *(const u32x4*)(AVh + so); v1 = *(const u32x4*)(AVh + so + 32 * 128);
      mw = *(const u32x2*)(MKb + mko);
      *(LAS u32x4*)(Kl + kws) = k0; *(LAS u32x4*)(Kl + kws + 32 * 256) = k1; *(LAS u32x4*)(Vl + vs0) = v0; *(LAS u32x4*)(Vl + vs1) = v1; }
    __syncthreads();
    float m_run = -1e30f, l_run = 0.f; f32x16 o[4] = {};
    mwn = mw;
#pragma unroll 1
    for (int t = 0; t < NT; ++t) {
        const int buf = t & 1;
        if (t + 1 < NT) { const bf16_t* kp = AKh + (size_t)(t + 1) * 8192; const bf16_t* vp = AVh + (size_t)(t + 1) * 8192;
            k0 = *(const u32x4*)(kp + so); k1 = *(const u32x4*)(kp + so + 32 * 128); v0 = *(const u32x4*)(vp + so); v1 = *(const u32x4*)(vp + so + 32 * 128);
            mwn = *(const u32x2*)(MKb + 2 * (t + 1) + mko); }
        f32x16 p0, p1;
        qkt(p0, p1, Kl + buf * 16384, r32, hi, qr);
        const unsigned w0s = mw.x >> (4 * hi), w1s = mw.y >> (4 * hi);
        const bool near = t >= cw - 2;
        const int relb = 64 * t + 4 * hi - qpos + 192;
        float tmax = NINF;
#pragma unroll
        for (int r = 0; r < 16; ++r) { const int bp = (r & 3) + 8 * (r >> 2);
            float z0 = p0[r] * C2, z1 = p1[r] * C2;
            if (near) { int i0 = relb + bp, i1 = i0 + 32; i0 = i0 < 0 ? 0 : (i0 > 255 ? 255 : i0); i1 = i1 < 0 ? 0 : (i1 > 255 ? 255 : i1); z0 += BT[i0]; z1 += BT[i1]; }
            z0 = ((w0s >> bp) & 1u) ? z0 : NINF; z1 = ((w1s >> bp) & 1u) ? z1 : NINF;
            p0[r] = z0; p1[r] = z1; tmax = fmaxf(tmax, fmaxf(z0, z1)); }
        tmax = fmaxf(tmax, __shfl_xor(tmax, 32));
        const float m_new = fmaxf(m_run, tmax), alpha = __builtin_amdgcn_exp2f(m_run - m_new); m_run = m_new;
        float rs = 0.f;
#pragma unroll
        for (int r = 0; r < 16; ++r) { p0[r] = __builtin_amdgcn_exp2f(p0[r] - m_new); p1[r] = __builtin_amdgcn_exp2f(p1[r] - m_new); rs += p0[r] + p1[r]; }
        rs += __shfl_xor(rs, 32);
        l_run = l_run * alpha + rs;
        if (__any(alpha < 1.f)) { if (hi == 0) wsf[r32] = alpha; LDS_WAIT();
#pragma unroll
            for (int d_ = 0; d_ < 4; ++d_)
#pragma unroll
                for (int r = 0; r < 16; ++r) o[d_][r] *= wsf[crow(r, hi)]; }
        bf16x8 pa0, pa1, pa2, pa3;
        pack_p(p0, p1, pa0, pa1, pa2, pa3);
        SBAR();
        if (buf == 0) pv_tile<0>(o, vb, pa0, pa1, pa2, pa3); else pv_tile<16384>(o, vb, pa0, pa1, pa2, pa3);
        if (t + 1 < NT) { LAS unsigned char* Kn = Kl + (buf ^ 1) * 16384; LAS unsigned char* Vn = Vl + (buf ^ 1) * 16384;
            *(LAS u32x4*)(Kn + kws) = k0; *(LAS u32x4*)(Kn + kws + 32 * 256) = k1; *(LAS u32x4*)(Vn + vs0) = v0; *(LAS u32x4*)(Vn + vs1) = v1; }
        mw = mwn;
        __syncthreads();
    }
    if (hi == 0) wsf[32 + r32] = l_run; LDS_WAIT();
    { int r32e = r32, hie = hi; asm volatile("" : "+v"(r32e), "+v"(hie));
      const size_t ub = ((size_t)b * SEQ + 256 * qb + 32 * wid) * 1024 + h * 128;
      const bf16_t* AZu = (const bf16_t*)(a.ws + WS_AZ) + ub; bf16_t* AOu = (bf16_t*)((unsigned char*)a.out + DO_AO) + ub;
#pragma unroll
      for (int r = 0; r < 16; ++r) { const float rl = 1.0f / wsf[32 + crow(r, hie)];
        const unsigned eo = (unsigned)crow(r, hie) * 1024u + r32e;
        const float x0 = o[0][r] * rl * bf2f(AZu[eo]), x1 = o[1][r] * rl * bf2f(AZu[eo + 32]), x2 = o[2][r] * rl * bf2f(AZu[eo + 64]), x3 = o[3][r] * rl * bf2f(AZu[eo + 96]);
        const float n0 = __shfl_xor(x0, 1), n1 = __shfl_xor(x1, 1), n2 = __shfl_xor(x2, 1), n3 = __shfl_xor(x3, 1);
        if ((r32e & 1) == 0) { *(unsigned*)(AOu + eo) = cvt_pk_bf16(x0, n0); *(unsigned*)(AOu + eo + 32) = cvt_pk_bf16(x1, n1); *(unsigned*)(AOu + eo + 64) = cvt_pk_bf16(x2, n2); *(unsigned*)(AOu + eo + 96) = cvt_pk_bf16(x3, n3); } } }
    __syncthreads();
}
__device__ __forceinline__ void p_attn(const Args& a, Frame& F) {
    for (int u2 = F.vcu; u2 < 256; u2 += F.G) { const int bh = u2 >> 3, s = u2 & 7;
        for (int pass = 0; pass < 2; ++pass) attn_unit(a, F, bh >> 3, bh & 7, pass ? 15 - s : s); }
}

constexpr int NPHASES = 12;
__global__ void __launch_bounds__(NTHREADS, 2) fwd_kernel(Args args) {
    extern __shared__ __attribute__((aligned(16))) unsigned char lds_raw[];
    cg::grid_group grid = cg::this_grid();
    Frame F;
    F.lds = (LAS unsigned char*)lds_raw;
    frame_ids(F);
    F.G = gridDim.x; { const int bx = blockIdx.x; F.vcu = (F.G % 8 == 0) ? (bx % 8) * (F.G / 8) + bx / 8 : bx; }
    const int lo = args.ph_lo, hi = args.ph_hi;
    unsigned char* ws = args.ws;
#define IN(k) (lo <= (k) && (k) < hi)
#define SEAM(k) do { if (IN(k) && IN((k) + 1)) { __threadfence(); grid.sync(); } } while (0)
    if (IN(0)) { frame_ids(F); p0_prologue(args, F); }
    SEAM(0);
    if (IN(1)) {
        pg8::Gemm g{(const bf16_t*)((unsigned char*)args.out + DO_H), (const bf16_t*)(ws + WS_WIN), MTOK, NWIN_PAD, DM}; pg8::StaticOrder S; S.init(MTOK, NWIN_PAD, F.G, (int)blockIdx.x);
        EpiProj E{ws, (unsigned char*)args.out};
        pg8::gemm_phase<EpiProj, pg8::StaticOrder, true>(F.lds, g, S, E);
    }
    SEAM(1);
    if (IN(2)) { frame_ids(F); p_ret_kv(args, F); }
    SEAM(2);
    if (IN(3)) { frame_ids(F); p_ret_scan(args, F); }
    SEAM(3);
    if (IN(4)) { frame_ids(F); p_ret_out(args, F); }
    SEAM(4);
    if (IN(5)) { frame_ids(F); p_index(args, F); }
    SEAM(5);
    if (IN(6)) { frame_ids(F); p_attn(args, F); }
    SEAM(6);
    if (IN(7)) {
        pg8::Gemm g{(const bf16_t*)((unsigned char*)args.out + DO_AO), (const bf16_t*)(ws + WS_WA), MTOK, DM, 1024}; pg8::StaticOrder S; S.init(MTOK, DM, F.G, (int)blockIdx.x);
        EpiMerge<false> E{nullptr, (const bf16_t*)(ws + WS_GA), (bf16_t*)(ws + WS_T)};
        pg8::gemm_phase<EpiMerge<false>, pg8::StaticOrder, true>(F.lds, g, S, E);
    }
    SEAM(7);
    if (IN(8)) {
        pg8::Gemm g{(const bf16_t*)(ws + WS_BO), (const bf16_t*)(ws + WS_WB), MTOK, DM, 1024}; pg8::StaticOrder S; S.init(MTOK, DM, F.G, (int)blockIdx.x);
        EpiMerge<true> E{(const bf16_t*)(ws + WS_T), (const bf16_t*)(ws + WS_GB), (bf16_t*)(ws + WS_MG)};
        pg8::gemm_phase<EpiMerge<true>, pg8::StaticOrder, true>(F.lds, g, S, E);
    }
    SEAM(8);
    if (IN(9)) {
        { pg8::Gemm g{(const bf16_t*)(ws + WS_MG), (const bf16_t*)(ws + WS_WO), MTOK, DM, DM}; pg8::StaticOrder S; S.init(MTOK, DM, F.G, (int)blockIdx.x);
          EpiResid E{args.x, args.out, (bf16_t*)(ws + WS_RB)};
          pg8::gemm_phase<EpiResid, pg8::StaticOrder, true>(F.lds, g, S, E); }
        { pg8::Gemm g{(const bf16_t*)(ws + WS_PB), (const bf16_t*)(ws + WS_WPLE), MTOK, DM, PLE}; pg8::StaticOrder S; S.init(MTOK, DM, F.G, (int)blockIdx.x);
          EpiPlainBf16<DM> E{(bf16_t*)(ws + WS_U)};
          pg8::gemm_phase<EpiPlainBf16<DM>, pg8::StaticOrder, true>(F.lds, g, S, E); }
    }
    SEAM(9);
    if (IN(10)) {
        pg8::Gemm g{(const bf16_t*)(ws + WS_RB), (const bf16_t*)(ws + WS_WPG), MTOK, DM, DM}; pg8::StaticOrder S; S.init(MTOK, DM, F.G, (int)blockIdx.x);
        EpiGate E{args.out, (const bf16_t*)(ws + WS_U), args.out};
        pg8::gemm_phase<EpiGate, pg8::StaticOrder, true>(F.lds, g, S, E);
    }
    SEAM(10);
    if (IN(11)) { frame_ids(F); p_final_norm(args, F); }
#undef IN
#undef SEAM
}

#ifndef ONE_LAUNCH
#define ONE_LAUNCH 1
#endif
extern "C" void kernel_launch(void* const* d_in, const int* in_sizes, int n_in, void* d_out, int out_size, void* d_ws, size_t ws_size, hipStream_t stream) {
    static int grid = 0;
    if (grid == 0) {
        int dev = 0, cus = 0, per_cu = 0;
        (void)hipGetDevice(&dev);
        if (hipDeviceGetAttribute(&cus, hipDeviceAttributeMultiprocessorCount, dev) != hipSuccess || cus <= 0) cus = 256;
        (void)hipFuncSetAttribute((const void*)fwd_kernel, hipFuncAttributeMaxDynamicSharedMemorySize, LDS_BYTES);
        if (hipOccupancyMaxActiveBlocksPerMultiprocessor(&per_cu, (const void*)fwd_kernel, NTHREADS, LDS_BYTES) != hipSuccess || per_cu < 1) per_cu = 1;
        (void)hipGetLastError();
        grid = cus * 1;
        if (ws_size < WS_END) fprintf(stderr, "kernel_launch: workspace too small (%zu < %zu)\n", ws_size, (size_t)WS_END);
    }
    Args a{};
    a.x = (const float*)d_in[0]; a.p = (const float*)d_in[1]; a.pos = (const int*)d_in[2]; a.w_in = (const float*)d_in[3]; a.norm_gain = (const float*)d_in[4];
    a.w_a = (const float*)d_in[5]; a.w_b = (const float*)d_in[6]; a.w_o = (const float*)d_in[7]; a.gn_gain = (const float*)d_in[8]; a.w_ple = (const float*)d_in[9];
    a.w_pg = (const float*)d_in[10]; a.rel_bias = (const float*)d_in[11]; a.final_gain = (const float*)d_in[12];
    a.out = (float*)d_out; a.ws = (unsigned char*)d_ws; a.coop = 1; a.pad = 0;
#if ONE_LAUNCH
    a.ph_lo = 0; a.ph_hi = NPHASES;
    { void* kargs[] = {&a}; hipError_t e = hipLaunchCooperativeKernel((const void*)fwd_kernel, dim3(grid), dim3(NTHREADS), kargs, LDS_BYTES, stream);
      if (e != hipSuccess) fprintf(stderr, "cooperative launch failed: %s (grid %d)\n", hipGetErrorString(e), grid); }
#else
    for (int ph = 0; ph < NPHASES; ++ph) {
        a.ph_lo = ph; a.ph_hi = ph + 1;
        void* kargs[] = {&a}; hipError_t e = hipLaunchCooperativeKernel((const void*)fwd_kernel, dim3(grid), dim3(NTHREADS), kargs, LDS_BYTES, stream);
        if (e != hipSuccess) fprintf(stderr, "cooperative launch %d failed: %s (grid %d)\n", ph, hipGetErrorString(e), grid);
    }
#endif
}
```

```cpp
#include <hip/hip_runtime.h>
#include <hip/hip_cooperative_groups.h>
#include <cstdio>
#include <cstdint>
namespace cg = cooperative_groups;

#define LAS __attribute__((address_space(3)))
typedef unsigned short bf16_t;
typedef short bf16x8 __attribute__((ext_vector_type(8)));
typedef float f32x4 __attribute__((ext_vector_type(4)));
typedef float f32x2 __attribute__((ext_vector_type(2)));
typedef unsigned u32x4 __attribute__((ext_vector_type(4)));
typedef unsigned u32x2 __attribute__((ext_vector_type(2)));

constexpr int DM = 2048, NB = 4, SEQ = 4096, MTOK = NB * SEQ, CHUNK = 64, PLE = 256;
constexpr int NWIN = 13392, NWIN_PAD = 13568;
constexpr float EPS = 1e-6f;

constexpr size_t MiB = 1u << 20;
constexpr size_t WS_CTL = 0;
constexpr size_t WS_WIN = 1 * MiB;
constexpr size_t WS_WA = 54 * MiB;
constexpr size_t WS_WB = 58 * MiB;
constexpr size_t WS_WO = 62 * MiB;
constexpr size_t WS_WPG = 70 * MiB;
constexpr size_t WS_WPLE = 78 * MiB;
constexpr size_t WS_PB = 79 * MiB;
constexpr size_t WS_ROPE = 87 * MiB;
constexpr size_t WS_IK = 95 * MiB;
constexpr size_t WS_IW = 97 * MiB;
constexpr size_t WS_MASK = 98 * MiB;
constexpr size_t WS_AK = 106 * MiB;
constexpr size_t WS_AV = 138 * MiB;
constexpr size_t WS_AZ = 170 * MiB;
constexpr size_t WS_RQ = 202 * MiB;
constexpr size_t WS_RK = 234 * MiB;
constexpr size_t WS_RV = 266 * MiB;
constexpr size_t WS_RZ = 298 * MiB;
constexpr size_t WS_GA = 330 * MiB;
constexpr size_t WS_GB = 394 * MiB;
constexpr size_t WS_BO = 458 * MiB;
constexpr size_t WS_END = 490 * MiB;
constexpr size_t DO_H = 0, DO_KVT = 0, DO_IQ = 64 * MiB, DO_AQ = 96 * MiB, DO_AO = DO_IQ;
constexpr size_t WS_T = WS_AK, WS_MG = WS_RK, WS_RB = WS_GA, WS_U = WS_GB;

typedef __bf16 bf16x2_t __attribute__((ext_vector_type(2)));
__device__ __forceinline__ unsigned cvt_pk_bf16(float lo, float hi) { f32x2 v = {lo, hi}; bf16x2_t b = __builtin_convertvector(v, bf16x2_t); return __builtin_bit_cast(unsigned, b); }
__device__ __forceinline__ unsigned f2bf(float f) { unsigned u = __builtin_bit_cast(unsigned, f); return (u + 0x7fffu + ((u >> 16) & 1u)) >> 16; }
__device__ __forceinline__ unsigned pk2(float lo, float hi) { return f2bf(lo) | (f2bf(hi) << 16); }
__device__ __forceinline__ float bf2f(unsigned short h) { return __builtin_bit_cast(float, (unsigned)h << 16); }
__device__ __forceinline__ float sigmoidf_(float z) { return 1.0f / (1.0f + __expf(-z)); }
__device__ __forceinline__ float siluf_(float z) { return z / (1.0f + __expf(-z)); }
__device__ __forceinline__ float wave_sum(float v) {
#pragma unroll
    for (int o = 1; o < 64; o <<= 1) v += __shfl_xor(v, o);
    return v;
}
#define LDS_WAIT() asm volatile("s_waitcnt lgkmcnt(0)" ::: "memory")

namespace pg8 {
constexpr int BM = 256, BK = 64, HALF = 128, HTB = HALF * BK * 2, STAGE_BYTES = 8 * HTB, NXCD = 8, WGM = 8;
__host__ __device__ __forceinline__ int lds_byte(int r, int c) { const int st = (r >> 4) * 2 + (c >> 5), rr = r & 15, cc = c & 31, ob = rr * 64 + cc * 2; return st * 1024 + (ob ^ (((ob >> 9) & 1) << 5)); }
__host__ __device__ __forceinline__ void stage_rc(int b, int& R, int& C) { const int st = b / 1024, sb = b % 1024, swz = sb ^ (((sb >> 9) & 1) << 5); R = (st >> 1) * 16 + swz / 64; C = (st & 1) * 32 + (swz % 64) / 2; }
__host__ __device__ __forceinline__ int perm32(int rho) { const int n = rho >> 4, i = rho & 15; return 8 * (i >> 2) + 4 * n + (i & 3); }
struct Unit { int pm, pn; };
struct Gemm { const bf16_t* A; const bf16_t* Bt; int M, N, K; };
struct StaticOrder {
    int nM, nN, nwg, G, c;
    __host__ __device__ void init(int M, int N, int G_, int c_) { nM = M / BM; nN = N / BM; nwg = nM * nN; G = G_; c = c_; }
    __host__ __device__ bool next(int i, Unit& u) const {
        const long L = (long)i * G + c; if (L >= nwg) return false;
        int wgid = (int)L; { const int q = nwg / NXCD, r = nwg % NXCD, xcd = wgid % NXCD, off = wgid / NXCD; wgid = (xcd < r ? xcd * (q + 1) : r * (q + 1) + (xcd - r) * q) + off; }
        const int nig = WGM * nN, gid = wgid / nig, fm = gid * WGM, gsz = (nM - fm) < WGM ? (nM - fm) : WGM;
        u.pm = fm + ((wgid % nig) % gsz); u.pn = (wgid % nig) / gsz; return true;
    }
    __device__ __forceinline__ void a_ready(const Unit&) const {}
    __device__ __forceinline__ void done(const Unit&) const {}
};

template <class Epi, class Sched, bool ALIGN_EPI = true>
__device__ __forceinline__ void gemm_phase(LAS unsigned char* lds, const Gemm g, const Sched& S, const Epi& E) {
    const int tid = threadIdx.x, wid = __builtin_amdgcn_readfirstlane(tid >> 6), lane = tid & 63, wr = wid >> 2, wc = wid & 3, fr = lane & 15, fq = lane >> 4;
    const int K = g.K, nt = K / BK;
    unsigned voffA[2], voffB[2];
#pragma unroll
    for (int i = 0; i < 2; ++i) { int R, C; stage_rc(tid * 16 + i * 8192, R, C); const int Rb = Epi::PERM ? ((R & ~31) + perm32(R & 31)) : R;
        voffA[i] = (unsigned)(R * K + C) * 2u; voffB[i] = (unsigned)(Rb * K + C) * 2u; }
    const size_t kstep = (size_t)(BK * 2);
    const size_t hstep = (size_t)HALF * K * 2;
    const size_t tstep = 2 * hstep;
    const unsigned ldsw = (unsigned)wid * 1024u;
    const int aoff = lds_byte(wr * 64 + fr, fq * 8), boff = lds_byte(wc * 32 + fr, fq * 8);
#define PG8_SA(b, h) (((b) * 2 + (h)) * HTB)
#define PG8_SB(b, h) ((4 + (b) * 2 + (h)) * HTB)
#define PG8_STAGE(bufoff, gbase, voff) do { _Pragma("unroll") for (int _i = 0; _i < 2; ++_i) \
        __builtin_amdgcn_global_load_lds((const unsigned*)((const char*)(gbase) + (voff)[_i]), (LAS unsigned*)(lds + (bufoff) + ldsw + _i * 8192), 16, 0, 0); } while (0)
#define PG8_LDA(dst, b, h) do { _Pragma("unroll") for (int m = 0; m < 4; ++m) _Pragma("unroll") for (int k = 0; k < 2; ++k) dst[m][k] = *(const LAS bf16x8*)(lds + PG8_SA(b, h) + aoff + m * 2048 + k * 1024); } while (0)
#define PG8_LDB(dst, b, h) do { _Pragma("unroll") for (int n = 0; n < 2; ++n) _Pragma("unroll") for (int k = 0; k < 2; ++k) dst[n][k] = *(const LAS bf16x8*)(lds + PG8_SB(b, h) + boff + n * 2048 + k * 1024); } while (0)
#define PG8_MMA(ai, bj, At, Bt) do { __builtin_amdgcn_s_setprio(1); _Pragma("unroll") for (int m = 0; m < 4; ++m) _Pragma("unroll") for (int n = 0; n < 2; ++n) _Pragma("unroll") for (int k = 0; k < 2; ++k) \
        acc[ai][bj][m][n] = __builtin_amdgcn_mfma_f32_16x16x32_bf16(Bt[n][k], At[m][k], acc[ai][bj][m][n], 0, 0, 0); __builtin_amdgcn_s_setprio(0); } while (0)
#define PG8_WAIT_V(n) asm volatile("s_waitcnt vmcnt(" #n ")" ::: "memory")
#define PG8_WAIT_L(n) asm volatile("s_waitcnt lgkmcnt(" #n ")" ::: "memory")
#define PG8_BAR __builtin_amdgcn_s_barrier()
#define PG8_SCHED __builtin_amdgcn_sched_barrier(0)
    Unit cur, nxt; int ui = 0;
    if (!S.next(0, cur)) return;
    f32x4 acc[2][2][4][2];
#pragma unroll
    for (int a = 0; a < 2; ++a)
#pragma unroll
        for (int b = 0; b < 2; ++b)
#pragma unroll
            for (int m = 0; m < 4; ++m)
#pragma unroll
                for (int n = 0; n < 2; ++n) acc[a][b][m][n] = (f32x4){0.f, 0.f, 0.f, 0.f};
    bf16x8 At[4][2], B0[2][2], B1[2][2];
    const char* cA = (const char*)g.A + (size_t)cur.pm * tstep; const char* cB = (const char*)g.Bt + (size_t)cur.pn * tstep;
    S.a_ready(cur);
    PG8_STAGE(PG8_SB(0, 0), cB, voffB); PG8_STAGE(PG8_SB(0, 1), cB + hstep, voffB); PG8_STAGE(PG8_SA(0, 0), cA, voffA); PG8_STAGE(PG8_SA(0, 1), cA + hstep, voffA);
    if (wr == 1) PG8_BAR;
    PG8_WAIT_V(2); PG8_BAR;
    PG8_STAGE(PG8_SB(1, 0), cB + kstep, voffB); PG8_STAGE(PG8_SA(1, 0), cA + kstep, voffA); PG8_STAGE(PG8_SB(1, 1), cB + hstep + kstep, voffB);
    PG8_WAIT_V(6); PG8_BAR;
    for (;;) {
        const bool has_next = S.next(ui + 1, nxt);
        const char* nA = has_next ? (const char*)g.A + (size_t)nxt.pm * tstep : cA; const char* nB = has_next ? (const char*)g.Bt + (size_t)nxt.pn * tstep : cB;
#pragma unroll 1
        for (int t = 0; t < nt; t += 2) {
            const bool last = (t == nt - 2);
            const char* a1 = cA + (size_t)(t + 1) * kstep;
            const char* a2 = last ? nA : cA + (size_t)(t + 2) * kstep; const char* b2 = last ? nB : cB + (size_t)(t + 2) * kstep;
            const char* a3 = a2 + kstep; const char* b3 = b2 + kstep;
            if (last && has_next) S.a_ready(nxt);
            PG8_LDB(B0, 0, 0); PG8_LDB(B1, 0, 1); PG8_SCHED; PG8_LDA(At, 0, 0); PG8_STAGE(PG8_SA(1, 1), a1 + hstep, voffA);
            PG8_WAIT_V(8); PG8_WAIT_L(0); PG8_BAR; PG8_MMA(0, 0, At, B0); PG8_MMA(0, 1, At, B1); PG8_BAR; PG8_SCHED;
            PG8_LDA(At, 0, 1); PG8_STAGE(PG8_SB(0, 0), b2, voffB); PG8_STAGE(PG8_SB(0, 1), b2 + hstep, voffB); PG8_STAGE(PG8_SA(0, 0), a2, voffA);
            PG8_WAIT_V(8); PG8_WAIT_L(0); PG8_BAR; PG8_MMA(1, 0, At, B0); PG8_MMA(1, 1, At, B1); PG8_BAR; PG8_SCHED;
            PG8_LDB(B0, 1, 0); PG8_LDB(B1, 1, 1); PG8_SCHED; PG8_LDA(At, 1, 0); PG8_STAGE(PG8_SA(0, 1), a2 + hstep, voffA);
            PG8_WAIT_V(8); PG8_WAIT_L(0); PG8_BAR; PG8_MMA(0, 0, At, B0); PG8_MMA(0, 1, At, B1); PG8_BAR; PG8_SCHED;
            PG8_LDA(At, 1, 1); PG8_STAGE(PG8_SB(1, 0), b3, voffB); PG8_STAGE(PG8_SB(1, 1), b3 + hstep, voffB); PG8_STAGE(PG8_SA(1, 0), a3, voffA);
            PG8_WAIT_V(8); PG8_WAIT_L(0); PG8_BAR; PG8_MMA(1, 0, At, B0); PG8_MMA(1, 1, At, B1); PG8_BAR; PG8_SCHED;
        }
        if constexpr (ALIGN_EPI) { if (wr == 0) PG8_BAR; }
        E(acc, cur, wr, wc, fr, fq);
        if (!has_next) break;
#pragma unroll
        for (int a = 0; a < 2; ++a)
#pragma unroll
            for (int b = 0; b < 2; ++b)
#pragma unroll
                for (int m = 0; m < 4; ++m)
#pragma unroll
                    for (int n = 0; n < 2; ++n) acc[a][b][m][n] = (f32x4){0.f, 0.f, 0.f, 0.f};
        cur = nxt; cA = nA; cB = nB; ++ui;
        if constexpr (ALIGN_EPI) { if (wr == 1) PG8_BAR; }
    }
    PG8_WAIT_V(0);
    if constexpr (!ALIGN_EPI) { if (wr == 0) PG8_BAR; }
    PG8_BAR;
#undef PG8_SA
#undef PG8_SB
#undef PG8_STAGE
#undef PG8_LDA
#undef PG8_LDB
#undef PG8_MMA
#undef PG8_WAIT_V
#undef PG8_WAIT_L
#undef PG8_BAR
#undef PG8_SCHED
}
}

typedef f32x4 AccT[2][2][4][2];
template <class Fn> __device__ __forceinline__ void epi_foreach(const AccT& acc, const pg8::Unit& u, int wr, int wc, int fr, int fq, Fn&& f) {
    asm volatile("" : "+v"(fr), "+v"(fq));
#pragma unroll
    for (int ai = 0; ai < 2; ++ai)
#pragma unroll
        for (int m = 0; m < 4; ++m)
#pragma unroll
            for (int bj = 0; bj < 2; ++bj) {
                f(u.pm * 256 + ai * 128 + wr * 64 + m * 16 + fr, u.pn * 256 + bj * 128 + wc * 32 + 8 * fq, acc[ai][bj][m][0], acc[ai][bj][m][1]);
                asm volatile("" ::: "memory"); }
}

template <int ldc> struct EpiPlainBf16 {
    static constexpr bool PERM = true;
    bf16_t* O;
    __device__ __forceinline__ void operator()(const AccT& acc, const pg8::Unit& u, int wr, int wc, int fr, int fq) const {
        epi_foreach(acc, u, wr, wc, fr, fq, [&](int row, int col, f32x4 v0, f32x4 v1) {
            u32x4 w; w.x = cvt_pk_bf16(v0[0], v0[1]); w.y = cvt_pk_bf16(v0[2], v0[3]); w.z = cvt_pk_bf16(v1[0], v1[1]); w.w = cvt_pk_bf16(v1[2], v1[3]);
            *(u32x4*)(O + (size_t)row * ldc + col) = w; });
    }
};
struct EpiGate {
    static constexpr bool PERM = true;
    const float* R; const bf16_t* U; float* O;
    __device__ __forceinline__ void operator()(const AccT& acc, const pg8::Unit& u, int wr, int wc, int fr, int fq) const {
        epi_foreach(acc, u, wr, wc, fr, fq, [&](int row, int col, f32x4 v0, f32x4 v1) {
            const size_t off = (size_t)row * DM + col;
            const f32x4 r0 = *(const f32x4*)(R + off), r1 = *(const f32x4*)(R + off + 4);
            const u32x4 uu = *(const u32x4*)(U + off);
            f32x4 o0, o1;
            o0[0] = r0[0] + bf2f((unsigned short)(uu.x & 0xffff)) * sigmoidf_(v0[0]); o0[1] = r0[1] + bf2f((unsigned short)(uu.x >> 16)) * sigmoidf_(v0[1]);
            o0[2] = r0[2] + bf2f((unsigned short)(uu.y & 0xffff)) * sigmoidf_(v0[2]); o0[3] = r0[3] + bf2f((unsigned short)(uu.y >> 16)) * sigmoidf_(v0[3]);
            o1[0] = r1[0] + bf2f((unsigned short)(uu.z & 0xffff)) * sigmoidf_(v1[0]); o1[1] = r1[1] + bf2f((unsigned short)(uu.z >> 16)) * sigmoidf_(v1[1]);
            o1[2] = r1[2] + bf2f((unsigned short)(uu.w & 0xffff)) * sigmoidf_(v1[2]); o1[3] = r1[3] + bf2f((unsigned short)(uu.w >> 16)) * sigmoidf_(v1[3]);
            *(f32x4*)(O + off) = o0; *(f32x4*)(O + off + 4) = o1; });
    }
};

template <bool HAS_T> struct EpiMerge {
    static constexpr bool PERM = true;
    const bf16_t* T; const bf16_t* Gt; bf16_t* O;
    __device__ __forceinline__ void operator()(const AccT& acc, const pg8::Unit& u, int wr, int wc, int fr, int fq) const {
        epi_foreach(acc, u, wr, wc, fr, fq, [&](int row, int col, f32x4 v0, f32x4 v1) {
            const size_t off = (size_t)row * DM + col;
            const u32x4 gg = *(const u32x4*)(Gt + off);
            float o[8];
            o[0] = bf2f((unsigned short)(gg.x & 0xffff)) * v0[0]; o[1] = bf2f((unsigned short)(gg.x >> 16)) * v0[1];
            o[2] = bf2f((unsigned short)(gg.y & 0xffff)) * v0[2]; o[3] = bf2f((unsigned short)(gg.y >> 16)) * v0[3];
            o[4] = bf2f((unsigned short)(gg.z & 0xffff)) * v1[0]; o[5] = bf2f((unsigned short)(gg.z >> 16)) * v1[1];
            o[6] = bf2f((unsigned short)(gg.w & 0xffff)) * v1[2]; o[7] = bf2f((unsigned short)(gg.w >> 16)) * v1[3];
            if constexpr (HAS_T) { const u32x4 tt = *(const u32x4*)(T + off);
                o[0] += bf2f((unsigned short)(tt.x & 0xffff)); o[1] += bf2f((unsigned short)(tt.x >> 16)); o[2] += bf2f((unsigned short)(tt.y & 0xffff)); o[3] += bf2f((unsigned short)(tt.y >> 16));
                o[4] += bf2f((unsigned short)(tt.z & 0xffff)); o[5] += bf2f((unsigned short)(tt.z >> 16)); o[6] += bf2f((unsigned short)(tt.w & 0xffff)); o[7] += bf2f((unsigned short)(tt.w >> 16)); }
            u32x4 w; w.x = cvt_pk_bf16(o[0], o[1]); w.y = cvt_pk_bf16(o[2], o[3]); w.z = cvt_pk_bf16(o[4], o[5]); w.w = cvt_pk_bf16(o[6], o[7]);
            *(u32x4*)(O + off) = w; });
    }
};
struct EpiResid {
    static constexpr bool PERM = true;
    const float* X; float* O32; bf16_t* O16;
    __device__ __forceinline__ void operator()(const AccT& acc, const pg8::Unit& u, int wr, int wc, int fr, int fq) const {
        epi_foreach(acc, u, wr, wc, fr, fq, [&](int row, int col, f32x4 v0, f32x4 v1) {
            const size_t off = (size_t)row * DM + col;
            const f32x4 r0 = *(const f32x4*)(X + off) + v0, r1 = *(const f32x4*)(X + off + 4) + v1;
            *(f32x4*)(O32 + off) = r0; *(f32x4*)(O32 + off + 4) = r1;
            u32x4 w; w.x = cvt_pk_bf16(r0[0], r0[1]); w.y = cvt_pk_bf16(r0[2], r0[3]); w.z = cvt_pk_bf16(r1[0], r1[1]); w.w = cvt_pk_bf16(r1[2], r1[3]);
            *(u32x4*)(O16 + off) = w; });
    }
};
__device__ __forceinline__ size_t hm_off(int row, int hh, int d) { return ((size_t)(row & ~4095) * 8 + (size_t)hh * 4096 + (size_t)(row & 4095)) * 128 + d; }
__device__ __forceinline__ u32x4 pack8f(const float* o) { u32x4 w; w.x = cvt_pk_bf16(o[0], o[1]); w.y = cvt_pk_bf16(o[2], o[3]); w.z = cvt_pk_bf16(o[4], o[5]); w.w = cvt_pk_bf16(o[6], o[7]); return w; }
struct EpiProj {
    static constexpr bool PERM = true;
    unsigned char* ws; unsigned char* dout;
    __device__ __forceinline__ void operator()(const AccT& acc, const pg8::Unit& u, int wr, int wc, int fr, int fq) const {
        const int pn = u.pn;
        if (pn < 12 || (pn >= 29 && pn < 33)) {
            bf16_t* base; int tl;
            if (pn < 4) { base = (bf16_t*)(dout + DO_AQ); tl = pn; } else if (pn < 8) { base = (bf16_t*)(ws + WS_AK); tl = pn - 4; }
            else if (pn < 12) { base = (bf16_t*)(ws + WS_AV); tl = pn - 8; } else { base = (bf16_t*)(ws + WS_RV); tl = pn - 29; }
            epi_foreach(acc, u, wr, wc, fr, fq, [&](int row, int col, f32x4 v0, f32x4 v1) {
                const int colt = col & 255; const float o[8] = {v0[0], v0[1], v0[2], v0[3], v1[0], v1[1], v1[2], v1[3]};
                *(u32x4*)(base + hm_off(row, 2 * tl + (colt >> 7), colt & 127)) = pack8f(o); });
        } else if (pn == 20) {
            asm volatile("" : "+v"(fr), "+v"(fq));
            if (wc == 0) {
                bf16_t* IK = (bf16_t*)(ws + WS_IK);
#pragma unroll
                for (int ai = 0; ai < 2; ++ai)
#pragma unroll
                    for (int m = 0; m < 4; ++m) {
                        const int row = u.pm * 256 + ai * 128 + wr * 64 + m * 16 + fr;
                        float x[16];
#pragma unroll
                        for (int j = 0; j < 4; ++j) { x[j] = acc[ai][0][m][0][j]; x[4 + j] = acc[ai][0][m][1][j]; x[8 + j] = acc[ai][1][m][0][j]; x[12 + j] = acc[ai][1][m][1][j]; }
                        float sum = 0.f;
#pragma unroll
                        for (int j = 0; j < 16; ++j) sum += x[j];
                        sum += __shfl_xor(sum, 16); sum += __shfl_xor(sum, 32);
                        const float mu = sum * (1.0f / 64.0f); float q = 0.f;
#pragma unroll
                        for (int j = 0; j < 16; ++j) { x[j] -= mu; q += x[j] * x[j]; }
                        q += __shfl_xor(q, 16); q += __shfl_xor(q, 32);
                        const float rs = 1.0f / sqrtf(q * (1.0f / 64.0f) + EPS);
#pragma unroll
                        for (int j = 0; j < 16; ++j) x[j] *= rs;
                        *(u32x4*)(IK + (size_t)row * 64 + 8 * fq) = pack8f(x); *(u32x4*)(IK + (size_t)row * 64 + 32 + 8 * fq) = pack8f(x + 8);
                        asm volatile("" ::: "memory");
                    }
            } else if (wc == 1) {
                float* IW = (float*)(ws + WS_IW);
                if (fq < 2) {
#pragma unroll
                    for (int ai = 0; ai < 2; ++ai)
#pragma unroll
                        for (int m = 0; m < 4; ++m) {
                            const int row = u.pm * 256 + ai * 128 + wr * 64 + m * 16 + fr;
                            *(f32x4*)(IW + (size_t)row * 16 + 8 * fq) = acc[ai][0][m][0] * 0.25f; *(f32x4*)(IW + (size_t)row * 16 + 8 * fq + 4) = acc[ai][0][m][1] * 0.25f;
                        }
                }
            }
        } else if (pn >= 21 && pn < 29) {
            asm volatile("" : "+v"(fr), "+v"(fq));
            const bool isk = pn >= 25; const int tl = isk ? pn - 25 : pn - 21; const float sc = isk ? 0.08838834764831845f : 1.0f;
            bf16_t* base = (bf16_t*)(ws + (isk ? WS_RK : WS_RQ)); const f32x4* rope = (const f32x4*)(ws + WS_ROPE);
            const int hh = 2 * tl + (wc >> 1), d0 = 32 * (wc & 1) + 8 * fq;
#pragma unroll
            for (int ai = 0; ai < 2; ++ai)
#pragma unroll
                for (int m = 0; m < 4; ++m) {
                    const int row = u.pm * 256 + ai * 128 + wr * 64 + m * 16 + fr;
                    const f32x4* rp = rope + ((size_t)row * 64 + d0) / 2;
                    float x1[8], x2[8], y1[8], y2[8];
#pragma unroll
                    for (int j = 0; j < 4; ++j) { x1[j] = acc[ai][0][m][0][j]; x1[4 + j] = acc[ai][0][m][1][j]; x2[j] = acc[ai][1][m][0][j]; x2[4 + j] = acc[ai][1][m][1][j]; }
#pragma unroll
                    for (int jj = 0; jj < 4; ++jj) { const f32x4 cs = rp[jj];
                        y1[2 * jj] = (x1[2 * jj] * cs[0] - x2[2 * jj] * cs[1]) * sc; y2[2 * jj] = (x1[2 * jj] * cs[1] + x2[2 * jj] * cs[0]) * sc;
                        y1[2 * jj + 1] = (x1[2 * jj + 1] * cs[2] - x2[2 * jj + 1] * cs[3]) * sc; y2[2 * jj + 1] = (x1[2 * jj + 1] * cs[3] + x2[2 * jj + 1] * cs[2]) * sc; }
                    const size_t o = hm_off(row, hh, d0);
                    *(u32x4*)(base + o) = pack8f(y1); *(u32x4*)(base + o + 64) = pack8f(y2);
                    asm volatile("" ::: "memory");
                }
        } else {
            bf16_t* base; int ld, c0, act;
            if (pn < 16) { base = (bf16_t*)(ws + WS_AZ); ld = 1024; c0 = (pn - 12) * 256; act = 0; }
            else if (pn < 20) { base = (bf16_t*)(dout + DO_IQ); ld = 1024; c0 = (pn - 16) * 256; act = 1; }
            else if (pn < 37) { base = (bf16_t*)(ws + WS_RZ); ld = 1024; c0 = (pn - 33) * 256; act = 0; }
            else if (pn < 45) { base = (bf16_t*)(ws + WS_GA); ld = 2048; c0 = (pn - 37) * 256; act = 2; }
            else { base = (bf16_t*)(ws + WS_GB); ld = 2048; c0 = (pn - 45) * 256; act = 2; }
            epi_foreach(acc, u, wr, wc, fr, fq, [&](int row, int col, f32x4 v0, f32x4 v1) {
                float o[8] = {v0[0], v0[1], v0[2], v0[3], v1[0], v1[1], v1[2], v1[3]};
#pragma unroll
                for (int j = 0; j < 8; ++j) o[j] = act == 0 ? siluf_(o[j]) : (act == 1 ? o[j] * 0.125f : sigmoidf_(o[j]));
                *(u32x4*)(base + (size_t)row * ld + c0 + (col & 255)) = pack8f(o); });
        }
    }
};

constexpr int NWAVES = 8, NTHREADS = 512;
constexpr int LDS_BYTES = 147456;
struct Args {
    const float* x; const float* p; const int* pos; const float* w_in; const float* norm_gain; const float* w_a; const float* w_b; const float* w_o;
    const float* gn_gain; const float* w_ple; const float* w_pg; const float* rel_bias; const float* final_gain;
    float* out; unsigned char* ws; int ph_lo, ph_hi; int coop, pad;
};
struct Frame { LAS unsigned char* lds; int tid, lane, wave, G, vcu; };
__device__ __forceinline__ void frame_ids(Frame& F) { int t = threadIdx.x; asm volatile("" : "+v"(t)); F.tid = t; F.lane = t & 63; F.wave = __builtin_amdgcn_readfirstlane(t >> 6); }

__device__ __forceinline__ void transpose_item(const float* W, int K, int N, int src_c0, int cnt, bf16_t* WT, int dst_r0, int k0, LAS float* scr, int lane) {
    const int c = lane & 31;
#pragma unroll 8
    for (int i = 0; i < 32; ++i) { const int kk = 2 * i + (lane >> 5); float v = 0.f; if (src_c0 >= 0 && c < cnt) v = W[(size_t)(k0 + kk) * N + src_c0 + c]; scr[kk * 33 + c] = v; }
    LDS_WAIT(); asm volatile("" ::: "memory");
    const int c8 = lane & 7;
#pragma unroll
    for (int j = 0; j < 4; ++j) { const int n = (lane >> 3) + 8 * j; const LAS float* s = scr + (8 * c8) * 33 + n;
        u32x4 o; o.x = pk2(s[0 * 33], s[1 * 33]); o.y = pk2(s[2 * 33], s[3 * 33]); o.z = pk2(s[4 * 33], s[5 * 33]); o.w = pk2(s[6 * 33], s[7 * 33]);
        *(u32x4*)(WT + (size_t)(dst_r0 + n) * K + k0 + 8 * c8) = o; }
    LDS_WAIT(); asm volatile("" ::: "memory");
}
__device__ __forceinline__ int win_src(int blk, int& cnt) {
    const int tile = blk >> 3, sb = blk & 7; cnt = 32;
    if (tile < 20) return tile * 256 + 32 * sb;
    if (tile == 20) { if (sb == 0) return 5120; if (sb == 4) return 5152; if (sb == 1) { cnt = 16; return 5184; } return -1; }
    if (tile < 29) { const int rk = tile >= 25, tl = rk ? tile - 25 : tile - 21, bj = sb >> 2, wc = sb & 3;
        return (rk ? 6224 : 5200) + (2 * tl + (wc >> 1)) * 128 + bj * 64 + 32 * (wc & 1); }
    if (tile < 37) return 7248 + (tile - 29) * 256 + 32 * sb;
    return 9296 + (tile - 37) * 256 + 32 * sb;
}
__device__ __forceinline__ void p0_prologue(const Args& a, Frame& F) {
    LAS float* scr = (LAS float*)(F.lds + F.wave * 16384);
    const int gw = F.vcu * NWAVES + F.wave, NGW = F.G * NWAVES;
    unsigned char* ws = a.ws;
    constexpr int KB_IN = DM / 64;
    constexpr int I_IN = KB_IN * (NWIN_PAD / 32);
    constexpr int I_A = (1024 / 64) * (DM / 32);
    constexpr int I_O = (DM / 64) * (DM / 32);
    constexpr int I_PLE = (PLE / 64) * (DM / 32);
    constexpr int NITEMS = I_IN + 2 * I_A + 2 * I_O + I_PLE;
    for (int it = gw; it < NITEMS; it += NGW) {
        int r = it;
        if (r < I_IN) { const int blk = r / KB_IN, kb = r % KB_IN; int cnt; const int src = win_src(blk, cnt);
            transpose_item(a.w_in, DM, NWIN, src, cnt, (bf16_t*)(ws + WS_WIN), blk * 32, kb * 64, scr, F.lane); continue; } r -= I_IN;
        if (r < I_A) { const int blk = r / 16, kb = r % 16; transpose_item(a.w_a, 1024, DM, blk * 32, 32, (bf16_t*)(ws + WS_WA), blk * 32, kb * 64, scr, F.lane); continue; } r -= I_A;
        if (r < I_A) { const int blk = r / 16, kb = r % 16; transpose_item(a.w_b, 1024, DM, blk * 32, 32, (bf16_t*)(ws + WS_WB), blk * 32, kb * 64, scr, F.lane); continue; } r -= I_A;
        if (r < I_O) { const int blk = r / 32, kb = r % 32; transpose_item(a.w_o, DM, DM, blk * 32, 32, (bf16_t*)(ws + WS_WO), blk * 32, kb * 64, scr, F.lane); continue; } r -= I_O;
        if (r < I_O) { const int blk = r / 32, kb = r % 32; transpose_item(a.w_pg, DM, DM, blk * 32, 32, (bf16_t*)(ws + WS_WPG), blk * 32, kb * 64, scr, F.lane); continue; } r -= I_O;
        { const int blk = r / 4, kb = r % 4; transpose_item(a.w_ple, PLE, DM, blk * 32, 32, (bf16_t*)(ws + WS_WPLE), blk * 32, kb * 64, scr, F.lane); }
    }
    bf16_t* H = (bf16_t*)((unsigned char*)a.out + DO_H); bf16_t* PB = (bf16_t*)(ws + WS_PB);
    for (int m = gw; m < MTOK; m += NGW) {
        const f32x4* xr = (const f32x4*)(a.x + (size_t)m * DM) + F.lane; const f32x4* gr = (const f32x4*)a.norm_gain + F.lane;
        f32x4 v[8]; float s = 0.f;
#pragma unroll
        for (int j = 0; j < 8; ++j) { v[j] = xr[64 * j]; s += (v[j][0] * v[j][0] + v[j][1] * v[j][1]) + (v[j][2] * v[j][2] + v[j][3] * v[j][3]); }
        const float rstd = 1.0f / sqrtf(wave_sum(s) * (1.0f / DM) + EPS);
        u32x2* o8 = (u32x2*)(H + (size_t)m * DM) + F.lane;
#pragma unroll
        for (int j = 0; j < 8; ++j) { const f32x4 g = gr[64 * j]; u32x2 w; w.x = pk2(v[j][0] * rstd * g[0], v[j][1] * rstd * g[1]); w.y = pk2(v[j][2] * rstd * g[2], v[j][3] * rstd * g[3]); o8[64 * j] = w; }
        const f32x4 pv = *((const f32x4*)(a.p + (size_t)m * PLE) + F.lane);
        u32x2 w; w.x = pk2(pv[0], pv[1]); w.y = pk2(pv[2], pv[3]); *((u32x2*)(PB + (size_t)m * PLE) + F.lane) = w;
    }
    f32x2* rope = (f32x2*)(ws + WS_ROPE);
    for (int e = (F.vcu * NTHREADS + F.tid); e < MTOK * 64; e += F.G * NTHREADS) {
        const int m = e >> 6, i = e & 63;
        const float invf = exp2f(-(float)i * (1.0f / 64.0f) * 13.287712379549449f);
        const float ang = (float)a.pos[m] * invf;
        const double ad = (double)ang;
        rope[e] = (f32x2){(float)cos(ad), (float)sin(ad)};
    }
}
__device__ __forceinline__ void p_final_norm(const Args& a, Frame& F) {
    const int gw = F.vcu * NWAVES + F.wave, NGW = F.G * NWAVES;
    for (int m = gw; m < MTOK; m += NGW) {
        f32x4* xr = (f32x4*)(a.out + (size_t)m * DM) + F.lane; const f32x4* gr = (const f32x4*)a.final_gain + F.lane;
        f32x4 v[8]; float s = 0.f;
#pragma unroll
        for (int j = 0; j < 8; ++j) { v[j] = xr[64 * j]; s += (v[j][0] * v[j][0] + v[j][1] * v[j][1]) + (v[j][2] * v[j][2] + v[j][3] * v[j][3]); }
        const float rstd = 1.0f / sqrtf(wave_sum(s) * (1.0f / DM) + EPS);
#pragma unroll
        for (int j = 0; j < 8; ++j) { const f32x4 g = gr[64 * j]; xr[64 * j] = (f32x4){v[j][0] * rstd * g[0], v[j][1] * rstd * g[1], v[j][2] * rstd * g[2], v[j][3] * rstd * g[3]}; }
    }
}

namespace att {
typedef short s16x4 __attribute__((ext_vector_type(4)));
typedef float f32x16 __attribute__((ext_vector_type(16)));
#define KSWZ(row, colB) ((row) * 256 + ((colB) ^ (((row) & 7) << 4)))
#define SBAR() __builtin_amdgcn_sched_barrier(0)
__device__ __forceinline__ int v_st(int k, int c) { const int kk = (k & ~0xC) | ((k & 4) << 1) | ((k & 8) >> 1); return ((kk >> 3) * 4 + (c >> 5)) * 512 + ((kk & 7) * 32 + (c & 31)) * 2; }
__device__ __forceinline__ int v_rd_base(int lane) { return ((lane & 3) << 3) | (((lane >> 2) & 3) << 6) | (((lane >> 4) & 1) << 5) | (((lane >> 5) & 1) << 8); }
constexpr int v_rd_off(int d0, int ks, int half) { return d0 * 512 + ks * 4096 + half * 2048; }
__device__ __forceinline__ int crow(int r, int hi) { return (r & 3) + 8 * (r >> 2) + 4 * hi; }
#define TRRD(dst, vb, off) asm volatile("ds_read_b64_tr_b16 %0, %1 offset:%2" : "=&v"(dst) : "v"(vb), "i"(off) : "memory")
#define TRRDV(dst, addr) asm volatile("ds_read_b64_tr_b16 %0, %1" : "=&v"(dst) : "v"(addr) : "memory")
__device__ __forceinline__ void qkt(f32x16& p0, f32x16& p1, const LAS unsigned char* Kb, int r32, int hi, const bf16x8* qr) {
    p0 = f32x16{}; p1 = f32x16{};
    const LAS unsigned char* kb[4];
#pragma unroll
    for (int dd = 0; dd < 4; ++dd) kb[dd] = Kb + KSWZ(r32, (dd * 16 + hi * 8) * 2);
#pragma unroll
    for (int d0 = 0; d0 < 8; ++d0) { const LAS unsigned char* a = kb[d0 & 3] + (d0 >> 2) * 128;
        const bf16x8 b0 = *(const LAS bf16x8*)a; const bf16x8 b1 = *(const LAS bf16x8*)(a + 32 * 256);
        p0 = __builtin_amdgcn_mfma_f32_32x32x16_bf16(b0, qr[d0], p0, 0, 0, 0);
        p1 = __builtin_amdgcn_mfma_f32_32x32x16_bf16(b1, qr[d0], p1, 0, 0, 0); }
}
template <int VOFF>
__device__ __forceinline__ void pv_tile(f32x16* o, int vb, bf16x8 pa0, bf16x8 pa1, bf16x8 pa2, bf16x8 pa3) {
#define PV_D0(d0) do { s16x4 l0, l1, l2, l3, h0, h1, h2, h3; constexpr int b_ = VOFF + v_rd_off(d0, 0, 0); \
        TRRD(l0, vb, b_); TRRD(h0, vb, b_ + 2048); TRRD(l1, vb, b_ + 4096); TRRD(h1, vb, b_ + 6144); TRRD(l2, vb, b_ + 8192); TRRD(h2, vb, b_ + 10240); TRRD(l3, vb, b_ + 12288); TRRD(h3, vb, b_ + 14336); \
        asm volatile("s_waitcnt lgkmcnt(0)" ::: "memory"); SBAR(); \
        o[d0] = __builtin_amdgcn_mfma_f32_32x32x16_bf16(pa0, (bf16x8){l0[0], l0[1], l0[2], l0[3], h0[0], h0[1], h0[2], h0[3]}, o[d0], 0, 0, 0); \
        o[d0] = __builtin_amdgcn_mfma_f32_32x32x16_bf16(pa1, (bf16x8){l1[0], l1[1], l1[2], l1[3], h1[0], h1[1], h1[2], h1[3]}, o[d0], 0, 0, 0); \
        o[d0] = __builtin_amdgcn_mfma_f32_32x32x16_bf16(pa2, (bf16x8){l2[0], l2[1], l2[2], l2[3], h2[0], h2[1], h2[2], h2[3]}, o[d0], 0, 0, 0); \
        o[d0] = __builtin_amdgcn_mfma_f32_32x32x16_bf16(pa3, (bf16x8){l3[0], l3[1], l3[2], l3[3], h3[0], h3[1], h3[2], h3[3]}, o[d0], 0, 0, 0); } while (0)
    PV_D0(0); PV_D0(1); PV_D0(2); PV_D0(3);
#undef PV_D0
}
__device__ __forceinline__ void pack_p(const f32x16& p0, const f32x16& p1, bf16x8& pa0, bf16x8& pa1, bf16x8& pa2, bf16x8& pa3) {
#define PK4(P, B_, OUT) do { const unsigned a0 = cvt_pk_bf16(P[B_+0], P[B_+1]), a1 = cvt_pk_bf16(P[B_+2], P[B_+3]); \
        const unsigned b0 = cvt_pk_bf16(P[B_+4], P[B_+5]), b1 = cvt_pk_bf16(P[B_+6], P[B_+7]); \
        auto r0 = __builtin_amdgcn_permlane32_swap(a0, b0, false, false); auto r1 = __builtin_amdgcn_permlane32_swap(a1, b1, false, false); \
        u32x4 w = {r0[0], r1[0], r0[1], r1[1]}; OUT = __builtin_bit_cast(bf16x8, w); } while (0)
    PK4(p0, 0, pa0); PK4(p0, 8, pa1); PK4(p1, 0, pa2); PK4(p1, 8, pa3);
#undef PK4
}
}

__device__ __forceinline__ float ret_log2g(int h) { return log2f(1.0f - exp2f(-5.0f - (float)h)); }
__device__ __forceinline__ void p_ret_kv(const Args& a, Frame& F) {
    using namespace att;
    const bf16_t* RK = (const bf16_t*)(a.ws + WS_RK); const bf16_t* RV = (const bf16_t*)(a.ws + WS_RV); bf16_t* KVT = (bf16_t*)((unsigned char*)a.out + DO_KVT);
    LAS unsigned char* Kl = F.lds; LAS unsigned char* Vl = F.lds + 16384;
    const int tid = F.tid, lane = F.lane, wid = F.wave, r32 = lane & 31, hi = lane >> 5;
    const int sr = tid >> 4, sc = (tid & 15) * 8;
    const int a0 = wid >> 1, dp = (wid & 1) * 2;
    const int vbK = (int)(uintptr_t)Kl + v_rd_base(lane), vbV = (int)(uintptr_t)Vl + v_rd_base(lane);
    for (int item = F.vcu; item < NB * 8 * 64; item += F.G) {
        const int bh = item >> 6, n = item & 63, h = bh & 7;
        const float lg = ret_log2g(h);
        const size_t rowbase = ((size_t)bh * SEQ + (size_t)n * 64) * 128;
#pragma unroll
        for (int i = 0; i < 2; ++i) { const int t = sr + 32 * i;
            const u32x4 kq = *(const u32x4*)(RK + rowbase + (size_t)t * 128 + sc); const u32x4 vq = *(const u32x4*)(RV + rowbase + (size_t)t * 128 + sc);
            const float w = exp2f((float)(63 - t) * lg);
            float kf[8]; kf[0] = bf2f((unsigned short)(kq.x & 0xffff)) * w; kf[1] = bf2f((unsigned short)(kq.x >> 16)) * w; kf[2] = bf2f((unsigned short)(kq.y & 0xffff)) * w; kf[3] = bf2f((unsigned short)(kq.y >> 16)) * w;
            kf[4] = bf2f((unsigned short)(kq.z & 0xffff)) * w; kf[5] = bf2f((unsigned short)(kq.z >> 16)) * w; kf[6] = bf2f((unsigned short)(kq.w & 0xffff)) * w; kf[7] = bf2f((unsigned short)(kq.w >> 16)) * w;
            *(LAS u32x4*)(Kl + v_st(t, sc)) = pack8f(kf); *(LAS u32x4*)(Vl + v_st(t, sc)) = vq; }
        __syncthreads();
        f32x16 acc[2] = {};
#pragma unroll
        for (int ks = 0; ks < 4; ++ks) {
            s16x4 al, ah, b0l, b0h, b1l, b1h;
            TRRDV(al, vbK + v_rd_off(a0, ks, 0)); TRRDV(ah, vbK + v_rd_off(a0, ks, 1));
            TRRDV(b0l, vbV + v_rd_off(dp, ks, 0)); TRRDV(b0h, vbV + v_rd_off(dp, ks, 1));
            TRRDV(b1l, vbV + v_rd_off(dp + 1, ks, 0)); TRRDV(b1h, vbV + v_rd_off(dp + 1, ks, 1));
            asm volatile("s_waitcnt lgkmcnt(0)" ::: "memory"); SBAR();
            const bf16x8 af = (bf16x8){al[0], al[1], al[2], al[3], ah[0], ah[1], ah[2], ah[3]};
            acc[0] = __builtin_amdgcn_mfma_f32_32x32x16_bf16(af, (bf16x8){b0l[0], b0l[1], b0l[2], b0l[3], b0h[0], b0h[1], b0h[2], b0h[3]}, acc[0], 0, 0, 0);
            acc[1] = __builtin_amdgcn_mfma_f32_32x32x16_bf16(af, (bf16x8){b1l[0], b1l[1], b1l[2], b1l[3], b1h[0], b1h[1], b1h[2], b1h[3]}, acc[1], 0, 0, 0);
        }
        bf16_t* dst = KVT + (size_t)item * 16384;
#pragma unroll
        for (int e = 0; e < 2; ++e)
#pragma unroll
            for (int g = 0; g < 4; ++g) { u32x2 w; w.x = cvt_pk_bf16(acc[e][4 * g], acc[e][4 * g + 1]); w.y = cvt_pk_bf16(acc[e][4 * g + 2], acc[e][4 * g + 3]);
                *(u32x2*)(dst + (size_t)(32 * (dp + e) + r32) * 128 + 32 * a0 + 8 * g + 4 * hi) = w; }
        __syncthreads();
    }
}
__device__ __forceinline__ void p_ret_scan(const Args& a, Frame& F) {
    bf16_t* KVT = (bf16_t*)((unsigned char*)a.out + DO_KVT);
    for (int idx = F.vcu * NTHREADS + F.tid; idx < 32 * 2048; idx += F.G * NTHREADS) {
        const int bh = idx >> 11, e8 = idx & 2047, h = bh & 7;
        const float dec = exp2f(64.0f * ret_log2g(h));
        float st[8] = {0.f, 0.f, 0.f, 0.f, 0.f, 0.f, 0.f, 0.f};
        u32x4* p = (u32x4*)(KVT + (size_t)bh * 64 * 16384 + (size_t)e8 * 8);
#pragma unroll 4
        for (int n = 0; n < 64; ++n) {
            const u32x4 kv = p[(size_t)n * 2048];
            p[(size_t)n * 2048] = pack8f(st);
            st[0] = st[0] * dec + bf2f((unsigned short)(kv.x & 0xffff)); st[1] = st[1] * dec + bf2f((unsigned short)(kv.x >> 16));
            st[2] = st[2] * dec + bf2f((unsigned short)(kv.y & 0xffff)); st[3] = st[3] * dec + bf2f((unsigned short)(kv.y >> 16));
            st[4] = st[4] * dec + bf2f((unsigned short)(kv.z & 0xffff)); st[5] = st[5] * dec + bf2f((unsigned short)(kv.z >> 16));
            st[6] = st[6] * dec + bf2f((unsigned short)(kv.w & 0xffff)); st[7] = st[7] * dec + bf2f((unsigned short)(kv.w >> 16));
        }
    }
}
__device__ __forceinline__ void p_ret_out(const Args& a, Frame& F) {
    using namespace att;
    const bf16_t* RQ = (const bf16_t*)(a.ws + WS_RQ); const bf16_t* RK = (const bf16_t*)(a.ws + WS_RK); const bf16_t* RV = (const bf16_t*)(a.ws + WS_RV);
    const bf16_t* RZ = (const bf16_t*)(a.ws + WS_RZ); const bf16_t* KVT = (const bf16_t*)((const unsigned char*)a.out + DO_KVT); bf16_t* BO = (bf16_t*)(a.ws + WS_BO);
    const int tid = F.tid, lane = F.lane, wid = F.wave, r32 = lane & 31, hi = lane >> 5;
    const int pr = wid >> 1, qblk = wid & 1, lt = tid & 127;
    LAS unsigned char* Kl = F.lds + pr * 32768; LAS unsigned char* Vl = Kl + 16384;
    const int vb = (int)(uintptr_t)Vl + v_rd_base(lane);
    for (int it0 = F.vcu * 4; it0 < NB * 8 * 64; it0 += F.G * 4) {
        const int item = it0 + pr, bh = item >> 6, n = item & 63, h = bh & 7, b = bh >> 3;
        const float lg = ret_log2g(h);
        const size_t rowbase = ((size_t)bh * SEQ + (size_t)n * 64) * 128;
#pragma unroll
        for (int i = 0; i < 8; ++i) { const int c = lt + 128 * i, t = c >> 4, sc = (c & 15) * 8;
            *(LAS u32x4*)(Kl + KSWZ(t, sc * 2)) = *(const u32x4*)(RK + rowbase + (size_t)t * 128 + sc);
            *(LAS u32x4*)(Vl + v_st(t, sc)) = *(const u32x4*)(RV + rowbase + (size_t)t * 128 + sc); }
        bf16x8 qr[8];
#pragma unroll
        for (int d0 = 0; d0 < 8; ++d0) qr[d0] = *(const bf16x8*)(RQ + rowbase + (size_t)(32 * qblk + r32) * 128 + d0 * 16 + hi * 8);
        __syncthreads();
        f32x16 p0, p1;
        qkt(p0, p1, Kl, r32, hi, qr);
        const int iq = 32 * qblk + r32;
#pragma unroll
        for (int r = 0; r < 16; ++r) { const int j0 = crow(r, hi), j1 = j0 + 32;
            const int e0 = (iq > j0 ? iq - j0 : j0 - iq) - iq - 1, e1 = (iq > j1 ? iq - j1 : j1 - iq) - iq - 1;
            p0[r] *= exp2f((float)e0 * lg); p1[r] *= exp2f((float)e1 * lg); }
        bf16x8 pa0, pa1, pa2, pa3;
        pack_p(p0, p1, pa0, pa1, pa2, pa3);
        f32x16 o[4] = {};
        SBAR();
        pv_tile<0>(o, vb, pa0, pa1, pa2, pa3);
        const bf16_t* ST = KVT + (size_t)item * 16384;
#pragma unroll
        for (int d0 = 0; d0 < 4; ++d0)
#pragma unroll
            for (int kk = 0; kk < 8; ++kk) { const bf16x8 sf = *(const bf16x8*)(ST + (size_t)(32 * d0 + r32) * 128 + 16 * kk + 8 * hi);
                o[d0] = __builtin_amdgcn_mfma_f32_32x32x16_bf16(qr[kk], sf, o[d0], 0, 0, 0); }
        float gain[4];
#pragma unroll
        for (int d0 = 0; d0 < 4; ++d0) gain[d0] = a.gn_gain[h * 128 + 32 * d0 + r32];
#pragma unroll
        for (int r = 0; r < 16; ++r) { const int il = 32 * qblk + crow(r, hi); const float fs = exp2f((float)(il + 1) * lg);
            float y0 = o[0][r] * fs, y1 = o[1][r] * fs, y2 = o[2][r] * fs, y3 = o[3][r] * fs;
            float s1 = (y0 + y1) + (y2 + y3), s2 = (y0 * y0 + y1 * y1) + (y2 * y2 + y3 * y3);
#pragma unroll
            for (int k = 1; k < 32; k <<= 1) { s1 += __shfl_xor(s1, k); s2 += __shfl_xor(s2, k); }
            const float mu = s1 * (1.0f / 128.0f); const float var = fmaxf(s2 * (1.0f / 128.0f) - mu * mu, 0.f); const float rs = 1.0f / sqrtf(var + EPS);
            const size_t m = (size_t)b * SEQ + (size_t)n * 64 + il;
            const bf16_t* rz = RZ + m * 1024 + h * 128 + r32; bf16_t* bo = BO + m * 1024 + h * 128 + r32;
            const float v0 = (y0 - mu) * rs * gain[0] * bf2f(rz[0]), v1 = (y1 - mu) * rs * gain[1] * bf2f(rz[32]), v2 = (y2 - mu) * rs * gain[2] * bf2f(rz[64]), v3 = (y3 - mu) * rs * gain[3] * bf2f(rz[96]);
            const float n0 = __shfl_xor(v0, 1), n1 = __shfl_xor(v1, 1), n2 = __shfl_xor(v2, 1), n3 = __shfl_xor(v3, 1);
            if ((r32 & 1) == 0) { *(unsigned*)(bo) = cvt_pk_bf16(v0, n0); *(unsigned*)(bo + 32) = cvt_pk_bf16(v1, n1); *(unsigned*)(bo + 64) = cvt_pk_bf16(v2, n2); *(unsigned*)(bo + 96) = cvt_pk_bf16(v3, n3); }
        }
        __syncthreads();
    }
}

__device__ __forceinline__ void p_index(const Args& a, Frame& F) {
    using namespace att;
    const bf16_t* IQ = (const bf16_t*)((const unsigned char*)a.out + DO_IQ); const bf16_t* IK = (const bf16_t*)(a.ws + WS_IK); const float* IW = (const float*)(a.ws + WS_IW);
    unsigned* MASK = (unsigned*)(a.ws + WS_MASK);
    LAS unsigned* hist = (LAS unsigned*)F.lds; LAS float* part = (LAS float*)(F.lds + 8192); LAS int* misc = (LAS int*)(F.lds + 8448); LAS float* miscf = (LAS float*)(F.lds + 8448);
    LAS float* cand = (LAS float*)(F.lds + 8704);
    constexpr int NBIN = 1024, CAP = 256;
    const int tid = F.tid, lane = F.lane, wid = F.wave, r32 = lane & 31, hi = lane >> 5;
    const float NINF = -__builtin_inff(), PINF = __builtin_inff();
    for (int round = 0; round * F.G < 1024; ++round) {
        const int j = round * F.G + ((round & 1) ? F.G - 1 - F.vcu : F.vcu);
        if (j >= 1024) continue;
        const int c = 63 - (j >> 4), sub = j & 15, b = sub >> 2, pg = sub & 3;
        const int m0 = b * SEQ + 64 * c, ntile = 2 * (c + 1), ntw = (c >> 2) + 1;
        const bool need_sel = c >= 4;
        for (int pp = 0; pp < 8; ++pp) {
            const int p = pg * 8 + pp;
            const int qrow = m0 + 2 * p + hi;
            bf16x8 af[4];
            { const int aq_ = (r32 >> 2) & 1, ah_ = (r32 & 3) + 4 * (r32 >> 3);
#pragma unroll
              for (int ks = 0; ks < 4; ++ks) af[ks] = *(const bf16x8*)(IQ + (size_t)(m0 + 2 * p + aq_) * 1024 + ah_ * 64 + 16 * ks + 8 * hi); }
            float wq[16];
#pragma unroll
            for (int q4 = 0; q4 < 4; ++q4) { const f32x4 w4 = *(const f32x4*)(IW + (size_t)qrow * 16 + 4 * q4); wq[4 * q4] = w4[0]; wq[4 * q4 + 1] = w4[1]; wq[4 * q4 + 2] = w4[2]; wq[4 * q4 + 3] = w4[3]; }
            float v[16];
#pragma unroll
            for (int tt = 0; tt < 16; ++tt) {
                v[tt] = NINF;
                if (tt < ntw) { const int t = wid + 8 * tt;
                    if (t < ntile) {
                        const bf16_t* kp = IK + (size_t)(b * SEQ + 32 * t + r32) * 64 + 8 * hi;
                        f32x16 cc = {};
#pragma unroll
                        for (int ks = 0; ks < 4; ++ks) cc = __builtin_amdgcn_mfma_f32_32x32x16_bf16(af[ks], *(const bf16x8*)(kp + 16 * ks), cc, 0, 0, 0);
                        float idx = 0.f;
#pragma unroll
                        for (int r = 0; r < 16; ++r) idx += fmaxf(cc[r], 0.f) * wq[r];
                        v[tt] = idx; } }
            }
            float T = NINF; int bstar = -1; bool ovf = false; float mn = 0.f, scale = 0.f;
            if (need_sel) {
                float lmn = PINF, lmx = NINF;
#pragma unroll
                for (int tt = 0; tt < 16; ++tt) { lmx = fmaxf(lmx, v[tt]); lmn = fminf(lmn, v[tt] == NINF ? PINF : v[tt]); }
#pragma unroll
                for (int k = 1; k < 32; k <<= 1) { lmx = fmaxf(lmx, __shfl_xor(lmx, k)); lmn = fminf(lmn, __shfl_xor(lmn, k)); }
                if (r32 == 0) { part[(wid * 2 + hi) * 2] = lmn; part[(wid * 2 + hi) * 2 + 1] = lmx; }
#pragma unroll
                for (int k = 0; k < 4; ++k) hist[tid + 512 * k] = 0u;
                if (tid < 2) misc[4 + tid] = 0;
                __syncthreads();
                float mx = NINF; mn = PINF;
#pragma unroll
                for (int w8 = 0; w8 < 8; ++w8) { mn = fminf(mn, part[(w8 * 2 + hi) * 2]); mx = fmaxf(mx, part[(w8 * 2 + hi) * 2 + 1]); }
                scale = (mx > mn) ? (float)NBIN / (mx - mn) : 0.f;
#pragma unroll
                for (int tt = 0; tt < 16; ++tt) if (v[tt] != NINF) { int bin = (int)((v[tt] - mn) * scale); bin = bin > NBIN - 1 ? NBIN - 1 : (bin < 0 ? 0 : bin);
                    __hip_atomic_fetch_add(hist + hi * NBIN + bin, 1u, __ATOMIC_RELAXED, __HIP_MEMORY_SCOPE_WORKGROUP); }
                __syncthreads();
                if (wid < 2) {
                    unsigned cnt[16]; unsigned sum = 0;
#pragma unroll
                    for (int k = 0; k < 16; ++k) { cnt[k] = hist[wid * NBIN + 16 * lane + k]; sum += cnt[k]; }
                    unsigned suf = sum;
#pragma unroll
                    for (int k = 1; k < 64; k <<= 1) { const unsigned o = __shfl_down(suf, k); if (lane + k < 64) suf += o; }
                    const unsigned above = suf - sum;
                    if (above < 256u && suf >= 256u) { unsigned run = above; int bs = 16 * lane; unsigned ca = above; bool found = false;
#pragma unroll
                        for (int k = 15; k >= 0; --k) { if (!found) { if (run + cnt[k] >= 256u) { bs = 16 * lane + k; ca = run; found = true; } else run += cnt[k]; } }
                        misc[wid] = bs; misc[2 + wid] = (int)ca; }
                }
                __syncthreads();
                bstar = misc[hi];
#pragma unroll
                for (int tt = 0; tt < 16; ++tt) if (v[tt] != NINF) { int bin = (int)((v[tt] - mn) * scale); bin = bin > NBIN - 1 ? NBIN - 1 : (bin < 0 ? 0 : bin);
                    if (bin == bstar) { const int pos = __hip_atomic_fetch_add(misc + 4 + hi, 1, __ATOMIC_RELAXED, __HIP_MEMORY_SCOPE_WORKGROUP); if (pos < CAP) cand[hi * CAP + pos] = v[tt]; } }
                __syncthreads();
                if (wid < 2) {
                    const int n = misc[4 + wid], kk = 256 - misc[2 + wid];
                    if (n <= CAP) {
                        float ci[4]; int rk[4];
#pragma unroll
                        for (int k = 0; k < 4; ++k) { const int i = lane + 64 * k; ci[k] = i < n ? cand[wid * CAP + i] : NINF; rk[k] = 0; }
                        for (int jj = 0; jj < n; ++jj) { const float cj = cand[wid * CAP + jj];
#pragma unroll
                            for (int k = 0; k < 4; ++k) rk[k] += (cj > ci[k] || (cj == ci[k] && jj < lane + 64 * k)) ? 1 : 0; }
#pragma unroll
                        for (int k = 0; k < 4; ++k) if (lane + 64 * k < n && rk[k] == kk - 1) miscf[6 + wid] = ci[k];
                    } else if (lane == 0) miscf[6 + wid] = NINF;
                    if (lane == 0) misc[8 + wid] = n > CAP ? 1 : 0;
                }
                __syncthreads();
                T = miscf[6 + hi]; ovf = misc[8 + hi] != 0;
            }
#pragma unroll
            for (int tt = 0; tt < 16; ++tt) if (tt < ntw) { const int t = wid + 8 * tt;
                bool sel = v[tt] != NINF;
                if (need_sel && sel) { if (ovf) { int bin = (int)((v[tt] - mn) * scale); bin = bin > NBIN - 1 ? NBIN - 1 : (bin < 0 ? 0 : bin); sel = bin >= bstar; } else sel = v[tt] >= T; }
                const unsigned long long bal = __ballot(sel);
                if (r32 == 0) MASK[(size_t)qrow * 128 + t] = hi ? (unsigned)(bal >> 32) : (unsigned)bal; }
        }
    }
}

__device__ __forceinline__ int t5_bucket(int rel) {
    const int n = rel < 0 ? -rel : rel; int bkt;
    if (n < 8) bkt = n; else { int k = (31 - __builtin_clz((unsigned)(n * n))) - 6; bkt = 8 + k; if (bkt > 15) bkt = 15; }
    return bkt + (rel > 0 ? 16 : 0);
}
__device__ __forceinline__ void attn_unit(const Args& a, Frame& F, int b, int h, int qb) {
    using namespace att;
    LAS unsigned char* Kl = F.lds; LAS unsigned char* Vl = F.lds + 32768;
    int tid = threadIdx.x; asm volatile("" : "+v"(tid));
    const int lane = tid & 63, wid = __builtin_amdgcn_readfirstlane(tid >> 6), r32 = lane & 31, hi = lane >> 5;
    LAS float* wsf = (LAS float*)(F.lds + 65536) + wid * 64; LAS float* BT = (LAS float*)(F.lds + 65536 + 2048);
    constexpr float LOG2E = 1.4426950408889634f, C2 = 0.08838834764831845f * LOG2E;
    const float NINF = -__builtin_inff();
    if (tid < 256) { const int rel = tid - 192; BT[tid] = (a.rel_bias[t5_bucket(rel) * 8 + h] - a.rel_bias[15 * 8 + h]) * LOG2E; }
    const size_t hb = ((size_t)(b * 8 + h) * SEQ) * 128;
    const bf16_t* AQh = (const bf16_t*)((const unsigned char*)a.out + DO_AQ) + hb; const bf16_t* AKh = (const bf16_t*)(a.ws + WS_AK) + hb; const bf16_t* AVh = (const bf16_t*)(a.ws + WS_AV) + hb;
    const int qpos = 256 * qb + 32 * wid + r32, cw = 4 * qb + (wid >> 1);
    const unsigned* MKb = (const unsigned*)(a.ws + WS_MASK) + (size_t)(b * SEQ + 256 * qb) * 128;
    const unsigned mko = (unsigned)(32 * wid + r32) * 128u;
    bf16x8 qr[8];
    { const unsigned qo = (unsigned)qpos * 128u + hi * 8u;
#pragma unroll
      for (int d0 = 0; d0 < 8; ++d0) qr[d0] = *(const bf16x8*)(AQh + qo + d0 * 16); }
    const int sr = tid >> 4, sc = (tid & 15) * 8, kws = KSWZ(sr, sc * 2), vs0 = v_st(sr, sc), vs1 = v_st(32 + sr, sc);
    const unsigned so = (unsigned)sr * 128u + sc;
    const int vb = (int)(uintptr_t)Vl + v_rd_base(lane);
    const int NT = 4 * (qb + 1);
    u32x4 k0, k1, v0, v1; u32x2 mw, mwn;
    { k0 = *(const u32x4*)(AKh + so); k1 = *(const u32x4*)(AKh + so + 32 * 128); v0 = *(const u32x4*)(AVh + so); v1 = *(const u32x4*)(AVh + so + 32 * 128);
      mw = *(const u32x2*)(MKb + mko);
      *(LAS u32x4*)(Kl + kws) = k0; *(LAS u32x4*)(Kl + kws + 32 * 256) = k1; *(LAS u32x4*)(Vl + vs0) = v0; *(LAS u32x4*)(Vl + vs1) = v1; }
    __syncthreads();
    float m_run = -1e30f, l_run = 0.f; f32x16 o[4] = {};
    mwn = mw;
#pragma unroll 1
    for (int t = 0; t < NT; ++t) {
        const int buf = t & 1;
        if (t + 1 < NT) { const bf16_t* kp = AKh + (size_t)(t + 1) * 8192; const bf16_t* vp = AVh + (size_t)(t + 1) * 8192;
            k0 = *(const u32x4*)(kp + so); k1 = *(const u32x4*)(kp + so + 32 * 128); v0 = *(const u32x4*)(vp + so); v1 = *(const u32x4*)(vp + so + 32 * 128);
            mwn = *(const u32x2*)(MKb + 2 * (t + 1) + mko); }
        f32x16 p0, p1;
        qkt(p0, p1, Kl + buf * 16384, r32, hi, qr);
        const unsigned w0s = mw.x >> (4 * hi), w1s = mw.y >> (4 * hi);
        const bool near = t >= cw - 2;
        const int relb = 64 * t + 4 * hi - qpos + 192;
        float tmax = NINF;
#pragma unroll
        for (int r = 0; r < 16; ++r) { const int bp = (r & 3) + 8 * (r >> 2);
            float z0 = p0[r] * C2, z1 = p1[r] * C2;
            if (near) { int i0 = relb + bp, i1 = i0 + 32; i0 = i0 < 0 ? 0 : (i0 > 255 ? 255 : i0); i1 = i1 < 0 ? 0 : (i1 > 255 ? 255 : i1); z0 += BT[i0]; z1 += BT[i1]; }
            z0 = ((w0s >> bp) & 1u) ? z0 : NINF; z1 = ((w1s >> bp) & 1u) ? z1 : NINF;
            p0[r] = z0; p1[r] = z1; tmax = fmaxf(tmax, fmaxf(z0, z1)); }
        tmax = fmaxf(tmax, __shfl_xor(tmax, 32));
        const float m_new = fmaxf(m_run, tmax), alpha = __builtin_amdgcn_exp2f(m_run - m_new); m_run = m_new;
        float rs = 0.f;
#pragma unroll
        for (int r = 0; r < 16; ++r) { p0[r] = __builtin_amdgcn_exp2f(p0[r] - m_new); p1[r] = __builtin_amdgcn_exp2f(p1[r] - m_new); rs += p0[r] + p1[r]; }
        rs += __shfl_xor(rs, 32);
        l_run = l_run * alpha + rs;
        if (__any(alpha < 1.f)) { if (hi == 0) wsf[r32] = alpha; LDS_WAIT();
#pragma unroll
            for (int d_ = 0; d_ < 4; ++d_)
#pragma unroll
                for (int r = 0; r < 16; ++r) o[d_][r] *= wsf[crow(r, hi)]; }
        bf16x8 pa0, pa1, pa2, pa3;
        pack_p(p0, p1, pa0, pa1, pa2, pa3);
        SBAR();
        if (buf == 0) pv_tile<0>(o, vb, pa0, pa1, pa2, pa3); else pv_tile<16384>(o, vb, pa0, pa1, pa2, pa3);
        if (t + 1 < NT) { LAS unsigned char* Kn = Kl + (buf ^ 1) * 16384; LAS unsigned char* Vn = Vl + (buf ^ 1) * 16384;
            *(LAS u32x4*)(Kn + kws) = k0; *(LAS u32x4*)(Kn + kws + 32 * 256) = k1; *(LAS u32x4*)(Vn + vs0) = v0; *(LAS u32x4*)(Vn + vs1) = v1; }
        mw = mwn;
        __syncthreads();
    }
    if (hi == 0) wsf[32 + r32] = l_run; LDS_WAIT();
    { int r32e = r32, hie = hi; asm volatile("" : "+v"(r32e), "+v"(hie));
      const size_t ub = ((size_t)b * SEQ + 256 * qb + 32 * wid) * 1024 + h * 128;
      const bf16_t* AZu = (const bf16_t*)(a.ws + WS_AZ) + ub; bf16_t* AOu = (bf16_t*)((unsigned char*)a.out + DO_AO) + ub;
#pragma unroll
      for (int r = 0; r < 16; ++r) { const float rl = 1.0f / wsf[32 + crow(r, hie)];
        const unsigned eo = (unsigned)crow(r, hie) * 1024u + r32e;
        const float x0 = o[0][r] * rl * bf2f(AZu[eo]), x1 = o[1][r] * rl * bf2f(AZu[eo + 32]), x2 = o[2][r] * rl * bf2f(AZu[eo + 64]), x3 = o[3][r] * rl * bf2f(AZu[eo + 96]);
        const float n0 = __shfl_xor(x0, 1), n1 = __shfl_xor(x1, 1), n2 = __shfl_xor(x2, 1), n3 = __shfl_xor(x3, 1);
        if ((r32e & 1) == 0) { *(unsigned*)(AOu + eo) = cvt_pk_bf16(x0, n0); *(unsigned*)(AOu + eo + 32) = cvt_pk_bf16(x1, n1); *(unsigned*)(AOu + eo + 64) = cvt_pk_bf16(x2, n2); *(unsigned*)(AOu + eo + 96) = cvt_pk_bf16(x3, n3); } } }
    __syncthreads();
}
__device__ __forceinline__ void p_attn(const Args& a, Frame& F) {
    for (int u2 = F.vcu; u2 < 256; u2 += F.G) { const int bh = u2 >> 3, s = u2 & 7;
        for (int pass = 0; pass < 2; ++pass) attn_unit(a, F, bh >> 3, bh & 7, pass ? 15 - s : s); }
}

typedef __attribute__((address_space(1))) unsigned gu32;
#define XB_TMO      128
#define XB_XCNT(j)  (256  + 64 * (j))
#define XB_XSUB(j)  (1280 + 64 * (j))
#define XB_XGEN(j)  (2304 + 64 * (j))
#define XB_TOP      3328
#define XB_TOPGEN   3392
#define XCD_BAR_WORDS 3456
#define XB_SPIN_CAP (1u << 20)
__device__ __forceinline__ unsigned xb_ld(unsigned* p)              { return __hip_atomic_load(p, __ATOMIC_RELAXED, __HIP_MEMORY_SCOPE_AGENT); }
__device__ __forceinline__ unsigned xb_add(unsigned* p, unsigned v) { return __hip_atomic_fetch_add(p, v, __ATOMIC_RELAXED, __HIP_MEMORY_SCOPE_AGENT); }
__device__ __forceinline__ unsigned xb_xcc_id() { return (unsigned)__builtin_amdgcn_s_getreg((3 << 11) | 20) & 0xFu; }
#define XB_SPIN(cond, bar) do { unsigned _sp = 0; while (cond) { __builtin_amdgcn_s_sleep(1); \
    if ((++_sp & 255u) == 0u) { if (xb_ld(&(bar)[XB_TMO])) break; if (_sp > XB_SPIN_CAP) { atomicAdd(&(bar)[XB_TMO], 1u); break; } } } } while (0)
struct XcdBarrier { unsigned* bar; unsigned x; volatile LAS unsigned* st; };
__device__ __forceinline__ XcdBarrier xcd_barrier_post(unsigned* bar, volatile LAS unsigned* st) {
    XcdBarrier b; b.bar = bar; b.x = xb_xcc_id(); b.st = st;
    if (threadIdx.x == 0) (void)xb_add(&bar[XB_XCNT(b.x)], 1u);
    return b;
}
__device__ __forceinline__ void xcd_barrier_complete(unsigned* bar, unsigned x, unsigned& nloc, unsigned& nx) {
    const unsigned G = gridDim.x * gridDim.y * gridDim.z;
    unsigned sum, cnt, mine, sp = 0u;
    for (;;) {
        sum = 0u; cnt = 0u; mine = 0u;
#pragma unroll
        for (unsigned j = 0; j < 16; ++j) { const unsigned c = xb_ld(&bar[XB_XCNT(j)]); sum += c; cnt += (c > 0u) ? 1u : 0u; mine = (j == x) ? c : mine; }
        if (sum == G) break;
        __builtin_amdgcn_s_sleep(1);
        if ((++sp & 255u) == 0u) { if (xb_ld(&bar[XB_TMO])) break; if (sp > XB_SPIN_CAP) { atomicAdd(&bar[XB_TMO], 1u); break; } }
    }
    nloc = mine > 0u ? mine : 1u; nx = cnt > 0u ? cnt : 1u;
}
__device__ __forceinline__ void xcd_barrier(const XcdBarrier& b) {
    asm volatile("s_waitcnt vmcnt(0)" ::: "memory");
    __syncthreads();
    if (threadIdx.x == 0) {
        unsigned* bar = b.bar;
        __builtin_amdgcn_s_waitcnt(0);
        unsigned nloc = b.st[0], nx = b.st[1];
        if (nloc == 0u) { xcd_barrier_complete(bar, b.x, nloc, nx); b.st[0] = nloc; b.st[1] = nx; }
        const unsigned old = xb_add(&bar[XB_XSUB(b.x)], 1u);
        const unsigned gen = old / nloc;
        if (old + 1u == (gen + 1u) * nloc) {
            __builtin_amdgcn_fence(__ATOMIC_RELEASE, "agent");
            asm volatile("s_waitcnt vmcnt(0)" ::: "memory");
            const unsigned og = xb_add(&bar[XB_TOP], 1u);
            const unsigned tg = og / nx;
            if (og + 1u == (tg + 1u) * nx) xb_add(&bar[XB_TOPGEN], 1u);
            else XB_SPIN(xb_ld(&bar[XB_TOPGEN]) == tg, bar);
            __builtin_amdgcn_fence(__ATOMIC_ACQUIRE, "agent");
            xb_add(&bar[XB_XGEN(b.x)], 1u);
            asm volatile("s_waitcnt vmcnt(0)" ::: "memory");
        } else {
            XB_SPIN(xb_ld(&bar[XB_XGEN(b.x)]) == gen, bar);
            __builtin_amdgcn_fence(__ATOMIC_ACQUIRE, "agent");
            asm volatile("s_waitcnt vmcnt(0)" ::: "memory");
        }
    }
    __syncthreads();
}

constexpr int NPHASES = 9;
constexpr int LDS_MISC = 139264;
constexpr size_t CTL_ZERO_BYTES = 65536;
__global__ void __launch_bounds__(NTHREADS, 2) fwd_kernel(Args args) {
    extern __shared__ __attribute__((aligned(16))) unsigned char lds_raw[];
    cg::grid_group grid = cg::this_grid();
    Frame F;
    F.lds = (LAS unsigned char*)lds_raw;
    frame_ids(F);
    F.G = gridDim.x; { const int bx = blockIdx.x; F.vcu = (F.G % 8 == 0) ? (bx % 8) * (F.G / 8) + bx / 8 : bx; }
    const int lo = args.ph_lo, hi = args.ph_hi;
    unsigned char* ws = args.ws;
    volatile LAS unsigned* MISC = (volatile LAS unsigned*)(F.lds + LDS_MISC);
    if (threadIdx.x < 16) MISC[threadIdx.x] = 0u;
    __syncthreads();
    XcdBarrier bar = xcd_barrier_post((unsigned*)(ws + WS_CTL) + 1024, MISC + 8);
#define IN(k) (lo <= (k) && (k) < hi)
#define SEAM_CG(k) do { if (IN(k) && IN((k) + 1)) { __threadfence(); grid.sync(); } } while (0)
#define SEAM(k) do { if (IN(k) && IN((k) + 1)) { xcd_barrier(bar); } } while (0)
    if (IN(0)) { frame_ids(F); p0_prologue(args, F); }
    SEAM_CG(0);
    if (IN(1)) {
        pg8::Gemm g{(const bf16_t*)((unsigned char*)args.out + DO_H), (const bf16_t*)(ws + WS_WIN), MTOK, NWIN_PAD, DM}; pg8::StaticOrder S; S.init(MTOK, NWIN_PAD, F.G, (int)blockIdx.x);
        EpiProj E{ws, (unsigned char*)args.out};
        pg8::gemm_phase<EpiProj, pg8::StaticOrder, true>(F.lds, g, S, E);
    }
    SEAM(1);
    if (IN(2)) { frame_ids(F); p_ret_kv(args, F); __syncthreads(); frame_ids(F); p_index(args, F); }
    SEAM(2);
    if (IN(3)) { frame_ids(F); p_ret_scan(args, F); __syncthreads(); frame_ids(F); p_attn(args, F); }
    SEAM(3);
    if (IN(4)) {
        frame_ids(F); p_ret_out(args, F); __syncthreads();
        pg8::Gemm g{(const bf16_t*)((unsigned char*)args.out + DO_AO), (const bf16_t*)(ws + WS_WA), MTOK, DM, 1024}; pg8::StaticOrder S; S.init(MTOK, DM, F.G, (int)blockIdx.x);
        EpiMerge<false> E{nullptr, (const bf16_t*)(ws + WS_GA), (bf16_t*)(ws + WS_T)};
        pg8::gemm_phase<EpiMerge<false>, pg8::StaticOrder, true>(F.lds, g, S, E);
    }
    SEAM(4);
    if (IN(5)) {
        pg8::Gemm g{(const bf16_t*)(ws + WS_BO), (const bf16_t*)(ws + WS_WB), MTOK, DM, 1024}; pg8::StaticOrder S; S.init(MTOK, DM, F.G, (int)blockIdx.x);
        EpiMerge<true> E{(const bf16_t*)(ws + WS_T), (const bf16_t*)(ws + WS_GB), (bf16_t*)(ws + WS_MG)};
        pg8::gemm_phase<EpiMerge<true>, pg8::StaticOrder, true>(F.lds, g, S, E);
    }
    SEAM(5);
    if (IN(6)) {
        { pg8::Gemm g{(const bf16_t*)(ws + WS_MG), (const bf16_t*)(ws + WS_WO), MTOK, DM, DM}; pg8::StaticOrder S; S.init(MTOK, DM, F.G, (int)blockIdx.x);
          EpiResid E{args.x, args.out, (bf16_t*)(ws + WS_RB)};
          pg8::gemm_phase<EpiResid, pg8::StaticOrder, true>(F.lds, g, S, E); }
        { pg8::Gemm g{(const bf16_t*)(ws + WS_PB), (const bf16_t*)(ws + WS_WPLE), MTOK, DM, PLE}; pg8::StaticOrder S; S.init(MTOK, DM, F.G, (int)blockIdx.x);
          EpiPlainBf16<DM> E{(bf16_t*)(ws + WS_U)};
          pg8::gemm_phase<EpiPlainBf16<DM>, pg8::StaticOrder, true>(F.lds, g, S, E); }
    }
    SEAM(6);
    if (IN(7)) {
        pg8::Gemm g{(const bf16_t*)(ws + WS_RB), (const bf16_t*)(ws + WS_WPG), MTOK, DM, DM}; pg8::StaticOrder S; S.init(MTOK, DM, F.G, (int)blockIdx.x);
        EpiGate E{args.out, (const bf16_t*)(ws + WS_U), args.out};
        pg8::gemm_phase<EpiGate, pg8::StaticOrder, true>(F.lds, g, S, E);
    }
    SEAM(7);
    if (IN(8)) { frame_ids(F); p_final_norm(args, F); }
#undef IN
#undef SEAM
#undef SEAM_CG
}

#ifndef ONE_LAUNCH
#define ONE_LAUNCH 1
#endif
extern "C" void kernel_launch(void* const* d_in, const int* in_sizes, int n_in, void* d_out, int out_size, void* d_ws, size_t ws_size, hipStream_t stream) {
    static int grid = 0;
    if (grid == 0) {
        int dev = 0, cus = 0, per_cu = 0;
        (void)hipGetDevice(&dev);
        if (hipDeviceGetAttribute(&cus, hipDeviceAttributeMultiprocessorCount, dev) != hipSuccess || cus <= 0) cus = 256;
        (void)hipFuncSetAttribute((const void*)fwd_kernel, hipFuncAttributeMaxDynamicSharedMemorySize, LDS_BYTES);
        if (hipOccupancyMaxActiveBlocksPerMultiprocessor(&per_cu, (const void*)fwd_kernel, NTHREADS, LDS_BYTES) != hipSuccess || per_cu < 1) per_cu = 1;
        (void)hipGetLastError();
        grid = cus * 1;
        if (ws_size < WS_END) fprintf(stderr, "kernel_launch: workspace too small (%zu < %zu)\n", ws_size, (size_t)WS_END);
    }
    (void)hipMemsetAsync((char*)d_ws + WS_CTL, 0, CTL_ZERO_BYTES, stream);
    Args a{};
    a.x = (const float*)d_in[0]; a.p = (const float*)d_in[1]; a.pos = (const int*)d_in[2]; a.w_in = (const float*)d_in[3]; a.norm_gain = (const float*)d_in[4];
    a.w_a = (const float*)d_in[5]; a.w_b = (const float*)d_in[6]; a.w_o = (const float*)d_in[7]; a.gn_gain = (const float*)d_in[8]; a.w_ple = (const float*)d_in[9];
    a.w_pg = (const float*)d_in[10]; a.rel_bias = (const float*)d_in[11]; a.final_gain = (const float*)d_in[12];
    a.out = (float*)d_out; a.ws = (unsigned char*)d_ws; a.coop = 1; a.pad = 0;
#if ONE_LAUNCH
    a.ph_lo = 0; a.ph_hi = NPHASES;
    { void* kargs[] = {&a}; hipError_t e = hipLaunchCooperativeKernel((const void*)fwd_kernel, dim3(grid), dim3(NTHREADS), kargs, LDS_BYTES, stream);
      if (e != hipSuccess) fprintf(stderr, "cooperative launch failed: %s (grid %d)\n", hipGetErrorString(e), grid); }
#else
    for (int ph = 0; ph < NPHASES; ++ph) {
        a.ph_lo = ph; a.ph_hi = ph + 1;
        void* kargs[] = {&a}; hipError_t e = hipLaunchCooperativeKernel((const void*)fwd_kernel, dim3(grid), dim3(NTHREADS), kargs, LDS_BYTES, stream);
        if (e != hipSuccess) fprintf(stderr, "cooperative launch %d failed: %s (grid %d)\n", ph, hipGetErrorString(e), grid);
    }
#endif
}
```

```cpp
#include <hip/hip_runtime.h>
#include <hip/hip_cooperative_groups.h>
#include <cstdio>
#include <cstdint>
namespace cg = cooperative_groups;

#define LAS __attribute__((address_space(3)))
typedef unsigned short bf16_t;
typedef short bf16x8 __attribute__((ext_vector_type(8)));
typedef float f32x4 __attribute__((ext_vector_type(4)));
typedef float f32x2 __attribute__((ext_vector_type(2)));
typedef unsigned u32x4 __attribute__((ext_vector_type(4)));
typedef unsigned u32x2 __attribute__((ext_vector_type(2)));

constexpr int DM = 2048, NB = 4, SEQ = 4096, MTOK = NB * SEQ, CHUNK = 64, PLE = 256;
constexpr int NWIN = 13392, NWIN_PAD = 13568;
constexpr float EPS = 1e-6f;

constexpr size_t MiB = 1u << 20;
constexpr size_t WS_CTL = 0;
constexpr size_t WS_WIN = 1 * MiB;
constexpr size_t WS_WA = 54 * MiB;
constexpr size_t WS_WB = 58 * MiB;
constexpr size_t WS_WO = 62 * MiB;
constexpr size_t WS_WPG = 70 * MiB;
constexpr size_t WS_WPLE = 78 * MiB;
constexpr size_t WS_PB = 79 * MiB;
constexpr size_t WS_ROPE = 87 * MiB;
constexpr size_t WS_IK = 95 * MiB;
constexpr size_t WS_IW = 97 * MiB;
constexpr size_t WS_MASK = 98 * MiB;
constexpr size_t WS_AK = 106 * MiB;
constexpr size_t WS_AV = 138 * MiB;
constexpr size_t WS_AZ = 170 * MiB;
constexpr size_t WS_RQ = 202 * MiB;
constexpr size_t WS_RK = 234 * MiB;
constexpr size_t WS_RV = 266 * MiB;
constexpr size_t WS_RZ = 298 * MiB;
constexpr size_t WS_GA = 330 * MiB;
constexpr size_t WS_GB = 394 * MiB;
constexpr size_t WS_BO = 458 * MiB;
constexpr size_t WS_END = 490 * MiB;
constexpr size_t DO_H = 0, DO_KVT = 0, DO_IQ = 64 * MiB, DO_AQ = 96 * MiB, DO_AO = DO_IQ;
constexpr size_t WS_T = WS_AK, WS_MG = WS_RK, WS_RB = WS_GA, WS_U = WS_GB;

typedef __bf16 bf16x2_t __attribute__((ext_vector_type(2)));
__device__ __forceinline__ unsigned cvt_pk_bf16(float lo, float hi) { f32x2 v = {lo, hi}; bf16x2_t b = __builtin_convertvector(v, bf16x2_t); return __builtin_bit_cast(unsigned, b); }
__device__ __forceinline__ unsigned f2bf(float f) { unsigned u = __builtin_bit_cast(unsigned, f); return (u + 0x7fffu + ((u >> 16) & 1u)) >> 16; }
__device__ __forceinline__ unsigned pk2(float lo, float hi) { return f2bf(lo) | (f2bf(hi) << 16); }
__device__ __forceinline__ float bf2f(unsigned short h) { return __builtin_bit_cast(float, (unsigned)h << 16); }
__device__ __forceinline__ float sigmoidf_(float z) { return 1.0f / (1.0f + __expf(-z)); }
__device__ __forceinline__ float siluf_(float z) { return z / (1.0f + __expf(-z)); }
__device__ __forceinline__ float wave_sum(float v) {
#pragma unroll
    for (int o = 1; o < 64; o <<= 1) v += __shfl_xor(v, o);
    return v;
}
#define LDS_WAIT() asm volatile("s_waitcnt lgkmcnt(0)" ::: "memory")

namespace pg8 {
constexpr int BM = 256, BK = 64, HALF = 128, HTB = HALF * BK * 2, STAGE_BYTES = 8 * HTB, NXCD = 8, WGM = 8;
__host__ __device__ __forceinline__ int lds_byte(int r, int c) { const int st = (r >> 4) * 2 + (c >> 5), rr = r & 15, cc = c & 31, ob = rr * 64 + cc * 2; return st * 1024 + (ob ^ (((ob >> 9) & 1) << 5)); }
__host__ __device__ __forceinline__ void stage_rc(int b, int& R, int& C) { const int st = b / 1024, sb = b % 1024, swz = sb ^ (((sb >> 9) & 1) << 5); R = (st >> 1) * 16 + swz / 64; C = (st & 1) * 32 + (swz % 64) / 2; }
__host__ __device__ __forceinline__ int perm32(int rho) { const int n = rho >> 4, i = rho & 15; return 8 * (i >> 2) + 4 * n + (i & 3); }
struct Unit { int pm, pn; };
struct Gemm { const bf16_t* A; const bf16_t* Bt; int M, N, K; };
struct StaticOrder {
    int nM, nN, nwg, G, c;
    __host__ __device__ void init(int M, int N, int G_, int c_) { nM = M / BM; nN = N / BM; nwg = nM * nN; G = G_; c = c_; }
    __host__ __device__ bool next(int i, Unit& u) const {
        const long L = (long)i * G + c; if (L >= nwg) return false;
        int wgid = (int)L; { const int q = nwg / NXCD, r = nwg % NXCD, xcd = wgid % NXCD, off = wgid / NXCD; wgid = (xcd < r ? xcd * (q + 1) : r * (q + 1) + (xcd - r) * q) + off; }
        const int nig = WGM * nN, gid = wgid / nig, fm = gid * WGM, gsz = (nM - fm) < WGM ? (nM - fm) : WGM;
        u.pm = fm + ((wgid % nig) % gsz); u.pn = (wgid % nig) / gsz; return true;
    }
    __device__ __forceinline__ void a_ready(const Unit&) const {}
    __device__ __forceinline__ void done(const Unit&) const {}
};

template <class Epi, class Sched, bool ALIGN_EPI = true>
__device__ __forceinline__ void gemm_phase(LAS unsigned char* lds, const Gemm g, const Sched& S, const Epi& E) {
    const int tid = threadIdx.x, wid = __builtin_amdgcn_readfirstlane(tid >> 6), lane = tid & 63, wr = wid >> 2, wc = wid & 3, fr = lane & 15, fq = lane >> 4;
    const int K = g.K, nt = K / BK;
    unsigned voffA[2], voffB[2];
#pragma unroll
    for (int i = 0; i < 2; ++i) { int R, C; stage_rc(tid * 16 + i * 8192, R, C); const int Rb = Epi::PERM ? ((R & ~31) + perm32(R & 31)) : R;
        voffA[i] = (unsigned)(R * K + C) * 2u; voffB[i] = (unsigned)(Rb * K + C) * 2u; }
    const size_t kstep = (size_t)(BK * 2);
    const size_t hstep = (size_t)HALF * K * 2;
    const size_t tstep = 2 * hstep;
    const unsigned ldsw = (unsigned)wid * 1024u;
    const int aoff = lds_byte(wr * 64 + fr, fq * 8), boff = lds_byte(wc * 32 + fr, fq * 8);
#define PG8_SA(b, h) (((b) * 2 + (h)) * HTB)
#define PG8_SB(b, h) ((4 + (b) * 2 + (h)) * HTB)
#define PG8_STAGE(bufoff, gbase, voff) do { _Pragma("unroll") for (int _i = 0; _i < 2; ++_i) \
        __builtin_amdgcn_global_load_lds((const unsigned*)((const char*)(gbase) + (voff)[_i]), (LAS unsigned*)(lds + (bufoff) + ldsw + _i * 8192), 16, 0, 0); } while (0)
#define PG8_LDA(dst, b, h) do { _Pragma("unroll") for (int m = 0; m < 4; ++m) _Pragma("unroll") for (int k = 0; k < 2; ++k) dst[m][k] = *(const LAS bf16x8*)(lds + PG8_SA(b, h) + aoff + m * 2048 + k * 1024); } while (0)
#define PG8_LDB(dst, b, h) do { _Pragma("unroll") for (int n = 0; n < 2; ++n) _Pragma("unroll") for (int k = 0; k < 2; ++k) dst[n][k] = *(const LAS bf16x8*)(lds + PG8_SB(b, h) + boff + n * 2048 + k * 1024); } while (0)
#define PG8_MMA(ai, bj, At, Bt) do { __builtin_amdgcn_s_setprio(1); _Pragma("unroll") for (int m = 0; m < 4; ++m) _Pragma("unroll") for (int n = 0; n < 2; ++n) _Pragma("unroll") for (int k = 0; k < 2; ++k) \
        acc[ai][bj][m][n] = __builtin_amdgcn_mfma_f32_16x16x32_bf16(Bt[n][k], At[m][k], acc[ai][bj][m][n], 0, 0, 0); __builtin_amdgcn_s_setprio(0); } while (0)
#define PG8_WAIT_V(n) asm volatile("s_waitcnt vmcnt(" #n ")" ::: "memory")
#define PG8_WAIT_L(n) asm volatile("s_waitcnt lgkmcnt(" #n ")" ::: "memory")
#define PG8_BAR __builtin_amdgcn_s_barrier()
#define PG8_SCHED __builtin_amdgcn_sched_barrier(0)
    Unit cur, nxt; int ui = 0;
    if (!S.next(0, cur)) return;
    f32x4 acc[2][2][4][2];
#pragma unroll
    for (int a = 0; a < 2; ++a)
#pragma unroll
        for (int b = 0; b < 2; ++b)
#pragma unroll
            for (int m = 0; m < 4; ++m)
#pragma unroll
                for (int n = 0; n < 2; ++n) acc[a][b][m][n] = (f32x4){0.f, 0.f, 0.f, 0.f};
    bf16x8 At[4][2], B0[2][2], B1[2][2];
    const char* cA = (const char*)g.A + (size_t)cur.pm * tstep; const char* cB = (const char*)g.Bt + (size_t)cur.pn * tstep;
    S.a_ready(cur);
    PG8_STAGE(PG8_SB(0, 0), cB, voffB); PG8_STAGE(PG8_SB(0, 1), cB + hstep, voffB); PG8_STAGE(PG8_SA(0, 0), cA, voffA); PG8_STAGE(PG8_SA(0, 1), cA + hstep, voffA);
    if (wr == 1) PG8_BAR;
    PG8_WAIT_V(2); PG8_BAR;
    PG8_STAGE(PG8_SB(1, 0), cB + kstep, voffB); PG8_STAGE(PG8_SA(1, 0), cA + kstep, voffA); PG8_STAGE(PG8_SB(1, 1), cB + hstep + kstep, voffB);
    PG8_WAIT_V(6); PG8_BAR;
    for (;;) {
        const bool has_next = S.next(ui + 1, nxt);
        const char* nA = has_next ? (const char*)g.A + (size_t)nxt.pm * tstep : cA; const char* nB = has_next ? (const char*)g.Bt + (size_t)nxt.pn * tstep : cB;
#pragma unroll 1
        for (int t = 0; t < nt; t += 2) {
            const bool last = (t == nt - 2);
            const char* a1 = cA + (size_t)(t + 1) * kstep;
            const char* a2 = last ? nA : cA + (size_t)(t + 2) * kstep; const char* b2 = last ? nB : cB + (size_t)(t + 2) * kstep;
            const char* a3 = a2 + kstep; const char* b3 = b2 + kstep;
            if (last && has_next) S.a_ready(nxt);
            PG8_LDB(B0, 0, 0); PG8_LDB(B1, 0, 1); PG8_SCHED; PG8_LDA(At, 0, 0); PG8_STAGE(PG8_SA(1, 1), a1 + hstep, voffA);
            PG8_WAIT_V(8); PG8_WAIT_L(0); PG8_BAR; PG8_MMA(0, 0, At, B0); PG8_MMA(0, 1, At, B1); PG8_BAR; PG8_SCHED;
            PG8_LDA(At, 0, 1); PG8_STAGE(PG8_SB(0, 0), b2, voffB); PG8_STAGE(PG8_SB(0, 1), b2 + hstep, voffB); PG8_STAGE(PG8_SA(0, 0), a2, voffA);
            PG8_WAIT_V(8); PG8_WAIT_L(0); PG8_BAR; PG8_MMA(1, 0, At, B0); PG8_MMA(1, 1, At, B1); PG8_BAR; PG8_SCHED;
            PG8_LDB(B0, 1, 0); PG8_LDB(B1, 1, 1); PG8_SCHED; PG8_LDA(At, 1, 0); PG8_STAGE(PG8_SA(0, 1), a2 + hstep, voffA);
            PG8_WAIT_V(8); PG8_WAIT_L(0); PG8_BAR; PG8_MMA(0, 0, At, B0); PG8_MMA(0, 1, At, B1); PG8_BAR; PG8_SCHED;
            PG8_LDA(At, 1, 1); PG8_STAGE(PG8_SB(1, 0), b3, voffB); PG8_STAGE(PG8_SB(1, 1), b3 + hstep, voffB); PG8_STAGE(PG8_SA(1, 0), a3, voffA);
            PG8_WAIT_V(8); PG8_WAIT_L(0); PG8_BAR; PG8_MMA(1, 0, At, B0); PG8_MMA(1, 1, At, B1); PG8_BAR; PG8_SCHED;
        }
        if constexpr (ALIGN_EPI) { if (wr == 0) PG8_BAR; }
        E(acc, cur, wr, wc, fr, fq);
        if (!has_next) break;
#pragma unroll
        for (int a = 0; a < 2; ++a)
#pragma unroll
            for (int b = 0; b < 2; ++b)
#pragma unroll
                for (int m = 0; m < 4; ++m)
#pragma unroll
                    for (int n = 0; n < 2; ++n) acc[a][b][m][n] = (f32x4){0.f, 0.f, 0.f, 0.f};
        cur = nxt; cA = nA; cB = nB; ++ui;
        if constexpr (ALIGN_EPI) { if (wr == 1) PG8_BAR; }
    }
    PG8_WAIT_V(0);
    if constexpr (!ALIGN_EPI) { if (wr == 0) PG8_BAR; }
    PG8_BAR;
#undef PG8_SA
#undef PG8_SB
#undef PG8_STAGE
#undef PG8_LDA
#undef PG8_LDB
#undef PG8_MMA
#undef PG8_WAIT_V
#undef PG8_WAIT_L
#undef PG8_BAR
#undef PG8_SCHED
}
}

typedef f32x4 AccT[2][2][4][2];
template <class Fn> __device__ __forceinline__ void epi_foreach(const AccT& acc, const pg8::Unit& u, int wr, int wc, int fr, int fq, Fn&& f) {
    asm volatile("" : "+v"(fr), "+v"(fq));
#pragma unroll
    for (int ai = 0; ai < 2; ++ai)
#pragma unroll
        for (int m = 0; m < 4; ++m)
#pragma unroll
            for (int bj = 0; bj < 2; ++bj) {
                f(u.pm * 256 + ai * 128 + wr * 64 + m * 16 + fr, u.pn * 256 + bj * 128 + wc * 32 + 8 * fq, acc[ai][bj][m][0], acc[ai][bj][m][1]);
                asm volatile("" ::: "memory"); }
}

template <int ldc> struct EpiPlainBf16 {
    static constexpr bool PERM = true;
    bf16_t* O;
    __device__ __forceinline__ void operator()(const AccT& acc, const pg8::Unit& u, int wr, int wc, int fr, int fq) const {
        epi_foreach(acc, u, wr, wc, fr, fq, [&](int row, int col, f32x4 v0, f32x4 v1) {
            u32x4 w; w.x = cvt_pk_bf16(v0[0], v0[1]); w.y = cvt_pk_bf16(v0[2], v0[3]); w.z = cvt_pk_bf16(v1[0], v1[1]); w.w = cvt_pk_bf16(v1[2], v1[3]);
            *(u32x4*)(O + (size_t)row * ldc + col) = w; });
    }
};
struct EpiGate {
    static constexpr bool PERM = true;
    const float* R; const bf16_t* U; float* O;
    __device__ __forceinline__ void operator()(const AccT& acc, const pg8::Unit& u, int wr, int wc, int fr, int fq) const {
        epi_foreach(acc, u, wr, wc, fr, fq, [&](int row, int col, f32x4 v0, f32x4 v1) {
            const size_t off = (size_t)row * DM + col;
            const f32x4 r0 = *(const f32x4*)(R + off), r1 = *(const f32x4*)(R + off + 4);
            const u32x4 uu = *(const u32x4*)(U + off);
            f32x4 o0, o1;
            o0[0] = r0[0] + bf2f((unsigned short)(uu.x & 0xffff)) * sigmoidf_(v0[0]); o0[1] = r0[1] + bf2f((unsigned short)(uu.x >> 16)) * sigmoidf_(v0[1]);
            o0[2] = r0[2] + bf2f((unsigned short)(uu.y & 0xffff)) * sigmoidf_(v0[2]); o0[3] = r0[3] + bf2f((unsigned short)(uu.y >> 16)) * sigmoidf_(v0[3]);
            o1[0] = r1[0] + bf2f((unsigned short)(uu.z & 0xffff)) * sigmoidf_(v1[0]); o1[1] = r1[1] + bf2f((unsigned short)(uu.z >> 16)) * sigmoidf_(v1[1]);
            o1[2] = r1[2] + bf2f((unsigned short)(uu.w & 0xffff)) * sigmoidf_(v1[2]); o1[3] = r1[3] + bf2f((unsigned short)(uu.w >> 16)) * sigmoidf_(v1[3]);
            *(f32x4*)(O + off) = o0; *(f32x4*)(O + off + 4) = o1; });
    }
};

template <bool HAS_T> struct EpiMerge {
    static constexpr bool PERM = true;
    const bf16_t* T; const bf16_t* Gt; bf16_t* O;
    __device__ __forceinline__ void operator()(const AccT& acc, const pg8::Unit& u, int wr, int wc, int fr, int fq) const {
        epi_foreach(acc, u, wr, wc, fr, fq, [&](int row, int col, f32x4 v0, f32x4 v1) {
            const size_t off = (size_t)row * DM + col;
            const u32x4 gg = *(const u32x4*)(Gt + off);
            float o[8];
            o[0] = bf2f((unsigned short)(gg.x & 0xffff)) * v0[0]; o[1] = bf2f((unsigned short)(gg.x >> 16)) * v0[1];
            o[2] = bf2f((unsigned short)(gg.y & 0xffff)) * v0[2]; o[3] = bf2f((unsigned short)(gg.y >> 16)) * v0[3];
            o[4] = bf2f((unsigned short)(gg.z & 0xffff)) * v1[0]; o[5] = bf2f((unsigned short)(gg.z >> 16)) * v1[1];
            o[6] = bf2f((unsigned short)(gg.w & 0xffff)) * v1[2]; o[7] = bf2f((unsigned short)(gg.w >> 16)) * v1[3];
            if constexpr (HAS_T) { const u32x4 tt = *(const u32x4*)(T + off);
                o[0] += bf2f((unsigned short)(tt.x & 0xffff)); o[1] += bf2f((unsigned short)(tt.x >> 16)); o[2] += bf2f((unsigned short)(tt.y & 0xffff)); o[3] += bf2f((unsigned short)(tt.y >> 16));
                o[4] += bf2f((unsigned short)(tt.z & 0xffff)); o[5] += bf2f((unsigned short)(tt.z >> 16)); o[6] += bf2f((unsigned short)(tt.w & 0xffff)); o[7] += bf2f((unsigned short)(tt.w >> 16)); }
            u32x4 w; w.x = cvt_pk_bf16(o[0], o[1]); w.y = cvt_pk_bf16(o[2], o[3]); w.z = cvt_pk_bf16(o[4], o[5]); w.w = cvt_pk_bf16(o[6], o[7]);
            *(u32x4*)(O + off) = w; });
    }
};
struct EpiResid {
    static constexpr bool PERM = true;
    const float* X; float* O32; bf16_t* O16;
    __device__ __forceinline__ void operator()(const AccT& acc, const pg8::Unit& u, int wr, int wc, int fr, int fq) const {
        epi_foreach(acc, u, wr, wc, fr, fq, [&](int row, int col, f32x4 v0, f32x4 v1) {
            const size_t off = (size_t)row * DM + col;
            const f32x4 r0 = *(const f32x4*)(X + off) + v0, r1 = *(const f32x4*)(X + off + 4) + v1;
            *(f32x4*)(O32 + off) = r0; *(f32x4*)(O32 + off + 4) = r1;
            u32x4 w; w.x = cvt_pk_bf16(r0[0], r0[1]); w.y = cvt_pk_bf16(r0[2], r0[3]); w.z = cvt_pk_bf16(r1[0], r1[1]); w.w = cvt_pk_bf16(r1[2], r1[3]);
            *(u32x4*)(O16 + off) = w; });
    }
};
__device__ __forceinline__ size_t hm_off(int row, int hh, int d) { return ((size_t)(row & ~4095) * 8 + (size_t)hh * 4096 + (size_t)(row & 4095)) * 128 + d; }
__device__ __forceinline__ u32x4 pack8f(const float* o) { u32x4 w; w.x = cvt_pk_bf16(o[0], o[1]); w.y = cvt_pk_bf16(o[2], o[3]); w.z = cvt_pk_bf16(o[4], o[5]); w.w = cvt_pk_bf16(o[6], o[7]); return w; }
struct EpiProj {
    static constexpr bool PERM = true;
    unsigned char* ws; unsigned char* dout;
    __device__ __forceinline__ void operator()(const AccT& acc, const pg8::Unit& u, int wr, int wc, int fr, int fq) const {
        const int pn = u.pn;
        if (pn < 12 || (pn >= 29 && pn < 33)) {
            bf16_t* base; int tl;
            if (pn < 4) { base = (bf16_t*)(dout + DO_AQ); tl = pn; } else if (pn < 8) { base = (bf16_t*)(ws + WS_AK); tl = pn - 4; }
            else if (pn < 12) { base = (bf16_t*)(ws + WS_AV); tl = pn - 8; } else { base = (bf16_t*)(ws + WS_RV); tl = pn - 29; }
            epi_foreach(acc, u, wr, wc, fr, fq, [&](int row, int col, f32x4 v0, f32x4 v1) {
                const int colt = col & 255; const float o[8] = {v0[0], v0[1], v0[2], v0[3], v1[0], v1[1], v1[2], v1[3]};
                *(u32x4*)(base + hm_off(row, 2 * tl + (colt >> 7), colt & 127)) = pack8f(o); });
        } else if (pn == 20) {
            asm volatile("" : "+v"(fr), "+v"(fq));
            if (wc == 0) {
                bf16_t* IK = (bf16_t*)(ws + WS_IK);
#pragma unroll
                for (int ai = 0; ai < 2; ++ai)
#pragma unroll
                    for (int m = 0; m < 4; ++m) {
                        const int row = u.pm * 256 + ai * 128 + wr * 64 + m * 16 + fr;
                        float x[16];
#pragma unroll
                        for (int j = 0; j < 4; ++j) { x[j] = acc[ai][0][m][0][j]; x[4 + j] = acc[ai][0][m][1][j]; x[8 + j] = acc[ai][1][m][0][j]; x[12 + j] = acc[ai][1][m][1][j]; }
                        float sum = 0.f;
#pragma unroll
                        for (int j = 0; j < 16; ++j) sum += x[j];
                        sum += __shfl_xor(sum, 16); sum += __shfl_xor(sum, 32);
                        const float mu = sum * (1.0f / 64.0f); float q = 0.f;
#pragma unroll
                        for (int j = 0; j < 16; ++j) { x[j] -= mu; q += x[j] * x[j]; }
                        q += __shfl_xor(q, 16); q += __shfl_xor(q, 32);
                        const float rs = 1.0f / sqrtf(q * (1.0f / 64.0f) + EPS);
#pragma unroll
                        for (int j = 0; j < 16; ++j) x[j] *= rs;
                        *(u32x4*)(IK + (size_t)row * 64 + 8 * fq) = pack8f(x); *(u32x4*)(IK + (size_t)row * 64 + 32 + 8 * fq) = pack8f(x + 8);
                        asm volatile("" ::: "memory");
                    }
            } else if (wc == 1) {
                float* IW = (float*)(ws + WS_IW);
                if (fq < 2) {
#pragma unroll
                    for (int ai = 0; ai < 2; ++ai)
#pragma unroll
                        for (int m = 0; m < 4; ++m) {
                            const int row = u.pm * 256 + ai * 128 + wr * 64 + m * 16 + fr;
                            *(f32x4*)(IW + (size_t)row * 16 + 8 * fq) = acc[ai][0][m][0] * 0.25f; *(f32x4*)(IW + (size_t)row * 16 + 8 * fq + 4) = acc[ai][0][m][1] * 0.25f;
                        }
                }
            }
        } else if (pn >= 21 && pn < 29) {
            asm volatile("" : "+v"(fr), "+v"(fq));
            const bool isk = pn >= 25; const int tl = isk ? pn - 25 : pn - 21; const float sc = isk ? 0.08838834764831845f : 1.0f;
            bf16_t* base = (bf16_t*)(ws + (isk ? WS_RK : WS_RQ)); const f32x4* rope = (const f32x4*)(ws + WS_ROPE);
            const int hh = 2 * tl + (wc >> 1), d0 = 32 * (wc & 1) + 8 * fq;
#pragma unroll
            for (int ai = 0; ai < 2; ++ai)
#pragma unroll
                for (int m = 0; m < 4; ++m) {
                    const int row = u.pm * 256 + ai * 128 + wr * 64 + m * 16 + fr;
                    const f32x4* rp = rope + ((size_t)row * 64 + d0) / 2;
                    float x1[8], x2[8], y1[8], y2[8];
#pragma unroll
                    for (int j = 0; j < 4; ++j) { x1[j] = acc[ai][0][m][0][j]; x1[4 + j] = acc[ai][0][m][1][j]; x2[j] = acc[ai][1][m][0][j]; x2[4 + j] = acc[ai][1][m][1][j]; }
#pragma unroll
                    for (int jj = 0; jj < 4; ++jj) { const f32x4 cs = rp[jj];
                        y1[2 * jj] = (x1[2 * jj] * cs[0] - x2[2 * jj] * cs[1]) * sc; y2[2 * jj] = (x1[2 * jj] * cs[1] + x2[2 * jj] * cs[0]) * sc;
                        y1[2 * jj + 1] = (x1[2 * jj + 1] * cs[2] - x2[2 * jj + 1] * cs[3]) * sc; y2[2 * jj + 1] = (x1[2 * jj + 1] * cs[3] + x2[2 * jj + 1] * cs[2]) * sc; }
                    const size_t o = hm_off(row, hh, d0);
                    *(u32x4*)(base + o) = pack8f(y1); *(u32x4*)(base + o + 64) = pack8f(y2);
                    asm volatile("" ::: "memory");
                }
        } else {
            bf16_t* base; int ld, c0, act;
            if (pn < 16) { base = (bf16_t*)(ws + WS_AZ); ld = 1024; c0 = (pn - 12) * 256; act = 0; }
            else if (pn < 20) { base = (bf16_t*)(dout + DO_IQ); ld = 1024; c0 = (pn - 16) * 256; act = 1; }
            else if (pn < 37) { base = (bf16_t*)(ws + WS_RZ); ld = 1024; c0 = (pn - 33) * 256; act = 0; }
            else if (pn < 45) { base = (bf16_t*)(ws + WS_GA); ld = 2048; c0 = (pn - 37) * 256; act = 2; }
            else { base = (bf16_t*)(ws + WS_GB); ld = 2048; c0 = (pn - 45) * 256; act = 2; }
            epi_foreach(acc, u, wr, wc, fr, fq, [&](int row, int col, f32x4 v0, f32x4 v1) {
                float o[8] = {v0[0], v0[1], v0[2], v0[3], v1[0], v1[1], v1[2], v1[3]};
#pragma unroll
                for (int j = 0; j < 8; ++j) o[j] = act == 0 ? siluf_(o[j]) : (act == 1 ? o[j] * 0.125f : sigmoidf_(o[j]));
                *(u32x4*)(base + (size_t)row * ld + c0 + (col & 255)) = pack8f(o); });
        }
    }
};

constexpr int NWAVES = 8, NTHREADS = 512;
constexpr int LDS_BYTES = 147456;
struct Args {
    const float* x; const float* p; const int* pos; const float* w_in; const float* norm_gain; const float* w_a; const float* w_b; const float* w_o;
    const float* gn_gain; const float* w_ple; const float* w_pg; const float* rel_bias; const float* final_gain;
    float* out; unsigned char* ws; int ph_lo, ph_hi; int coop, pad;
};
struct Frame { LAS unsigned char* lds; int tid, lane, wave, G, vcu; };
__device__ __forceinline__ void frame_ids(Frame& F) { int t = threadIdx.x; asm volatile("" : "+v"(t)); F.tid = t; F.lane = t & 63; F.wave = __builtin_amdgcn_readfirstlane(t >> 6); }

__device__ __forceinline__ void transpose_item(const float* W, int K, int N, int src_c0, int cnt, bf16_t* WT, int dst_r0, int k0, LAS float* scr, int lane) {
    const int c = lane & 31;
#pragma unroll 8
    for (int i = 0; i < 32; ++i) { const int kk = 2 * i + (lane >> 5); float v = 0.f; if (src_c0 >= 0 && c < cnt) v = W[(size_t)(k0 + kk) * N + src_c0 + c]; scr[kk * 33 + c] = v; }
    LDS_WAIT(); asm volatile("" ::: "memory");
    const int c8 = lane & 7;
#pragma unroll
    for (int j = 0; j < 4; ++j) { const int n = (lane >> 3) + 8 * j; const LAS float* s = scr + (8 * c8) * 33 + n;
        u32x4 o; o.x = pk2(s[0 * 33], s[1 * 33]); o.y = pk2(s[2 * 33], s[3 * 33]); o.z = pk2(s[4 * 33], s[5 * 33]); o.w = pk2(s[6 * 33], s[7 * 33]);
        *(u32x4*)(WT + (size_t)(dst_r0 + n) * K + k0 + 8 * c8) = o; }
    LDS_WAIT(); asm volatile("" ::: "memory");
}
__device__ __forceinline__ int win_src(int blk, int& cnt) {
    const int tile = blk >> 3, sb = blk & 7; cnt = 32;
    if (tile < 20) return tile * 256 + 32 * sb;
    if (tile == 20) { if (sb == 0) return 5120; if (sb == 4) return 5152; if (sb == 1) { cnt = 16; return 5184; } return -1; }
    if (tile < 29) { const int rk = tile >= 25, tl = rk ? tile - 25 : tile - 21, bj = sb >> 2, wc = sb & 3;
        return (rk ? 6224 : 5200) + (2 * tl + (wc >> 1)) * 128 + bj * 64 + 32 * (wc & 1); }
    if (tile < 37) return 7248 + (tile - 29) * 256 + 32 * sb;
    return 9296 + (tile - 37) * 256 + 32 * sb;
}
__device__ __forceinline__ void p0_prologue(const Args& a, Frame& F) {
    LAS float* scr = (LAS float*)(F.lds + F.wave * 16384);
    const int gw = F.vcu * NWAVES + F.wave, NGW = F.G * NWAVES;
    unsigned char* ws = a.ws;
    constexpr int KB_IN = DM / 64;
    constexpr int I_IN = KB_IN * (NWIN_PAD / 32);
    constexpr int I_A = (1024 / 64) * (DM / 32);
    constexpr int I_O = (DM / 64) * (DM / 32);
    constexpr int I_PLE = (PLE / 64) * (DM / 32);
    constexpr int NITEMS = I_IN + 2 * I_A + 2 * I_O + I_PLE;
    for (int it = gw; it < NITEMS; it += NGW) {
        int r = it;
        if (r < I_IN) { const int blk = r / KB_IN, kb = r % KB_IN; int cnt; const int src = win_src(blk, cnt);
            transpose_item(a.w_in, DM, NWIN, src, cnt, (bf16_t*)(ws + WS_WIN), blk * 32, kb * 64, scr, F.lane); continue; } r -= I_IN;
        if (r < I_A) { const int blk = r / 16, kb = r % 16; transpose_item(a.w_a, 1024, DM, blk * 32, 32, (bf16_t*)(ws + WS_WA), blk * 32, kb * 64, scr, F.lane); continue; } r -= I_A;
        if (r < I_A) { const int blk = r / 16, kb = r % 16; transpose_item(a.w_b, 1024, DM, blk * 32, 32, (bf16_t*)(ws + WS_WB), blk * 32, kb * 64, scr, F.lane); continue; } r -= I_A;
        if (r < I_O) { const int blk = r / 32, kb = r % 32; transpose_item(a.w_o, DM, DM, blk * 32, 32, (bf16_t*)(ws + WS_WO), blk * 32, kb * 64, scr, F.lane); continue; } r -= I_O;
        if (r < I_O) { const int blk = r / 32, kb = r % 32; transpose_item(a.w_pg, DM, DM, blk * 32, 32, (bf16_t*)(ws + WS_WPG), blk * 32, kb * 64, scr, F.lane); continue; } r -= I_O;
        { const int blk = r / 4, kb = r % 4; transpose_item(a.w_ple, PLE, DM, blk * 32, 32, (bf16_t*)(ws + WS_WPLE), blk * 32, kb * 64, scr, F.lane); }
    }
    bf16_t* H = (bf16_t*)((unsigned char*)a.out + DO_H); bf16_t* PB = (bf16_t*)(ws + WS_PB);
    for (int m = gw; m < MTOK; m += NGW) {
        const f32x4* xr = (const f32x4*)(a.x + (size_t)m * DM) + F.lane; const f32x4* gr = (const f32x4*)a.norm_gain + F.lane;
        f32x4 v[8]; float s = 0.f;
#pragma unroll
        for (int j = 0; j < 8; ++j) { v[j] = xr[64 * j]; s += (v[j][0] * v[j][0] + v[j][1] * v[j][1]) + (v[j][2] * v[j][2] + v[j][3] * v[j][3]); }
        const float rstd = 1.0f / sqrtf(wave_sum(s) * (1.0f / DM) + EPS);
        u32x2* o8 = (u32x2*)(H + (size_t)m * DM) + F.lane;
#pragma unroll
        for (int j = 0; j < 8; ++j) { const f32x4 g = gr[64 * j]; u32x2 w; w.x = pk2(v[j][0] * rstd * g[0], v[j][1] * rstd * g[1]); w.y = pk2(v[j][2] * rstd * g[2], v[j][3] * rstd * g[3]); o8[64 * j] = w; }
        const f32x4 pv = *((const f32x4*)(a.p + (size_t)m * PLE) + F.lane);
        u32x2 w; w.x = pk2(pv[0], pv[1]); w.y = pk2(pv[2], pv[3]); *((u32x2*)(PB + (size_t)m * PLE) + F.lane) = w;
    }
    f32x2* rope = (f32x2*)(ws + WS_ROPE);
    for (int e = (F.vcu * NTHREADS + F.tid); e < MTOK * 64; e += F.G * NTHREADS) {
        const int m = e >> 6, i = e & 63;
        const float invf = exp2f(-(float)i * (1.0f / 64.0f) * 13.287712379549449f);
        const float ang = (float)a.pos[m] * invf;
        const double ad = (double)ang;
        rope[e] = (f32x2){(float)cos(ad), (float)sin(ad)};
    }
}
__device__ __forceinline__ void p_final_norm(const Args& a, Frame& F) {
    const int gw = F.vcu * NWAVES + F.wave, NGW = F.G * NWAVES;
    for (int m = gw; m < MTOK; m += NGW) {
        f32x4* xr = (f32x4*)(a.out + (size_t)m * DM) + F.lane; const f32x4* gr = (const f32x4*)a.final_gain + F.lane;
        f32x4 v[8]; float s = 0.f;
#pragma unroll
        for (int j = 0; j < 8; ++j) { v[j] = xr[64 * j]; s += (v[j][0] * v[j][0] + v[j][1] * v[j][1]) + (v[j][2] * v[j][2] + v[j][3] * v[j][3]); }
        const float rstd = 1.0f / sqrtf(wave_sum(s) * (1.0f / DM) + EPS);
#pragma unroll
        for (int j = 0; j < 8; ++j) { const f32x4 g = gr[64 * j]; xr[64 * j] = (f32x4){v[j][0] * rstd * g[0], v[j][1] * rstd * g[1], v[j][2] * rstd * g[2], v[j][3] * rstd * g[3]}; }
    }
}

namespace att {
typedef short s16x4 __attribute__((ext_vector_type(4)));
typedef float f32x16 __attribute__((ext_vector_type(16)));
#define KSWZ(row, colB) ((row) * 256 + ((colB) ^ (((row) & 7) << 4)))
#define SBAR() __builtin_amdgcn_sched_barrier(0)
__device__ __forceinline__ int v_st(int k, int c) { const int kk = (k & ~0xC) | ((k & 4) << 1) | ((k & 8) >> 1); return ((kk >> 3) * 4 + (c >> 5)) * 512 + ((kk & 7) * 32 + (c & 31)) * 2; }
__device__ __forceinline__ int v_rd_base(int lane) { return ((lane & 3) << 3) | (((lane >> 2) & 3) << 6) | (((lane >> 4) & 1) << 5) | (((lane >> 5) & 1) << 8); }
constexpr int v_rd_off(int d0, int ks, int half) { return d0 * 512 + ks * 4096 + half * 2048; }
__device__ __forceinline__ int crow(int r, int hi) { return (r & 3) + 8 * (r >> 2) + 4 * hi; }
#define TRRD(dst, vb, off) asm volatile("ds_read_b64_tr_b16 %0, %1 offset:%2" : "=&v"(dst) : "v"(vb), "i"(off) : "memory")
#define TRRDV(dst, addr) asm volatile("ds_read_b64_tr_b16 %0, %1" : "=&v"(dst) : "v"(addr) : "memory")
__device__ __forceinline__ void qkt(f32x16& p0, f32x16& p1, const LAS unsigned char* Kb, int r32, int hi, const bf16x8* qr) {
    p0 = f32x16{}; p1 = f32x16{};
    const LAS unsigned char* kb[4];
#pragma unroll
    for (int dd = 0; dd < 4; ++dd) kb[dd] = Kb + KSWZ(r32, (dd * 16 + hi * 8) * 2);
#pragma unroll
    for (int d0 = 0; d0 < 8; ++d0) { const LAS unsigned char* a = kb[d0 & 3] + (d0 >> 2) * 128;
        const bf16x8 b0 = *(const LAS bf16x8*)a; const bf16x8 b1 = *(const LAS bf16x8*)(a + 32 * 256);
        p0 = __builtin_amdgcn_mfma_f32_32x32x16_bf16(b0, qr[d0], p0, 0, 0, 0);
        p1 = __builtin_amdgcn_mfma_f32_32x32x16_bf16(b1, qr[d0], p1, 0, 0, 0); }
}
template <int VOFF>
__device__ __forceinline__ void pv_tile(f32x16* o, int vb, bf16x8 pa0, bf16x8 pa1, bf16x8 pa2, bf16x8 pa3) {
#define PV_D0(d0) do { s16x4 l0, l1, l2, l3, h0, h1, h2, h3; constexpr int b_ = VOFF + v_rd_off(d0, 0, 0); \
        TRRD(l0, vb, b_); TRRD(h0, vb, b_ + 2048); TRRD(l1, vb, b_ + 4096); TRRD(h1, vb, b_ + 6144); TRRD(l2, vb, b_ + 8192); TRRD(h2, vb, b_ + 10240); TRRD(l3, vb, b_ + 12288); TRRD(h3, vb, b_ + 14336); \
        asm volatile("s_waitcnt lgkmcnt(0)" ::: "memory"); SBAR(); \
        o[d0] = __builtin_amdgcn_mfma_f32_32x32x16_bf16(pa0, (bf16x8){l0[0], l0[1], l0[2], l0[3], h0[0], h0[1], h0[2], h0[3]}, o[d0], 0, 0, 0); \
        o[d0] = __builtin_amdgcn_mfma_f32_32x32x16_bf16(pa1, (bf16x8){l1[0], l1[1], l1[2], l1[3], h1[0], h1[1], h1[2], h1[3]}, o[d0], 0, 0, 0); \
        o[d0] = __builtin_amdgcn_mfma_f32_32x32x16_bf16(pa2, (bf16x8){l2[0], l2[1], l2[2], l2[3], h2[0], h2[1], h2[2], h2[3]}, o[d0], 0, 0, 0); \
        o[d0] = __builtin_amdgcn_mfma_f32_32x32x16_bf16(pa3, (bf16x8){l3[0], l3[1], l3[2], l3[3], h3[0], h3[1], h3[2], h3[3]}, o[d0], 0, 0, 0); } while (0)
    PV_D0(0); PV_D0(1); PV_D0(2); PV_D0(3);
#undef PV_D0
}
__device__ __forceinline__ void pack_p(const f32x16& p0, const f32x16& p1, bf16x8& pa0, bf16x8& pa1, bf16x8& pa2, bf16x8& pa3) {
#define PK4(P, B_, OUT) do { const unsigned a0 = cvt_pk_bf16(P[B_+0], P[B_+1]), a1 = cvt_pk_bf16(P[B_+2], P[B_+3]); \
        const unsigned b0 = cvt_pk_bf16(P[B_+4], P[B_+5]), b1 = cvt_pk_bf16(P[B_+6], P[B_+7]); \
        auto r0 = __builtin_amdgcn_permlane32_swap(a0, b0, false, false); auto r1 = __builtin_amdgcn_permlane32_swap(a1, b1, false, false); \
        u32x4 w = {r0[0], r1[0], r0[1], r1[1]}; OUT = __builtin_bit_cast(bf16x8, w); } while (0)
    PK4(p0, 0, pa0); PK4(p0, 8, pa1); PK4(p1, 0, pa2); PK4(p1, 8, pa3);
#undef PK4
}
}

__device__ __forceinline__ float ret_log2g(int h) { return log2f(1.0f - exp2f(-5.0f - (float)h)); }
__device__ __forceinline__ void p_ret_kv(const Args& a, Frame& F) {
    using namespace att;
    const bf16_t* RK = (const bf16_t*)(a.ws + WS_RK); const bf16_t* RV = (const bf16_t*)(a.ws + WS_RV); bf16_t* KVT = (bf16_t*)((unsigned char*)a.out + DO_KVT);
    LAS unsigned char* Kl = F.lds; LAS unsigned char* Vl = F.lds + 16384;
    const int tid = F.tid, lane = F.lane, wid = F.wave, r32 = lane & 31, hi = lane >> 5;
    const int sr = tid >> 4, sc = (tid & 15) * 8;
    const int a0 = wid >> 1, dp = (wid & 1) * 2;
    const int vbK = (int)(uintptr_t)Kl + v_rd_base(lane), vbV = (int)(uintptr_t)Vl + v_rd_base(lane);
    for (int item = F.vcu; item < NB * 8 * 64; item += F.G) {
        const int bh = item >> 6, n = item & 63, h = bh & 7;
        const float lg = ret_log2g(h);
        const size_t rowbase = ((size_t)bh * SEQ + (size_t)n * 64) * 128;
#pragma unroll
        for (int i = 0; i < 2; ++i) { const int t = sr + 32 * i;
            const u32x4 kq = *(const u32x4*)(RK + rowbase + (size_t)t * 128 + sc); const u32x4 vq = *(const u32x4*)(RV + rowbase + (size_t)t * 128 + sc);
            const float w = exp2f((float)(63 - t) * lg);
            float kf[8]; kf[0] = bf2f((unsigned short)(kq.x & 0xffff)) * w; kf[1] = bf2f((unsigned short)(kq.x >> 16)) * w; kf[2] = bf2f((unsigned short)(kq.y & 0xffff)) * w; kf[3] = bf2f((unsigned short)(kq.y >> 16)) * w;
            kf[4] = bf2f((unsigned short)(kq.z & 0xffff)) * w; kf[5] = bf2f((unsigned short)(kq.z >> 16)) * w; kf[6] = bf2f((unsigned short)(kq.w & 0xffff)) * w; kf[7] = bf2f((unsigned short)(kq.w >> 16)) * w;
            *(LAS u32x4*)(Kl + v_st(t, sc)) = pack8f(kf); *(LAS u32x4*)(Vl + v_st(t, sc)) = vq; }
        __syncthreads();
        f32x16 acc[2] = {};
#pragma unroll
        for (int ks = 0; ks < 4; ++ks) {
            s16x4 al, ah, b0l, b0h, b1l, b1h;
            TRRDV(al, vbK + v_rd_off(a0, ks, 0)); TRRDV(ah, vbK + v_rd_off(a0, ks, 1));
            TRRDV(b0l, vbV + v_rd_off(dp, ks, 0)); TRRDV(b0h, vbV + v_rd_off(dp, ks, 1));
            TRRDV(b1l, vbV + v_rd_off(dp + 1, ks, 0)); TRRDV(b1h, vbV + v_rd_off(dp + 1, ks, 1));
            asm volatile("s_waitcnt lgkmcnt(0)" ::: "memory"); SBAR();
            const bf16x8 af = (bf16x8){al[0], al[1], al[2], al[3], ah[0], ah[1], ah[2], ah[3]};
            acc[0] = __builtin_amdgcn_mfma_f32_32x32x16_bf16(af, (bf16x8){b0l[0], b0l[1], b0l[2], b0l[3], b0h[0], b0h[1], b0h[2], b0h[3]}, acc[0], 0, 0, 0);
            acc[1] = __builtin_amdgcn_mfma_f32_32x32x16_bf16(af, (bf16x8){b1l[0], b1l[1], b1l[2], b1l[3], b1h[0], b1h[1], b1h[2], b1h[3]}, acc[1], 0, 0, 0);
        }
        bf16_t* dst = KVT + (size_t)item * 16384;
#pragma unroll
        for (int e = 0; e < 2; ++e)
#pragma unroll
            for (int g = 0; g < 4; ++g) { u32x2 w; w.x = cvt_pk_bf16(acc[e][4 * g], acc[e][4 * g + 1]); w.y = cvt_pk_bf16(acc[e][4 * g + 2], acc[e][4 * g + 3]);
                *(u32x2*)(dst + (size_t)(32 * (dp + e) + r32) * 128 + 32 * a0 + 8 * g + 4 * hi) = w; }
        __syncthreads();
    }
}
__device__ __forceinline__ void p_ret_scan(const Args& a, Frame& F) {
    bf16_t* KVT = (bf16_t*)((unsigned char*)a.out + DO_KVT);
    for (int idx = F.vcu * NTHREADS + F.tid; idx < 32 * 2048; idx += F.G * NTHREADS) {
        const int bh = idx >> 11, e8 = idx & 2047, h = bh & 7;
        const float dec = exp2f(64.0f * ret_log2g(h));
        float st[8] = {0.f, 0.f, 0.f, 0.f, 0.f, 0.f, 0.f, 0.f};
        u32x4* p = (u32x4*)(KVT + (size_t)bh * 64 * 16384 + (size_t)e8 * 8);
#pragma unroll 4
        for (int n = 0; n < 64; ++n) {
            const u32x4 kv = p[(size_t)n * 2048];
            p[(size_t)n * 2048] = pack8f(st);
            st[0] = st[0] * dec + bf2f((unsigned short)(kv.x & 0xffff)); st[1] = st[1] * dec + bf2f((unsigned short)(kv.x >> 16));
            st[2] = st[2] * dec + bf2f((unsigned short)(kv.y & 0xffff)); st[3] = st[3] * dec + bf2f((unsigned short)(kv.y >> 16));
            st[4] = st[4] * dec + bf2f((unsigned short)(kv.z & 0xffff)); st[5] = st[5] * dec + bf2f((unsigned short)(kv.z >> 16));
            st[6] = st[6] * dec + bf2f((unsigned short)(kv.w & 0xffff)); st[7] = st[7] * dec + bf2f((unsigned short)(kv.w >> 16));
        }
    }
}
__device__ __forceinline__ void p_ret_out(const Args& a, Frame& F) {
    using namespace att;
    const bf16_t* RQ = (const bf16_t*)(a.ws + WS_RQ); const bf16_t* RK = (const bf16_t*)(a.ws + WS_RK); const bf16_t* RV = (const bf16_t*)(a.ws + WS_RV);
    const bf16_t* RZ = (const bf16_t*)(a.ws + WS_RZ); const bf16_t* KVT = (const bf16_t*)((const unsigned char*)a.out + DO_KVT); bf16_t* BO = (bf16_t*)(a.ws + WS_BO);
    const int tid = F.tid, lane = F.lane, wid = F.wave, r32 = lane & 31, hi = lane >> 5;
    const int pr = wid >> 1, qblk = wid & 1, lt = tid & 127;
    LAS unsigned char* Kl = F.lds + pr * 32768; LAS unsigned char* Vl = Kl + 16384;
    const int vb = (int)(uintptr_t)Vl + v_rd_base(lane);
    for (int it0 = F.vcu * 4; it0 < NB * 8 * 64; it0 += F.G * 4) {
        const int item = it0 + pr, bh = item >> 6, n = item & 63, h = bh & 7, b = bh >> 3;
        const float lg = ret_log2g(h);
        const size_t rowbase = ((size_t)bh * SEQ + (size_t)n * 64) * 128;
#pragma unroll
        for (int i = 0; i < 8; ++i) { const int c = lt + 128 * i, t = c >> 4, sc = (c & 15) * 8;
            *(LAS u32x4*)(Kl + KSWZ(t, sc * 2)) = *(const u32x4*)(RK + rowbase + (size_t)t * 128 + sc);
            *(LAS u32x4*)(Vl + v_st(t, sc)) = *(const u32x4*)(RV + rowbase + (size_t)t * 128 + sc); }
        bf16x8 qr[8];
#pragma unroll
        for (int d0 = 0; d0 < 8; ++d0) qr[d0] = *(const bf16x8*)(RQ + rowbase + (size_t)(32 * qblk + r32) * 128 + d0 * 16 + hi * 8);
        __syncthreads();
        f32x16 p0, p1;
        qkt(p0, p1, Kl, r32, hi, qr);
        const int iq = 32 * qblk + r32;
#pragma unroll
        for (int r = 0; r < 16; ++r) { const int j0 = crow(r, hi), j1 = j0 + 32;
            const int e0 = (iq > j0 ? iq - j0 : j0 - iq) - iq - 1, e1 = (iq > j1 ? iq - j1 : j1 - iq) - iq - 1;
            p0[r] *= exp2f((float)e0 * lg); p1[r] *= exp2f((float)e1 * lg); }
        bf16x8 pa0, pa1, pa2, pa3;
        pack_p(p0, p1, pa0, pa1, pa2, pa3);
        f32x16 o[4] = {};
        SBAR();
        pv_tile<0>(o, vb, pa0, pa1, pa2, pa3);
        const bf16_t* ST = KVT + (size_t)item * 16384;
#pragma unroll
        for (int d0 = 0; d0 < 4; ++d0)
#pragma unroll
            for (int kk = 0; kk < 8; ++kk) { const bf16x8 sf = *(const bf16x8*)(ST + (size_t)(32 * d0 + r32) * 128 + 16 * kk + 8 * hi);
                o[d0] = __builtin_amdgcn_mfma_f32_32x32x16_bf16(qr[kk], sf, o[d0], 0, 0, 0); }
        float gain[4];
#pragma unroll
        for (int d0 = 0; d0 < 4; ++d0) gain[d0] = a.gn_gain[h * 128 + 32 * d0 + r32];
#pragma unroll
        for (int r = 0; r < 16; ++r) { const int il = 32 * qblk + crow(r, hi); const float fs = exp2f((float)(il + 1) * lg);
            float y0 = o[0][r] * fs, y1 = o[1][r] * fs, y2 = o[2][r] * fs, y3 = o[3][r] * fs;
            float s1 = (y0 + y1) + (y2 + y3), s2 = (y0 * y0 + y1 * y1) + (y2 * y2 + y3 * y3);
#pragma unroll
            for (int k = 1; k < 32; k <<= 1) { s1 += __shfl_xor(s1, k); s2 += __shfl_xor(s2, k); }
            const float mu = s1 * (1.0f / 128.0f); const float var = fmaxf(s2 * (1.0f / 128.0f) - mu * mu, 0.f); const float rs = 1.0f / sqrtf(var + EPS);
            const size_t m = (size_t)b * SEQ + (size_t)n * 64 + il;
            const bf16_t* rz = RZ + m * 1024 + h * 128 + r32; bf16_t* bo = BO + m * 1024 + h * 128 + r32;
            const float v0 = (y0 - mu) * rs * gain[0] * bf2f(rz[0]), v1 = (y1 - mu) * rs * gain[1] * bf2f(rz[32]), v2 = (y2 - mu) * rs * gain[2] * bf2f(rz[64]), v3 = (y3 - mu) * rs * gain[3] * bf2f(rz[96]);
            const float n0 = __shfl_xor(v0, 1), n1 = __shfl_xor(v1, 1), n2 = __shfl_xor(v2, 1), n3 = __shfl_xor(v3, 1);
            if ((r32 & 1) == 0) { *(unsigned*)(bo) = cvt_pk_bf16(v0, n0); *(unsigned*)(bo + 32) = cvt_pk_bf16(v1, n1); *(unsigned*)(bo + 64) = cvt_pk_bf16(v2, n2); *(unsigned*)(bo + 96) = cvt_pk_bf16(v3, n3); }
        }
        __syncthreads();
    }
}

__device__ __forceinline__ void p_index(const Args& a, Frame& F) {
    using namespace att;
    const bf16_t* IQ = (const bf16_t*)((const unsigned char*)a.out + DO_IQ); const bf16_t* IK = (const bf16_t*)(a.ws + WS_IK); const float* IW = (const float*)(a.ws + WS_IW);
    unsigned* MASK = (unsigned*)(a.ws + WS_MASK);
    constexpr int NBIN = 1024, CAP = 256;
    const int tid = F.tid, lane = F.lane, wid = F.wave, r32 = lane & 31, hi = lane >> 5, pq = wid >> 1, e = wid & 1;
    LAS unsigned char* KS = F.lds;
    LAS unsigned* hist = (LAS unsigned*)(F.lds + 65536) + pq * 2 * NBIN;
    LAS float* part = (LAS float*)(F.lds + 98304) + pq * 8;
    LAS int* misc = (LAS int*)(F.lds + 98816) + pq * 16; LAS float* miscf = (LAS float*)(F.lds + 98816) + pq * 16;
    LAS float* cand = (LAS float*)(F.lds + 99072) + pq * 2 * CAP;
    const float NINF = -__builtin_inff(), PINF = __builtin_inff();
    int boff[4];
#pragma unroll
    for (int ks = 0; ks < 4; ++ks) boff[ks] = e * 4096 + r32 * 128 + (((2 * ks + hi) ^ (r32 & 7)) << 4);
    const unsigned sgo = (unsigned)((tid >> 3) * 64 + (((tid & 7) ^ ((tid >> 3) & 7)) * 8)) * 2u;
    for (int round = 0; round * F.G < 2048; ++round) {
        const int j = round * F.G + ((round & 1) ? F.G - 1 - F.vcu : F.vcu);
        if (j >= 2048) continue;
        const int c = 63 - (j >> 5), sub = j & 31, b = sub >> 3, pg = sub & 7;
        const int m0 = b * SEQ + 64 * c, ntile = 2 * (c + 1), ngrp = (ntile + 7) >> 3, ntzh = 4 * ((c >> 2) + 1);
        const bool need_sel = c >= 4;
        const int p = pg * 4 + pq;
        const int qrow = m0 + 2 * p + hi;
        bf16x8 af[4];
        { const int aq_ = (r32 >> 2) & 1, ah_ = (r32 & 3) + 4 * (r32 >> 3);
#pragma unroll
          for (int ks = 0; ks < 4; ++ks) af[ks] = *(const bf16x8*)(IQ + (size_t)(m0 + 2 * p + aq_) * 1024 + ah_ * 64 + 16 * ks + 8 * hi); }
        float wq[16];
#pragma unroll
        for (int q4 = 0; q4 < 4; ++q4) { const f32x4 w4 = *(const f32x4*)(IW + (size_t)qrow * 16 + 4 * q4); wq[4 * q4] = w4[0]; wq[4 * q4 + 1] = w4[1]; wq[4 * q4 + 2] = w4[2]; wq[4 * q4 + 3] = w4[3]; }
        const unsigned char* ikb = (const unsigned char*)(IK + (size_t)b * SEQ * 64);
#pragma unroll
        for (int i = 0; i < 4; ++i) __builtin_amdgcn_global_load_lds((const unsigned*)(ikb + sgo + i * 8192), (LAS unsigned*)(KS + wid * 1024 + i * 8192), 16, 0, 0);
        __syncthreads();
        float v[64];
        int lim_v = ntile - e; asm volatile("" : "+v"(lim_v));
#pragma unroll
        for (int g = 0; g < 16; ++g) {
            if (g < ngrp) {
                if (g + 1 < ngrp) { unsigned so_ = sgo; asm volatile("" : "+v"(so_));
                    const unsigned char* gb = ikb + (size_t)(g + 1) * 32768; LAS unsigned char* kn = KS + ((g + 1) & 1) * 32768 + wid * 1024;
#pragma unroll
                    for (int i = 0; i < 4; ++i) __builtin_amdgcn_global_load_lds((const unsigned*)(gb + so_ + i * 8192), (LAS unsigned*)(kn + i * 8192), 16, 0, 0); }
                const LAS unsigned char* kb = KS + (g & 1) * 32768;
#pragma unroll
                for (int i = 0; i < 4; ++i) {
                    f32x16 cc = {};
#pragma unroll
                    for (int ks = 0; ks < 4; ++ks) cc = __builtin_amdgcn_mfma_f32_32x32x16_bf16(af[ks], *(const LAS bf16x8*)(kb + i * 8192 + boff[ks]), cc, 0, 0, 0);
                    float idx = 0.f;
#pragma unroll
                    for (int r = 0; r < 16; ++r) idx += fmaxf(cc[r], 0.f) * wq[r];
                    v[g * 4 + i] = (g * 8 + 2 * i < lim_v) ? idx : NINF;
                    if (i & 1) __builtin_amdgcn_sched_barrier(0);
                }
                __syncthreads();
            } else {
#pragma unroll
                for (int i = 0; i < 4; ++i) v[g * 4 + i] = NINF;
            }
        }
        float T = NINF; int bstar = -1; bool ovf = false; float mn = 0.f, scale = 0.f;
        if (need_sel) {
            int lane_s = lane; asm volatile("" : "+v"(lane_s));
            const int r32s = lane_s & 31, his = lane_s >> 5;
            float lmn = PINF, lmx = NINF;
#pragma unroll
            for (int tt = 0; tt < 64; ++tt) { lmx = fmaxf(lmx, v[tt]); lmn = fminf(lmn, v[tt] == NINF ? PINF : v[tt]); }
#pragma unroll
            for (int k = 1; k < 32; k <<= 1) { const int pa = (lane_s ^ k) << 2; lmx = fmaxf(lmx, __builtin_bit_cast(float, __builtin_amdgcn_ds_bpermute(pa, __builtin_bit_cast(int, lmx)))); lmn = fminf(lmn, __builtin_bit_cast(float, __builtin_amdgcn_ds_bpermute(pa, __builtin_bit_cast(int, lmn)))); }
            if (r32s == 0) { part[(e * 2 + his) * 2] = lmn; part[(e * 2 + his) * 2 + 1] = lmx; }
#pragma unroll
            for (int k = 0; k < 4; ++k) *(LAS u32x4*)(F.lds + 65536 + (wid * 64 + lane_s + 512 * k) * 16) = (u32x4){0u, 0u, 0u, 0u};
            if (tid < 8) ((LAS int*)(F.lds + 98816))[(tid >> 1) * 16 + 4 + (tid & 1)] = 0;
            __syncthreads();
            mn = fminf(part[his * 2], part[(2 + his) * 2]); const float mx = fmaxf(part[his * 2 + 1], part[(2 + his) * 2 + 1]);
            scale = (mx > mn) ? (float)NBIN / (mx - mn) : 0.f;
#pragma unroll
            for (int tt = 0; tt < 64; ++tt) { if (v[tt] != NINF) { int bin = (int)((v[tt] - mn) * scale); bin = bin > NBIN - 1 ? NBIN - 1 : (bin < 0 ? 0 : bin);
                __hip_atomic_fetch_add(hist + his * NBIN + bin, 1u, __ATOMIC_RELAXED, __HIP_MEMORY_SCOPE_WORKGROUP); }
                if ((tt & 7) == 7) __builtin_amdgcn_sched_barrier(0); }
            __syncthreads();
            { unsigned cnt[16]; unsigned sum = 0;
#pragma unroll
              for (int k = 0; k < 4; ++k) { const u32x4 w = *(const LAS u32x4*)(hist + e * NBIN + 16 * lane_s + 4 * k); cnt[4 * k] = w.x; cnt[4 * k + 1] = w.y; cnt[4 * k + 2] = w.z; cnt[4 * k + 3] = w.w; }
#pragma unroll
              for (int k = 0; k < 16; ++k) sum += cnt[k];
              unsigned suf = sum;
#pragma unroll
              for (int k = 1; k < 64; k <<= 1) { const unsigned o = (unsigned)__builtin_amdgcn_ds_bpermute(((lane_s + k) & 63) << 2, (int)suf); if (lane_s + k < 64) suf += o; }
              const unsigned above = suf - sum;
              if (above < 256u && suf >= 256u) { unsigned run = above; int bs = 16 * lane_s; unsigned ca = above; bool found = false;
#pragma unroll
                  for (int k = 15; k >= 0; --k) { if (!found) { if (run + cnt[k] >= 256u) { bs = 16 * lane_s + k; ca = run; found = true; } else run += cnt[k]; } }
                  misc[e] = bs; misc[2 + e] = (int)ca; }
            }
            __syncthreads();
            bstar = misc[his];
            asm volatile("" : "+v"(mn), "+v"(scale));
#pragma unroll
            for (int tt = 0; tt < 64; ++tt) { if (v[tt] != NINF) { int bin = (int)((v[tt] - mn) * scale); bin = bin > NBIN - 1 ? NBIN - 1 : (bin < 0 ? 0 : bin);
                if (bin == bstar) { const int pos = __hip_atomic_fetch_add(misc + 4 + his, 1, __ATOMIC_RELAXED, __HIP_MEMORY_SCOPE_WORKGROUP); if (pos < CAP) cand[his * CAP + pos] = v[tt]; } }
                if ((tt & 7) == 7) __builtin_amdgcn_sched_barrier(0); }
            __syncthreads();
            { const int n = misc[4 + e], kk = 256 - misc[2 + e];
              if (n <= CAP) {
                  float ci[4]; int rk[4];
#pragma unroll
                  for (int k = 0; k < 4; ++k) { const int i = lane_s + 64 * k; ci[k] = i < n ? cand[e * CAP + i] : NINF; rk[k] = 0; }
                  for (int jj = 0; jj < n; ++jj) { const float cj = cand[e * CAP + jj];
#pragma unroll
                      for (int k = 0; k < 4; ++k) rk[k] += (cj > ci[k] || (cj == ci[k] && jj < lane_s + 64 * k)) ? 1 : 0; }
#pragma unroll
                  for (int k = 0; k < 4; ++k) if (lane_s + 64 * k < n && rk[k] == kk - 1) miscf[6 + e] = ci[k];
              } else if (lane_s == 0) miscf[6 + e] = NINF;
              if (lane_s == 0) misc[8 + e] = n > CAP ? 1 : 0; }
            __syncthreads();
            T = miscf[6 + his]; ovf = misc[8 + his] != 0;
            asm volatile("" : "+v"(mn), "+v"(scale));
        }
#pragma unroll
        for (int tt = 0; tt < 64; ++tt) if (tt < ntzh) { const int t = e + 2 * tt;
            bool sel = v[tt] != NINF;
            if (need_sel && sel) { if (ovf) { int bin = (int)((v[tt] - mn) * scale); bin = bin > NBIN - 1 ? NBIN - 1 : (bin < 0 ? 0 : bin); sel = bin >= bstar; } else sel = v[tt] >= T; }
            const unsigned long long bal = __ballot(sel);
            if (r32 == 0) MASK[(size_t)qrow * 128 + t] = hi ? (unsigned)(bal >> 32) : (unsigned)bal;
            if ((tt & 7) == 7) __builtin_amdgcn_sched_barrier(0); }
    }
}

__device__ __forceinline__ int t5_bucket(int rel) {
    const int n = rel < 0 ? -rel : rel; int bkt;
    if (n < 8) bkt = n; else { int k = (31 - __builtin_clz((unsigned)(n * n))) - 6; bkt = 8 + k; if (bkt > 15) bkt = 15; }
    return bkt + (rel > 0 ? 16 : 0);
}
__device__ __forceinline__ void attn_unit(const Args& a, Frame& F, int b, int h, int qb) {
    using namespace att;
    LAS unsigned char* Kl = F.lds; LAS unsigned char* Vl = F.lds + 32768;
    int tid = threadIdx.x; asm volatile("" : "+v"(tid));
    const int lane = tid & 63, wid = __builtin_amdgcn_readfirstlane(tid >> 6), r32 = lane & 31, hi = lane >> 5;
    LAS float* wsf = (LAS float*)(F.lds + 65536) + wid * 64; LAS float* BT = (LAS float*)(F.lds + 65536 + 2048);
    constexpr float LOG2E = 1.4426950408889634f, C2 = 0.08838834764831845f * LOG2E;
    const float NINF = -__builtin_inff();
    if (tid < 256) { const int rel = tid - 192; BT[tid] = (a.rel_bias[t5_bucket(rel) * 8 + h] - a.rel_bias[15 * 8 + h]) * LOG2E; }
    const size_t hb = ((size_t)(b * 8 + h) * SEQ) * 128;
    const bf16_t* AQh = (const bf16_t*)((const unsigned char*)a.out + DO_AQ) + hb; const bf16_t* AKh = (const bf16_t*)(a.ws + WS_AK) + hb; const bf16_t* AVh = (const bf16_t*)(a.ws + WS_AV) + hb;
    const int qpos = 256 * qb + 32 * wid + r32, cw = 4 * qb + (wid >> 1);
    const unsigned* MKb = (const unsigned*)(a.ws + WS_MASK) + (size_t)(b * SEQ + 256 * qb) * 128;
    const unsigned mko = (unsigned)(32 * wid + r32) * 128u;
    bf16x8 qr[8];
    { const unsigned qo = (unsigned)qpos * 128u + hi * 8u;
#pragma unroll
      for (int d0 = 0; d0 < 8; ++d0) qr[d0] = *(const bf16x8*)(AQh + qo + d0 * 16); }
    const int sr = tid >> 4, sc = (tid & 15) * 8, kws = KSWZ(sr, sc * 2), vs0 = v_st(sr, sc), vs1 = v_st(32 + sr, sc);
    const unsigned so = (unsigned)sr * 128u + sc;
    const int vb = (int)(uintptr_t)Vl + v_rd_base(lane);
    const int NT = 4 * (qb + 1);
    u32x4 k0, k1, v0, v1; u32x2 mw, mwn;
    { k0 = *(const u32x4*)(AKh + so); k1 = *(const u32x4*)(AKh + so + 32 * 128); v0 = *(const u32x4*)(AVh + so); v1 = *(const u32x4*)(AVh + so + 32 * 128);
      mw = *(const u32x2*)(MKb + mko);
      *(LAS u32x4*)(Kl + kws) = k0; *(LAS u32x4*)(Kl + kws + 32 * 256) = k1; *(LAS u32x4*)(Vl + vs0) = v0; *(LAS u32x4*)(Vl + vs1) = v1; }
    __syncthreads();
    float m_run = -1e30f, l_run = 0.f; f32x16 o[4] = {};
    mwn = mw;
#pragma unroll 1
    for (int t = 0; t < NT; ++t) {
        const int buf = t & 1;
        if (t + 1 < NT) { const bf16_t* kp = AKh + (size_t)(t + 1) * 8192; const bf16_t* vp = AVh + (size_t)(t + 1) * 8192;
            k0 = *(const u32x4*)(kp + so); k1 = *(const u32x4*)(kp + so + 32 * 128); v0 = *(const u32x4*)(vp + so); v1 = *(const u32x4*)(vp + so + 32 * 128);
            mwn = *(const u32x2*)(MKb + 2 * (t + 1) + mko); }
        f32x16 p0, p1;
        qkt(p0, p1, Kl + buf * 16384, r32, hi, qr);
        const unsigned w0s = mw.x >> (4 * hi), w1s = mw.y >> (4 * hi);
        const bool near = t >= cw - 2;
        const int relb = 64 * t + 4 * hi - qpos + 192;
        float tmax = NINF;
#pragma unroll
        for (int r = 0; r < 16; ++r) { const int bp = (r & 3) + 8 * (r >> 2);
            float z0 = p0[r] * C2, z1 = p1[r] * C2;
            if (near) { int i0 = relb + bp, i1 = i0 + 32; i0 = i0 < 0 ? 0 : (i0 > 255 ? 255 : i0); i1 = i1 < 0 ? 0 : (i1 > 255 ? 255 : i1); z0 += BT[i0]; z1 += BT[i1]; }
            z0 = ((w0s >> bp) & 1u) ? z0 : NINF; z1 = ((w1s >> bp) & 1u) ? z1 : NINF;
            p0[r] = z0; p1[r] = z1; tmax = fmaxf(tmax, fmaxf(z0, z1)); }
        tmax = fmaxf(tmax, __shfl_xor(tmax, 32));
        const float m_new = fmaxf(m_run, tmax), alpha = __builtin_amdgcn_exp2f(m_run - m_new); m_run = m_new;
        float rs = 0.f;
#pragma unroll
        for (int r = 0; r < 16; ++r) { p0[r] = __builtin_amdgcn_exp2f(p0[r] - m_new); p1[r] = __builtin_amdgcn_exp2f(p1[r] - m_new); rs += p0[r] + p1[r]; }
        rs += __shfl_xor(rs, 32);
        l_run = l_run * alpha + rs;
        if (__any(alpha < 1.f)) { if (hi == 0) wsf[r32] = alpha; LDS_WAIT();
#pragma unroll
            for (int d_ = 0; d_ < 4; ++d_)
#pragma unroll
                for (int r = 0; r < 16; ++r) o[d_][r] *= wsf[crow(r, hi)]; }
        bf16x8 pa0, pa1, pa2, pa3;
        pack_p(p0, p1, pa0, pa1, pa2, pa3);
        SBAR();
        if (buf == 0) pv_tile<0>(o, vb, pa0, pa1, pa2, pa3); else pv_tile<16384>(o, vb, pa0, pa1, pa2, pa3);
        if (t + 1 < NT) { LAS unsigned char* Kn = Kl + (buf ^ 1) * 16384; LAS unsigned char* Vn = Vl + (buf ^ 1) * 16384;
            *(LAS u32x4*)(Kn + kws) = k0; *(LAS u32x4*)(Kn + kws + 32 * 256) = k1; *(LAS u32x4*)(Vn + vs0) = v0; *(LAS u32x4*)(Vn + vs1) = v1; }
        mw = mwn;
        __syncthreads();
    }
    if (hi == 0) wsf[32 + r32] = l_run; LDS_WAIT();
    { int r32e = r32, hie = hi; asm volatile("" : "+v"(r32e), "+v"(hie));
      const size_t ub = ((size_t)b * SEQ + 256 * qb + 32 * wid) * 1024 + h * 128;
      const bf16_t* AZu = (const bf16_t*)(a.ws + WS_AZ) + ub; bf16_t* AOu = (bf16_t*)((unsigned char*)a.out + DO_AO) + ub;
#pragma unroll
      for (int r = 0; r < 16; ++r) { const float rl = 1.0f / wsf[32 + crow(r, hie)];
        const unsigned eo = (unsigned)crow(r, hie) * 1024u + r32e;
        const float x0 = o[0][r] * rl * bf2f(AZu[eo]), x1 = o[1][r] * rl * bf2f(AZu[eo + 32]), x2 = o[2][r] * rl * bf2f(AZu[eo + 64]), x3 = o[3][r] * rl * bf2f(AZu[eo + 96]);
        const float n0 = __shfl_xor(x0, 1), n1 = __shfl_xor(x1, 1), n2 = __shfl_xor(x2, 1), n3 = __shfl_xor(x3, 1);
        if ((r32e & 1) == 0) { *(unsigned*)(AOu + eo) = cvt_pk_bf16(x0, n0); *(unsigned*)(AOu + eo + 32) = cvt_pk_bf16(x1, n1); *(unsigned*)(AOu + eo + 64) = cvt_pk_bf16(x2, n2); *(unsigned*)(AOu + eo + 96) = cvt_pk_bf16(x3, n3); } } }
    __syncthreads();
}
__device__ __forceinline__ void p_attn(const Args& a, Frame& F) {
    for (int u2 = F.vcu; u2 < 256; u2 += F.G) { const int bh = u2 >> 3, s = u2 & 7;
        for (int pass = 0; pass < 2; ++pass) attn_unit(a, F, bh >> 3, bh & 7, pass ? 15 - s : s); }
}

typedef __attribute__((address_space(1))) unsigned gu32;
#define XB_TMO      128
#define XB_XCNT(j)  (256  + 64 * (j))
#define XB_XSUB(j)  (1280 + 64 * (j))
#define XB_XGEN(j)  (2304 + 64 * (j))
#define XB_TOP      3328
#define XB_TOPGEN   3392
#define XCD_BAR_WORDS 3456
#define XB_SPIN_CAP (1u << 20)
__device__ __forceinline__ unsigned xb_ld(unsigned* p)              { return __hip_atomic_load(p, __ATOMIC_RELAXED, __HIP_MEMORY_SCOPE_AGENT); }
__device__ __forceinline__ unsigned xb_add(unsigned* p, unsigned v) { return __hip_atomic_fetch_add(p, v, __ATOMIC_RELAXED, __HIP_MEMORY_SCOPE_AGENT); }
__device__ __forceinline__ unsigned xb_xcc_id() { return (unsigned)__builtin_amdgcn_s_getreg((3 << 11) | 20) & 0xFu; }
#define XB_SPIN(cond, bar) do { unsigned _sp = 0; while (cond) { __builtin_amdgcn_s_sleep(1); \
    if ((++_sp & 255u) == 0u) { if (xb_ld(&(bar)[XB_TMO])) break; if (_sp > XB_SPIN_CAP) { atomicAdd(&(bar)[XB_TMO], 1u); break; } } } } while (0)
struct XcdBarrier { unsigned* bar; unsigned x; volatile LAS unsigned* st; };
__device__ __forceinline__ XcdBarrier xcd_barrier_post(unsigned* bar, volatile LAS unsigned* st) {
    XcdBarrier b; b.bar = bar; b.x = xb_xcc_id(); b.st = st;
    if (threadIdx.x == 0) (void)xb_add(&bar[XB_XCNT(b.x)], 1u);
    return b;
}
__device__ __forceinline__ void xcd_barrier_complete(unsigned* bar, unsigned x, unsigned& nloc, unsigned& nx) {
    const unsigned G = gridDim.x * gridDim.y * gridDim.z;
    unsigned sum, cnt, mine, sp = 0u;
    for (;;) {
        sum = 0u; cnt = 0u; mine = 0u;
#pragma unroll
        for (unsigned j = 0; j < 16; ++j) { const unsigned c = xb_ld(&bar[XB_XCNT(j)]); sum += c; cnt += (c > 0u) ? 1u : 0u; mine = (j == x) ? c : mine; }
        if (sum == G) break;
        __builtin_amdgcn_s_sleep(1);
        if ((++sp & 255u) == 0u) { if (xb_ld(&bar[XB_TMO])) break; if (sp > XB_SPIN_CAP) { atomicAdd(&bar[XB_TMO], 1u); break; } }
    }
    nloc = mine > 0u ? mine : 1u; nx = cnt > 0u ? cnt : 1u;
}
__device__ __forceinline__ void xcd_barrier(const XcdBarrier& b) {
    asm volatile("s_waitcnt vmcnt(0)" ::: "memory");
    __syncthreads();
    if (threadIdx.x == 0) {
        unsigned* bar = b.bar;
        __builtin_amdgcn_s_waitcnt(0);
        unsigned nloc = b.st[0], nx = b.st[1];
        if (nloc == 0u) { xcd_barrier_complete(bar, b.x, nloc, nx); b.st[0] = nloc; b.st[1] = nx; }
        const unsigned old = xb_add(&bar[XB_XSUB(b.x)], 1u);
        const unsigned gen = old / nloc;
        if (old + 1u == (gen + 1u) * nloc) {
            __builtin_amdgcn_fence(__ATOMIC_RELEASE, "agent");
            asm volatile("s_waitcnt vmcnt(0)" ::: "memory");
            const unsigned og = xb_add(&bar[XB_TOP], 1u);
            const unsigned tg = og / nx;
            if (og + 1u == (tg + 1u) * nx) xb_add(&bar[XB_TOPGEN], 1u);
            else XB_SPIN(xb_ld(&bar[XB_TOPGEN]) == tg, bar);
            __builtin_amdgcn_fence(__ATOMIC_ACQUIRE, "agent");
            xb_add(&bar[XB_XGEN(b.x)], 1u);
            asm volatile("s_waitcnt vmcnt(0)" ::: "memory");
        } else {
            XB_SPIN(xb_ld(&bar[XB_XGEN(b.x)]) == gen, bar);
            __builtin_amdgcn_fence(__ATOMIC_ACQUIRE, "agent");
            asm volatile("s_waitcnt vmcnt(0)" ::: "memory");
        }
    }
    __syncthreads();
}

constexpr int NPHASES = 9;
constexpr int LDS_MISC = 139264;
constexpr size_t CTL_ZERO_BYTES = 65536;
__global__ void __launch_bounds__(NTHREADS, 2) fwd_kernel(Args args) {
    extern __shared__ __attribute__((aligned(16))) unsigned char lds_raw[];
    cg::grid_group grid = cg::this_grid();
    Frame F;
    F.lds = (LAS unsigned char*)lds_raw;
    frame_ids(F);
    F.G = gridDim.x; { const int bx = blockIdx.x; F.vcu = (F.G % 8 == 0) ? (bx % 8) * (F.G / 8) + bx / 8 : bx; }
    const int lo = args.ph_lo, hi = args.ph_hi;
    unsigned char* ws = args.ws;
    volatile LAS unsigned* MISC = (volatile LAS unsigned*)(F.lds + LDS_MISC);
    if (threadIdx.x < 16) MISC[threadIdx.x] = 0u;
    __syncthreads();
    XcdBarrier bar = xcd_barrier_post((unsigned*)(ws + WS_CTL) + 1024, MISC + 8);
#define IN(k) (lo <= (k) && (k) < hi)
#define SEAM_CG(k) do { if (IN(k) && IN((k) + 1)) { __threadfence(); grid.sync(); } } while (0)
#define SEAM(k) do { if (IN(k) && IN((k) + 1)) { xcd_barrier(bar); } } while (0)
    if (IN(0)) { frame_ids(F); p0_prologue(args, F); }
    SEAM_CG(0);
    if (IN(1)) {
        pg8::Gemm g{(const bf16_t*)((unsigned char*)args.out + DO_H), (const bf16_t*)(ws + WS_WIN), MTOK, NWIN_PAD, DM}; pg8::StaticOrder S; S.init(MTOK, NWIN_PAD, F.G, (int)blockIdx.x);
        EpiProj E{ws, (unsigned char*)args.out};
        pg8::gemm_phase<EpiProj, pg8::StaticOrder, true>(F.lds, g, S, E);
    }
    SEAM(1);
    if (IN(2)) { frame_ids(F); p_ret_kv(args, F); __syncthreads(); frame_ids(F); p_index(args, F); }
    SEAM(2);
    if (IN(3)) { frame_ids(F); p_ret_scan(args, F); __syncthreads(); frame_ids(F); p_attn(args, F); }
    SEAM(3);
    if (IN(4)) {
        frame_ids(F); p_ret_out(args, F); __syncthreads();
        pg8::Gemm g{(const bf16_t*)((unsigned char*)args.out + DO_AO), (const bf16_t*)(ws + WS_WA), MTOK, DM, 1024}; pg8::StaticOrder S; S.init(MTOK, DM, F.G, (int)blockIdx.x);
        EpiMerge<false> E{nullptr, (const bf16_t*)(ws + WS_GA), (bf16_t*)(ws + WS_T)};
        pg8::gemm_phase<EpiMerge<false>, pg8::StaticOrder, true>(F.lds, g, S, E);
    }
    SEAM(4);
    if (IN(5)) {
        pg8::Gemm g{(const bf16_t*)(ws + WS_BO), (const bf16_t*)(ws + WS_WB), MTOK, DM, 1024}; pg8::StaticOrder S; S.init(MTOK, DM, F.G, (int)blockIdx.x);
        EpiMerge<true> E{(const bf16_t*)(ws + WS_T), (const bf16_t*)(ws + WS_GB), (bf16_t*)(ws + WS_MG)};
        pg8::gemm_phase<EpiMerge<true>, pg8::StaticOrder, true>(F.lds, g, S, E);
    }
    SEAM(5);
    if (IN(6)) {
        { pg8::Gemm g{(const bf16_t*)(ws + WS_MG), (const bf16_t*)(ws + WS_WO), MTOK, DM, DM}; pg8::StaticOrder S; S.init(MTOK, DM, F.G, (int)blockIdx.x);
          EpiResid E{args.x, args.out, (bf16_t*)(ws + WS_RB)};
          pg8::gemm_phase<EpiResid, pg8::StaticOrder, true>(F.lds, g, S, E); }
        { pg8::Gemm g{(const bf16_t*)(ws + WS_PB), (const bf16_t*)(ws + WS_WPLE), MTOK, DM, PLE}; pg8::StaticOrder S; S.init(MTOK, DM, F.G, (int)blockIdx.x);
          EpiPlainBf16<DM> E{(bf16_t*)(ws + WS_U)};
          pg8::gemm_phase<EpiPlainBf16<DM>, pg8::StaticOrder, true>(F.lds, g, S, E); }
    }
    SEAM(6);
    if (IN(7)) {
        pg8::Gemm g{(const bf16_t*)(ws + WS_RB), (const bf16_t*)(ws + WS_WPG), MTOK, DM, DM}; pg8::StaticOrder S; S.init(MTOK, DM, F.G, (int)blockIdx.x);
        EpiGate E{args.out, (const bf16_t*)(ws + WS_U), args.out};
        pg8::gemm_phase<EpiGate, pg8::StaticOrder, true>(F.lds, g, S, E);
    }
    SEAM(7);
    if (IN(8)) { frame_ids(F); p_final_norm(args, F); }
#undef IN
#undef SEAM
#undef SEAM_CG
}

#ifndef ONE_LAUNCH
#define ONE_LAUNCH 1
#endif
extern "C" void kernel_launch(void* const* d_in, const int* in_sizes, int n_in, void* d_out, int out_size, void* d_ws, size_t ws_size, hipStream_t stream) {
    static int grid = 0;
    if (grid == 0) {
        int dev = 0, cus = 0, per_cu = 0;
        (void)hipGetDevice(&dev);
        if (hipDeviceGetAttribute(&cus, hipDeviceAttributeMultiprocessorCount, dev) != hipSuccess || cus <= 0) cus = 256;
        (void)hipFuncSetAttribute((const void*)fwd_kernel, hipFuncAttributeMaxDynamicSharedMemorySize, LDS_BYTES);
        if (hipOccupancyMaxActiveBlocksPerMultiprocessor(&per_cu, (const void*)fwd_kernel, NTHREADS, LDS_BYTES) != hipSuccess || per_cu < 1) per_cu = 1;
        (void)hipGetLastError();
        grid = cus * 1;
        if (ws_size < WS_END) fprintf(stderr, "kernel_launch: workspace too small (%zu < %zu)\n", ws_size, (size_t)WS_END);
    }
    (void)hipMemsetAsync((char*)d_ws + WS_CTL, 0, CTL_ZERO_BYTES, stream);
    Args a{};
    a.x = (const float*)d_in[0]; a.p = (const float*)d_in[1]; a.pos = (const int*)d_in[2]; a.w_in = (const float*)d_in[3]; a.norm_gain = (const float*)d_in[4];
    a.w_a = (const float*)d_in[5]; a.w_b = (const float*)d_in[6]; a.w_o = (const float*)d_in[7]; a.gn_gain = (const float*)d_in[8]; a.w_ple = (const float*)d_in[9];
    a.w_pg = (const float*)d_in[10]; a.rel_bias = (const float*)d_in[11]; a.final_gain = (const float*)d_in[12];
    a.out = (float*)d_out; a.ws = (unsigned char*)d_ws; a.coop = 1; a.pad = 0;
#ifdef PROBE_SPLIT
    for (int li = 0; li < 2; ++li) { a.ph_lo = li ? PROBE_SPLIT : 0; a.ph_hi = li ? NPHASES : PROBE_SPLIT + 1;
      void* kargs[] = {&a}; hipError_t e = hipLaunchCooperativeKernel((const void*)fwd_kernel, dim3(grid), dim3(NTHREADS), kargs, LDS_BYTES, stream);
      if (e != hipSuccess) fprintf(stderr, "cooperative launch failed: %s (grid %d)\n", hipGetErrorString(e), grid);
      if (li == 0) (void)hipMemsetAsync((char*)d_ws + WS_CTL, 0, CTL_ZERO_BYTES, stream); }
#elif ONE_LAUNCH
    a.ph_lo = 0; a.ph_hi = NPHASES;
    { void* kargs[] = {&a}; hipError_t e = hipLaunchCooperativeKernel((const void*)fwd_kernel, dim3(grid), dim3(NTHREADS), kargs, LDS_BYTES, stream);
      if (e != hipSuccess) fprintf(stderr, "cooperative launch failed: %s (grid %d)\n", hipGetErrorString(e), grid); }
#else
    for (int ph = 0; ph < NPHASES; ++ph) {
        a.ph_lo = ph; a.ph_hi = ph + 1;
        void* kargs[] = {&a}; hipError_t e = hipLaunchCooperativeKernel((const void*)fwd_kernel, dim3(grid), dim3(NTHREADS), kargs, LDS_BYTES, stream);
        if (e != hipSuccess) fprintf(stderr, "cooperative launch %d failed: %s (grid %d)\n", ph, hipGetErrorString(e), grid);
    }
#endif
}
```

```cpp
#include <hip/hip_runtime.h>
#include <hip/hip_cooperative_groups.h>
#include <cstdio>
#include <cstdint>
namespace cg = cooperative_groups;

#define LAS __attribute__((address_space(3)))
typedef unsigned short bf16_t;
typedef short bf16x8 __attribute__((ext_vector_type(8)));
typedef float f32x4 __attribute__((ext_vector_type(4)));
typedef float f32x2 __attribute__((ext_vector_type(2)));
typedef unsigned u32x4 __attribute__((ext_vector_type(4)));
typedef unsigned u32x2 __attribute__((ext_vector_type(2)));

constexpr int DM = 2048, NB = 4, SEQ = 4096, MTOK = NB * SEQ, CHUNK = 64, PLE = 256;
constexpr int NWIN = 13392, NWIN_PAD = 13568;
constexpr float EPS = 1e-6f;

constexpr size_t MiB = 1u << 20;
constexpr size_t WS_CTL = 0;
constexpr size_t WS_WIN = 1 * MiB;
constexpr size_t WS_WA = 54 * MiB;
constexpr size_t WS_WB = 58 * MiB;
constexpr size_t WS_WO = 62 * MiB;
constexpr size_t WS_WPG = 70 * MiB;
constexpr size_t WS_WPLE = 78 * MiB;
constexpr size_t WS_PB = 79 * MiB;
constexpr size_t WS_ROPE = 87 * MiB;
constexpr size_t WS_IK = 95 * MiB;
constexpr size_t WS_IW = 97 * MiB;
constexpr size_t WS_MASK = 98 * MiB;
constexpr size_t WS_AK = 106 * MiB;
constexpr size_t WS_AV = 138 * MiB;
constexpr size_t WS_AZ = 170 * MiB;
constexpr size_t WS_RQ = 202 * MiB;
constexpr size_t WS_RK = 234 * MiB;
constexpr size_t WS_RV = 266 * MiB;
constexpr size_t WS_RZ = 298 * MiB;
constexpr size_t WS_GA = 330 * MiB;
constexpr size_t WS_GB = 394 * MiB;
constexpr size_t WS_BO = 458 * MiB;
constexpr size_t WS_END = 490 * MiB;
constexpr size_t DO_H = 0, DO_KVT = 0, DO_IQ = 64 * MiB, DO_AQ = 96 * MiB, DO_AO = DO_IQ;
constexpr size_t WS_T = WS_AK, WS_MG = WS_RK, WS_RB = WS_GA, WS_U = WS_GB;

typedef __bf16 bf16x2_t __attribute__((ext_vector_type(2)));
__device__ __forceinline__ unsigned cvt_pk_bf16(float lo, float hi) { f32x2 v = {lo, hi}; bf16x2_t b = __builtin_convertvector(v, bf16x2_t); return __builtin_bit_cast(unsigned, b); }
__device__ __forceinline__ unsigned f2bf(float f) { unsigned u = __builtin_bit_cast(unsigned, f); return (u + 0x7fffu + ((u >> 16) & 1u)) >> 16; }
__device__ __forceinline__ unsigned pk2(float lo, float hi) { return f2bf(lo) | (f2bf(hi) << 16); }
__device__ __forceinline__ float bf2f(unsigned short h) { return __builtin_bit_cast(float, (unsigned)h << 16); }
__device__ __forceinline__ float sigmoidf_(float z) { return __builtin_amdgcn_rcpf(1.0f + __builtin_amdgcn_exp2f(-1.4426950408889634f * z)); }
__device__ __forceinline__ float siluf_(float z) { return z * __builtin_amdgcn_rcpf(1.0f + __builtin_amdgcn_exp2f(-1.4426950408889634f * z)); }
__device__ __forceinline__ float wave_sum(float v) {
#pragma unroll
    for (int o = 1; o < 64; o <<= 1) v += __shfl_xor(v, o);
    return v;
}
#define LDS_WAIT() asm volatile("s_waitcnt lgkmcnt(0)" ::: "memory")

namespace pg8 {
constexpr int BM = 256, BK = 64, HALF = 128, HTB = HALF * BK * 2, STAGE_BYTES = 8 * HTB, NXCD = 8, WGM = 8;
__host__ __device__ __forceinline__ int lds_byte(int r, int c) { const int st = (r >> 4) * 2 + (c >> 5), rr = r & 15, cc = c & 31, ob = rr * 64 + cc * 2; return st * 1024 + (ob ^ (((ob >> 9) & 1) << 5)); }
__host__ __device__ __forceinline__ void stage_rc(int b, int& R, int& C) { const int st = b / 1024, sb = b % 1024, swz = sb ^ (((sb >> 9) & 1) << 5); R = (st >> 1) * 16 + swz / 64; C = (st & 1) * 32 + (swz % 64) / 2; }
__host__ __device__ __forceinline__ int perm32(int rho) { const int n = rho >> 4, i = rho & 15; return 8 * (i >> 2) + 4 * n + (i & 3); }
struct Unit { int pm, pn; };
struct Gemm { const bf16_t* A; const bf16_t* Bt; int M, N, K; };
struct StaticOrder {
    int nM, nN, nwg, G, c;
    __host__ __device__ void init(int M, int N, int G_, int c_) { nM = M / BM; nN = N / BM; nwg = nM * nN; G = G_; c = c_; }
    __host__ __device__ bool next(int i, Unit& u) const {
        const long L = (long)i * G + c; if (L >= nwg) return false;
        int wgid = (int)L; { const int q = nwg / NXCD, r = nwg % NXCD, xcd = wgid % NXCD, off = wgid / NXCD; wgid = (xcd < r ? xcd * (q + 1) : r * (q + 1) + (xcd - r) * q) + off; }
        const int nig = WGM * nN, gid = wgid / nig, fm = gid * WGM, gsz = (nM - fm) < WGM ? (nM - fm) : WGM;
        u.pm = fm + ((wgid % nig) % gsz); u.pn = (wgid % nig) / gsz; return true;
    }
    __device__ __forceinline__ void a_ready(const Unit&) const {}
    __device__ __forceinline__ void done(const Unit&) const {}
};

template <class Epi, class Sched, bool ALIGN_EPI = true>
__device__ __forceinline__ void gemm_phase(LAS unsigned char* lds, const Gemm g, const Sched& S, const Epi& E) {
    const int tid = threadIdx.x, wid = __builtin_amdgcn_readfirstlane(tid >> 6), lane = tid & 63, wr = wid >> 2, wc = wid & 3, fr = lane & 15, fq = lane >> 4;
    const int K = g.K, nt = K / BK;
    unsigned voffA[2], voffB[2];
#pragma unroll
    for (int i = 0; i < 2; ++i) { int R, C; stage_rc(tid * 16 + i * 8192, R, C); const int Rb = Epi::PERM ? ((R & ~31) + perm32(R & 31)) : R;
        voffA[i] = (unsigned)(R * K + C) * 2u; voffB[i] = (unsigned)(Rb * K + C) * 2u; }
    const size_t kstep = (size_t)(BK * 2);
    const size_t hstep = (size_t)HALF * K * 2;
    const size_t tstep = 2 * hstep;
    const unsigned ldsw = (unsigned)wid * 1024u;
    const int aoff = lds_byte(wr * 64 + fr, fq * 8), boff = lds_byte(wc * 32 + fr, fq * 8);
#define PG8_SA(b, h) (((b) * 2 + (h)) * HTB)
#define PG8_SB(b, h) ((4 + (b) * 2 + (h)) * HTB)
#define PG8_STAGE(bufoff, gbase, voff) do { _Pragma("unroll") for (int _i = 0; _i < 2; ++_i) \
        __builtin_amdgcn_global_load_lds((const unsigned*)((const char*)(gbase) + (voff)[_i]), (LAS unsigned*)(lds + (bufoff) + ldsw + _i * 8192), 16, 0, 0); } while (0)
#define PG8_LDA(dst, b, h) do { _Pragma("unroll") for (int m = 0; m < 4; ++m) _Pragma("unroll") for (int k = 0; k < 2; ++k) dst[m][k] = *(const LAS bf16x8*)(lds + PG8_SA(b, h) + aoff + m * 2048 + k * 1024); } while (0)
#define PG8_LDB(dst, b, h) do { _Pragma("unroll") for (int n = 0; n < 2; ++n) _Pragma("unroll") for (int k = 0; k < 2; ++k) dst[n][k] = *(const LAS bf16x8*)(lds + PG8_SB(b, h) + boff + n * 2048 + k * 1024); } while (0)
#define PG8_MMA(ai, bj, At, Bt) do { __builtin_amdgcn_s_setprio(1); _Pragma("unroll") for (int m = 0; m < 4; ++m) _Pragma("unroll") for (int n = 0; n < 2; ++n) _Pragma("unroll") for (int k = 0; k < 2; ++k) \
        acc[ai][bj][m][n] = __builtin_amdgcn_mfma_f32_16x16x32_bf16(Bt[n][k], At[m][k], acc[ai][bj][m][n], 0, 0, 0); __builtin_amdgcn_s_setprio(0); } while (0)
#define PG8_WAIT_V(n) asm volatile("s_waitcnt vmcnt(" #n ")" ::: "memory")
#define PG8_WAIT_L(n) asm volatile("s_waitcnt lgkmcnt(" #n ")" ::: "memory")
#define PG8_BAR __builtin_amdgcn_s_barrier()
#define PG8_SCHED __builtin_amdgcn_sched_barrier(0)
    Unit cur, nxt; int ui = 0;
    if (!S.next(0, cur)) return;
    f32x4 acc[2][2][4][2];
#pragma unroll
    for (int a = 0; a < 2; ++a)
#pragma unroll
        for (int b = 0; b < 2; ++b)
#pragma unroll
            for (int m = 0; m < 4; ++m)
#pragma unroll
                for (int n = 0; n < 2; ++n) acc[a][b][m][n] = (f32x4){0.f, 0.f, 0.f, 0.f};
    bf16x8 At[4][2], B0[2][2], B1[2][2];
    const char* cA = (const char*)g.A + (size_t)cur.pm * tstep; const char* cB = (const char*)g.Bt + (size_t)cur.pn * tstep;
    S.a_ready(cur);
    PG8_STAGE(PG8_SB(0, 0), cB, voffB); PG8_STAGE(PG8_SB(0, 1), cB + hstep, voffB); PG8_STAGE(PG8_SA(0, 0), cA, voffA); PG8_STAGE(PG8_SA(0, 1), cA + hstep, voffA);
    if (wr == 1) PG8_BAR;
    PG8_WAIT_V(2); PG8_BAR;
    PG8_STAGE(PG8_SB(1, 0), cB + kstep, voffB); PG8_STAGE(PG8_SA(1, 0), cA + kstep, voffA); PG8_STAGE(PG8_SB(1, 1), cB + hstep + kstep, voffB);
    PG8_WAIT_V(6); PG8_BAR;
    for (;;) {
        const bool has_next = S.next(ui + 1, nxt);
        const char* nA = has_next ? (const char*)g.A + (size_t)nxt.pm * tstep : cA; const char* nB = has_next ? (const char*)g.Bt + (size_t)nxt.pn * tstep : cB;
#pragma unroll 1
        for (int t = 0; t < nt; t += 2) {
            const bool last = (t == nt - 2);
            const char* a1 = cA + (size_t)(t + 1) * kstep;
            const char* a2 = last ? nA : cA + (size_t)(t + 2) * kstep; const char* b2 = last ? nB : cB + (size_t)(t + 2) * kstep;
            const char* a3 = a2 + kstep; const char* b3 = b2 + kstep;
            if (last && has_next) S.a_ready(nxt);
            PG8_LDB(B0, 0, 0); PG8_LDB(B1, 0, 1); PG8_SCHED; PG8_LDA(At, 0, 0); PG8_STAGE(PG8_SA(1, 1), a1 + hstep, voffA);
            PG8_WAIT_V(8); PG8_WAIT_L(0); PG8_BAR; PG8_MMA(0, 0, At, B0); PG8_MMA(0, 1, At, B1); PG8_BAR; PG8_SCHED;
            PG8_LDA(At, 0, 1); PG8_STAGE(PG8_SB(0, 0), b2, voffB); PG8_STAGE(PG8_SB(0, 1), b2 + hstep, voffB); PG8_STAGE(PG8_SA(0, 0), a2, voffA);
            PG8_WAIT_V(8); PG8_WAIT_L(0); PG8_BAR; PG8_MMA(1, 0, At, B0); PG8_MMA(1, 1, At, B1); PG8_BAR; PG8_SCHED;
            PG8_LDB(B0, 1, 0); PG8_LDB(B1, 1, 1); PG8_SCHED; PG8_LDA(At, 1, 0); PG8_STAGE(PG8_SA(0, 1), a2 + hstep, voffA);
            PG8_WAIT_V(8); PG8_WAIT_L(0); PG8_BAR; PG8_MMA(0, 0, At, B0); PG8_MMA(0, 1, At, B1); PG8_BAR; PG8_SCHED;
            PG8_LDA(At, 1, 1); PG8_STAGE(PG8_SB(1, 0), b3, voffB); PG8_STAGE(PG8_SB(1, 1), b3 + hstep, voffB); PG8_STAGE(PG8_SA(1, 0), a3, voffA);
            PG8_WAIT_V(8); PG8_WAIT_L(0); PG8_BAR; PG8_MMA(1, 0, At, B0); PG8_MMA(1, 1, At, B1); PG8_BAR; PG8_SCHED;
        }
        if constexpr (ALIGN_EPI) { if (wr == 0) PG8_BAR; }
        E(acc, cur, wr, wc, fr, fq);
        if (!has_next) break;
#pragma unroll
        for (int a = 0; a < 2; ++a)
#pragma unroll
            for (int b = 0; b < 2; ++b)
#pragma unroll
                for (int m = 0; m < 4; ++m)
#pragma unroll
                    for (int n = 0; n < 2; ++n) acc[a][b][m][n] = (f32x4){0.f, 0.f, 0.f, 0.f};
        cur = nxt; cA = nA; cB = nB; ++ui;
        if constexpr (ALIGN_EPI) { if (wr == 1) PG8_BAR; }
    }
    PG8_WAIT_V(0);
    if constexpr (!ALIGN_EPI) { if (wr == 0) PG8_BAR; }
    PG8_BAR;
#undef PG8_SA
#undef PG8_SB
#undef PG8_STAGE
#undef PG8_LDA
#undef PG8_LDB
#undef PG8_MMA
#undef PG8_WAIT_V
#undef PG8_WAIT_L
#undef PG8_BAR
#undef PG8_SCHED
}
}

typedef f32x4 AccT[2][2][4][2];
template <class Fn> __device__ __forceinline__ void epi_foreach(const AccT& acc, const pg8::Unit& u, int wr, int wc, int fr, int fq, Fn&& f) {
    asm volatile("" : "+v"(fr), "+v"(fq));
#pragma unroll
    for (int ai = 0; ai < 2; ++ai)
#pragma unroll
        for (int m = 0; m < 4; ++m)
#pragma unroll
            for (int bj = 0; bj < 2; ++bj) {
                f(u.pm * 256 + ai * 128 + wr * 64 + m * 16 + fr, u.pn * 256 + bj * 128 + wc * 32 + 8 * fq, acc[ai][bj][m][0], acc[ai][bj][m][1]);
                asm volatile("" ::: "memory"); }
}

template <int ldc> struct EpiPlainBf16 {
    static constexpr bool PERM = true;
    bf16_t* O;
    __device__ __forceinline__ void operator()(const AccT& acc, const pg8::Unit& u, int wr, int wc, int fr, int fq) const {
        epi_foreach(acc, u, wr, wc, fr, fq, [&](int row, int col, f32x4 v0, f32x4 v1) {
            u32x4 w; w.x = cvt_pk_bf16(v0[0], v0[1]); w.y = cvt_pk_bf16(v0[2], v0[3]); w.z = cvt_pk_bf16(v1[0], v1[1]); w.w = cvt_pk_bf16(v1[2], v1[3]);
            *(u32x4*)(O + (size_t)row * ldc + col) = w; });
    }
};
struct EpiGate {
    static constexpr bool PERM = true;
    const float* R; const bf16_t* U; float* O;
    __device__ __forceinline__ void operator()(const AccT& acc, const pg8::Unit& u, int wr, int wc, int fr, int fq) const {
        epi_foreach(acc, u, wr, wc, fr, fq, [&](int row, int col, f32x4 v0, f32x4 v1) {
            const size_t off = (size_t)row * DM + col;
            const f32x4 r0 = *(const f32x4*)(R + off), r1 = *(const f32x4*)(R + off + 4);
            const u32x4 uu = *(const u32x4*)(U + off);
            f32x4 o0, o1;
            o0[0] = r0[0] + bf2f((unsigned short)(uu.x & 0xffff)) * sigmoidf_(v0[0]); o0[1] = r0[1] + bf2f((unsigned short)(uu.x >> 16)) * sigmoidf_(v0[1]);
            o0[2] = r0[2] + bf2f((unsigned short)(uu.y & 0xffff)) * sigmoidf_(v0[2]); o0[3] = r0[3] + bf2f((unsigned short)(uu.y >> 16)) * sigmoidf_(v0[3]);
            o1[0] = r1[0] + bf2f((unsigned short)(uu.z & 0xffff)) * sigmoidf_(v1[0]); o1[1] = r1[1] + bf2f((unsigned short)(uu.z >> 16)) * sigmoidf_(v1[1]);
            o1[2] = r1[2] + bf2f((unsigned short)(uu.w & 0xffff)) * sigmoidf_(v1[2]); o1[3] = r1[3] + bf2f((unsigned short)(uu.w >> 16)) * sigmoidf_(v1[3]);
            *(f32x4*)(O + off) = o0; *(f32x4*)(O + off + 4) = o1; });
    }
};

template <bool HAS_T> struct EpiMerge {
    static constexpr bool PERM = true;
    const bf16_t* T; const bf16_t* Gt; bf16_t* O;
    __device__ __forceinline__ void operator()(const AccT& acc, const pg8::Unit& u, int wr, int wc, int fr, int fq) const {
        epi_foreach(acc, u, wr, wc, fr, fq, [&](int row, int col, f32x4 v0, f32x4 v1) {
            const size_t off = (size_t)row * DM + col;
            const u32x4 gg = *(const u32x4*)(Gt + off);
            float o[8];
            o[0] = bf2f((unsigned short)(gg.x & 0xffff)) * v0[0]; o[1] = bf2f((unsigned short)(gg.x >> 16)) * v0[1];
            o[2] = bf2f((unsigned short)(gg.y & 0xffff)) * v0[2]; o[3] = bf2f((unsigned short)(gg.y >> 16)) * v0[3];
            o[4] = bf2f((unsigned short)(gg.z & 0xffff)) * v1[0]; o[5] = bf2f((unsigned short)(gg.z >> 16)) * v1[1];
            o[6] = bf2f((unsigned short)(gg.w & 0xffff)) * v1[2]; o[7] = bf2f((unsigned short)(gg.w >> 16)) * v1[3];
            if constexpr (HAS_T) { const u32x4 tt = *(const u32x4*)(T + off);
                o[0] += bf2f((unsigned short)(tt.x & 0xffff)); o[1] += bf2f((unsigned short)(tt.x >> 16)); o[2] += bf2f((unsigned short)(tt.y & 0xffff)); o[3] += bf2f((unsigned short)(tt.y >> 16));
                o[4] += bf2f((unsigned short)(tt.z & 0xffff)); o[5] += bf2f((unsigned short)(tt.z >> 16)); o[6] += bf2f((unsigned short)(tt.w & 0xffff)); o[7] += bf2f((unsigned short)(tt.w >> 16)); }
            u32x4 w; w.x = cvt_pk_bf16(o[0], o[1]); w.y = cvt_pk_bf16(o[2], o[3]); w.z = cvt_pk_bf16(o[4], o[5]); w.w = cvt_pk_bf16(o[6], o[7]);
            *(u32x4*)(O + off) = w; });
    }
};
struct EpiResid {
    static constexpr bool PERM = true;
    const float* X; float* O32; bf16_t* O16;
    __device__ __forceinline__ void operator()(const AccT& acc, const pg8::Unit& u, int wr, int wc, int fr, int fq) const {
        epi_foreach(acc, u, wr, wc, fr, fq, [&](int row, int col, f32x4 v0, f32x4 v1) {
            const size_t off = (size_t)row * DM + col;
            const f32x4 r0 = *(const f32x4*)(X + off) + v0, r1 = *(const f32x4*)(X + off + 4) + v1;
            *(f32x4*)(O32 + off) = r0; *(f32x4*)(O32 + off + 4) = r1;
            u32x4 w; w.x = cvt_pk_bf16(r0[0], r0[1]); w.y = cvt_pk_bf16(r0[2], r0[3]); w.z = cvt_pk_bf16(r1[0], r1[1]); w.w = cvt_pk_bf16(r1[2], r1[3]);
            *(u32x4*)(O16 + off) = w; });
    }
};
__device__ __forceinline__ size_t hm_off(int row, int hh, int d) { return ((size_t)(row & ~4095) * 8 + (size_t)hh * 4096 + (size_t)(row & 4095)) * 128 + d; }
__device__ __forceinline__ u32x4 pack8f(const float* o) { u32x4 w; w.x = cvt_pk_bf16(o[0], o[1]); w.y = cvt_pk_bf16(o[2], o[3]); w.z = cvt_pk_bf16(o[4], o[5]); w.w = cvt_pk_bf16(o[6], o[7]); return w; }
struct EpiProj {
    static constexpr bool PERM = true;
    unsigned char* ws; unsigned char* dout;
    __device__ __forceinline__ void operator()(const AccT& acc, const pg8::Unit& u, int wr, int wc, int fr, int fq) const {
        const int pn = u.pn;
        if (pn < 12 || (pn >= 29 && pn < 33)) {
            bf16_t* base; int tl;
            if (pn < 4) { base = (bf16_t*)(dout + DO_AQ); tl = pn; } else if (pn < 8) { base = (bf16_t*)(ws + WS_AK); tl = pn - 4; }
            else if (pn < 12) { base = (bf16_t*)(ws + WS_AV); tl = pn - 8; } else { base = (bf16_t*)(ws + WS_RV); tl = pn - 29; }
            epi_foreach(acc, u, wr, wc, fr, fq, [&](int row, int col, f32x4 v0, f32x4 v1) {
                const int colt = col & 255; const float o[8] = {v0[0], v0[1], v0[2], v0[3], v1[0], v1[1], v1[2], v1[3]};
                *(u32x4*)(base + hm_off(row, 2 * tl + (colt >> 7), colt & 127)) = pack8f(o); });
        } else if (pn == 20) {
            asm volatile("" : "+v"(fr), "+v"(fq));
            if (wc == 0) {
                bf16_t* IK = (bf16_t*)(ws + WS_IK);
#pragma unroll
                for (int ai = 0; ai < 2; ++ai)
#pragma unroll
                    for (int m = 0; m < 4; ++m) {
                        const int row = u.pm * 256 + ai * 128 + wr * 64 + m * 16 + fr;
                        float x[16];
#pragma unroll
                        for (int j = 0; j < 4; ++j) { x[j] = acc[ai][0][m][0][j]; x[4 + j] = acc[ai][0][m][1][j]; x[8 + j] = acc[ai][1][m][0][j]; x[12 + j] = acc[ai][1][m][1][j]; }
                        float sum = 0.f;
#pragma unroll
                        for (int j = 0; j < 16; ++j) sum += x[j];
                        sum += __shfl_xor(sum, 16); sum += __shfl_xor(sum, 32);
                        const float mu = sum * (1.0f / 64.0f); float q = 0.f;
#pragma unroll
                        for (int j = 0; j < 16; ++j) { x[j] -= mu; q += x[j] * x[j]; }
                        q += __shfl_xor(q, 16); q += __shfl_xor(q, 32);
                        const float rs = 1.0f / sqrtf(q * (1.0f / 64.0f) + EPS);
#pragma unroll
                        for (int j = 0; j < 16; ++j) x[j] *= rs;
                        *(u32x4*)(IK + (size_t)row * 64 + 8 * fq) = pack8f(x); *(u32x4*)(IK + (size_t)row * 64 + 32 + 8 * fq) = pack8f(x + 8);
                        asm volatile("" ::: "memory");
                    }
            } else if (wc == 1) {
                float* IW = (float*)(ws + WS_IW);
                if (fq < 2) {
#pragma unroll
                    for (int ai = 0; ai < 2; ++ai)
#pragma unroll
                        for (int m = 0; m < 4; ++m) {
                            const int row = u.pm * 256 + ai * 128 + wr * 64 + m * 16 + fr;
                            *(f32x4*)(IW + (size_t)row * 16 + 8 * fq) = acc[ai][0][m][0] * 0.25f; *(f32x4*)(IW + (size_t)row * 16 + 8 * fq + 4) = acc[ai][0][m][1] * 0.25f;
                        }
                }
            }
        } else if (pn >= 21 && pn < 29) {
            asm volatile("" : "+v"(fr), "+v"(fq));
            const bool isk = pn >= 25; const int tl = isk ? pn - 25 : pn - 21; const float sc = isk ? 0.08838834764831845f : 1.0f;
            bf16_t* base = (bf16_t*)(ws + (isk ? WS_RK : WS_RQ)); const f32x4* rope = (const f32x4*)(ws + WS_ROPE);
            const int hh = 2 * tl + (wc >> 1), d0 = 32 * (wc & 1) + 8 * fq;
#pragma unroll
            for (int ai = 0; ai < 2; ++ai)
#pragma unroll
                for (int m = 0; m < 4; ++m) {
                    const int row = u.pm * 256 + ai * 128 + wr * 64 + m * 16 + fr;
                    const f32x4* rp = rope + ((size_t)row * 64 + d0) / 2;
                    float x1[8], x2[8], y1[8], y2[8];
#pragma unroll
                    for (int j = 0; j < 4; ++j) { x1[j] = acc[ai][0][m][0][j]; x1[4 + j] = acc[ai][0][m][1][j]; x2[j] = acc[ai][1][m][0][j]; x2[4 + j] = acc[ai][1][m][1][j]; }
#pragma unroll
                    for (int jj = 0; jj < 4; ++jj) { const f32x4 cs = rp[jj];
                        y1[2 * jj] = (x1[2 * jj] * cs[0] - x2[2 * jj] * cs[1]) * sc; y2[2 * jj] = (x1[2 * jj] * cs[1] + x2[2 * jj] * cs[0]) * sc;
                        y1[2 * jj + 1] = (x1[2 * jj + 1] * cs[2] - x2[2 * jj + 1] * cs[3]) * sc; y2[2 * jj + 1] = (x1[2 * jj + 1] * cs[3] + x2[2 * jj + 1] * cs[2]) * sc; }
                    const size_t o = hm_off(row, hh, d0);
                    *(u32x4*)(base + o) = pack8f(y1); *(u32x4*)(base + o + 64) = pack8f(y2);
                    asm volatile("" ::: "memory");
                }
        } else {
            bf16_t* base; int ld, c0, act;
            if (pn < 16) { base = (bf16_t*)(ws + WS_AZ); ld = 1024; c0 = (pn - 12) * 256; act = 0; }
            else if (pn < 20) { base = (bf16_t*)(dout + DO_IQ); ld = 1024; c0 = (pn - 16) * 256; act = 1; }
            else if (pn < 37) { base = (bf16_t*)(ws + WS_RZ); ld = 1024; c0 = (pn - 33) * 256; act = 0; }
            else if (pn < 45) { base = (bf16_t*)(ws + WS_GA); ld = 2048; c0 = (pn - 37) * 256; act = 2; }
            else { base = (bf16_t*)(ws + WS_GB); ld = 2048; c0 = (pn - 45) * 256; act = 2; }
            epi_foreach(acc, u, wr, wc, fr, fq, [&](int row, int col, f32x4 v0, f32x4 v1) {
                float o[8] = {v0[0], v0[1], v0[2], v0[3], v1[0], v1[1], v1[2], v1[3]};
#pragma unroll
                for (int j = 0; j < 8; ++j) o[j] = act == 0 ? siluf_(o[j]) : (act == 1 ? o[j] * 0.125f : sigmoidf_(o[j]));
                *(u32x4*)(base + (size_t)row * ld + c0 + (col & 255)) = pack8f(o); });
        }
    }
};

constexpr int NWAVES = 8, NTHREADS = 512;
constexpr int LDS_BYTES = 147456;
struct Args {
    const float* x; const float* p; const int* pos; const float* w_in; const float* norm_gain; const float* w_a; const float* w_b; const float* w_o;
    const float* gn_gain; const float* w_ple; const float* w_pg; const float* rel_bias; const float* final_gain;
    float* out; unsigned char* ws; int ph_lo, ph_hi; int coop, pad;
};
struct Frame { LAS unsigned char* lds; int tid, lane, wave, G, vcu; };
__device__ __forceinline__ void frame_ids(Frame& F) { int t = threadIdx.x; asm volatile("" : "+v"(t)); F.tid = t; F.lane = t & 63; F.wave = __builtin_amdgcn_readfirstlane(t >> 6); }

__device__ __forceinline__ void transpose_item64(const float* W, int K, int N, int src_c0, int cnt, bf16_t* WT, int dst_r0, int k0, int lane) {
    const bool ok = src_c0 >= 0 && lane < cnt;
    const float* src = W + (size_t)k0 * N + (ok ? src_c0 + lane : 0);
    bf16_t* dst = WT + (size_t)(dst_r0 + lane) * K + k0;
#pragma unroll
    for (int h = 0; h < 2; ++h) {
        float x[32];
#pragma unroll
        for (int kk = 0; kk < 32; ++kk) x[kk] = ok ? src[(size_t)(32 * h + kk) * N] : 0.f;
#pragma unroll
        for (int c8 = 0; c8 < 4; ++c8) { u32x4 o; o.x = pk2(x[8 * c8], x[8 * c8 + 1]); o.y = pk2(x[8 * c8 + 2], x[8 * c8 + 3]); o.z = pk2(x[8 * c8 + 4], x[8 * c8 + 5]); o.w = pk2(x[8 * c8 + 6], x[8 * c8 + 7]);
            *(u32x4*)(dst + 32 * h + 8 * c8) = o; }
    }
}
__device__ __forceinline__ int win_src(int blk, int& cnt) {
    const int tile = blk >> 3, sb = blk & 7; cnt = 32;
    if (tile < 20) return tile * 256 + 32 * sb;
    if (tile == 20) { if (sb == 0) return 5120; if (sb == 4) return 5152; if (sb == 1) { cnt = 16; return 5184; } return -1; }
    if (tile < 29) { const int rk = tile >= 25, tl = rk ? tile - 25 : tile - 21, bj = sb >> 2, wc = sb & 3;
        return (rk ? 6224 : 5200) + (2 * tl + (wc >> 1)) * 128 + bj * 64 + 32 * (wc & 1); }
    if (tile < 37) return 7248 + (tile - 29) * 256 + 32 * sb;
    return 9296 + (tile - 37) * 256 + 32 * sb;
}
__device__ __forceinline__ void p0_prologue(const Args& a, Frame& F) {
    const int gw = F.vcu * NWAVES + F.wave, NGW = F.G * NWAVES;
    unsigned char* ws = a.ws;
    constexpr int KB_IN = DM / 64;
    constexpr int I_IN = KB_IN * (NWIN_PAD / 64);
    constexpr int I_A = (1024 / 64) * (DM / 64);
    constexpr int I_O = (DM / 64) * (DM / 64);
    constexpr int I_PLE = (PLE / 64) * (DM / 64);
    constexpr int NITEMS = I_IN + 2 * I_A + 2 * I_O + I_PLE;
    for (int it = gw; it < NITEMS; it += NGW) {
        int r = it;
        if (r < I_IN) { const int blk64 = r / KB_IN, kb = r % KB_IN; int cnt; const int src = win_src(blk64 * 2 + (F.lane >> 5), cnt);
            const int l5 = F.lane & 31; const bool ok = src >= 0 && l5 < cnt;
            const float* sp = a.w_in + (size_t)(kb * 64) * NWIN + (ok ? src + l5 : 0);
            bf16_t* dp = (bf16_t*)(ws + WS_WIN) + (size_t)(blk64 * 64 + F.lane) * DM + kb * 64;
#pragma unroll
            for (int h = 0; h < 2; ++h) { float x[32];
#pragma unroll
                for (int kk = 0; kk < 32; ++kk) x[kk] = ok ? sp[(size_t)(32 * h + kk) * NWIN] : 0.f;
#pragma unroll
                for (int c8 = 0; c8 < 4; ++c8) { u32x4 o; o.x = pk2(x[8 * c8], x[8 * c8 + 1]); o.y = pk2(x[8 * c8 + 2], x[8 * c8 + 3]); o.z = pk2(x[8 * c8 + 4], x[8 * c8 + 5]); o.w = pk2(x[8 * c8 + 6], x[8 * c8 + 7]);
                    *(u32x4*)(dp + 32 * h + 8 * c8) = o; } }
            continue; } r -= I_IN;
        if (r < I_A) { const int blk = r / 16, kb = r % 16; transpose_item64(a.w_a, 1024, DM, blk * 64, 64, (bf16_t*)(ws + WS_WA), blk * 64, kb * 64, F.lane); continue; } r -= I_A;
        if (r < I_A) { const int blk = r / 16, kb = r % 16; transpose_item64(a.w_b, 1024, DM, blk * 64, 64, (bf16_t*)(ws + WS_WB), blk * 64, kb * 64, F.lane); continue; } r -= I_A;
        if (r < I_O) { const int blk = r / 32, kb = r % 32; transpose_item64(a.w_o, DM, DM, blk * 64, 64, (bf16_t*)(ws + WS_WO), blk * 64, kb * 64, F.lane); continue; } r -= I_O;
        if (r < I_O) { const int blk = r / 32, kb = r % 32; transpose_item64(a.w_pg, DM, DM, blk * 64, 64, (bf16_t*)(ws + WS_WPG), blk * 64, kb * 64, F.lane); continue; } r -= I_O;
        { const int blk = r / 4, kb = r % 4; transpose_item64(a.w_ple, PLE, DM, blk * 64, 64, (bf16_t*)(ws + WS_WPLE), blk * 64, kb * 64, F.lane); }
    }
    bf16_t* H = (bf16_t*)((unsigned char*)a.out + DO_H); bf16_t* PB = (bf16_t*)(ws + WS_PB);
    for (int m = gw; m < MTOK; m += NGW) {
        const f32x4* xr = (const f32x4*)(a.x + (size_t)m * DM) + F.lane; const f32x4* gr = (const f32x4*)a.norm_gain + F.lane;
        f32x4 v[8]; float s = 0.f;
#pragma unroll
        for (int j = 0; j < 8; ++j) v[j] = xr[64 * j];
        const f32x4 pv = *((const f32x4*)(a.p + (size_t)m * PLE) + F.lane);
#pragma unroll
        for (int j = 0; j < 8; ++j) s += (v[j][0] * v[j][0] + v[j][1] * v[j][1]) + (v[j][2] * v[j][2] + v[j][3] * v[j][3]);
        const float rstd = 1.0f / sqrtf(wave_sum(s) * (1.0f / DM) + EPS);
        u32x2* o8 = (u32x2*)(H + (size_t)m * DM) + F.lane;
#pragma unroll
        for (int j = 0; j < 8; ++j) { const f32x4 g = gr[64 * j]; u32x2 w; w.x = pk2(v[j][0] * rstd * g[0], v[j][1] * rstd * g[1]); w.y = pk2(v[j][2] * rstd * g[2], v[j][3] * rstd * g[3]); o8[64 * j] = w; }
        u32x2 w; w.x = pk2(pv[0], pv[1]); w.y = pk2(pv[2], pv[3]); *((u32x2*)(PB + (size_t)m * PLE) + F.lane) = w;
    }
    f32x2* rope = (f32x2*)(ws + WS_ROPE);
    for (int e = (F.vcu * NTHREADS + F.tid); e < MTOK * 64; e += F.G * NTHREADS) {
        const int m = e >> 6, i = e & 63;
        const float invf = exp2f(-(float)i * (1.0f / 64.0f) * 13.287712379549449f);
        const float ang = (float)a.pos[m] * invf;
        float sn, cs; sincosf(ang, &sn, &cs);
        rope[e] = (f32x2){cs, sn};
    }
}
__device__ __forceinline__ void p_final_norm(const Args& a, Frame& F) {
    const int gw = F.vcu * NWAVES + F.wave, NGW = F.G * NWAVES;
    for (int m = gw; m < MTOK; m += NGW) {
        f32x4* xr = (f32x4*)(a.out + (size_t)m * DM) + F.lane; const f32x4* gr = (const f32x4*)a.final_gain + F.lane;
        f32x4 v[8]; float s = 0.f;
#pragma unroll
        for (int j = 0; j < 8; ++j) { v[j] = xr[64 * j]; s += (v[j][0] * v[j][0] + v[j][1] * v[j][1]) + (v[j][2] * v[j][2] + v[j][3] * v[j][3]); }
        const float rstd = 1.0f / sqrtf(wave_sum(s) * (1.0f / DM) + EPS);
#pragma unroll
        for (int j = 0; j < 8; ++j) { const f32x4 g = gr[64 * j]; xr[64 * j] = (f32x4){v[j][0] * rstd * g[0], v[j][1] * rstd * g[1], v[j][2] * rstd * g[2], v[j][3] * rstd * g[3]}; }
    }
}

namespace att {
typedef short s16x4 __attribute__((ext_vector_type(4)));
typedef float f32x16 __attribute__((ext_vector_type(16)));
#define KSWZ(row, colB) ((row) * 256 + ((colB) ^ (((row) & 7) << 4)))
#define SBAR() __builtin_amdgcn_sched_barrier(0)
__device__ __forceinline__ int v_st(int k, int c) { const int kk = (k & ~0xC) | ((k & 4) << 1) | ((k & 8) >> 1); return ((kk >> 3) * 4 + (c >> 5)) * 512 + ((kk & 7) * 32 + (c & 31)) * 2; }
__device__ __forceinline__ int v_rd_base(int lane) { return ((lane & 3) << 3) | (((lane >> 2) & 3) << 6) | (((lane >> 4) & 1) << 5) | (((lane >> 5) & 1) << 8); }
constexpr int v_rd_off(int d0, int ks, int half) { return d0 * 512 + ks * 4096 + half * 2048; }
__device__ __forceinline__ int crow(int r, int hi) { return (r & 3) + 8 * (r >> 2) + 4 * hi; }
#define TRRD(dst, vb, off) asm volatile("ds_read_b64_tr_b16 %0, %1 offset:%2" : "=&v"(dst) : "v"(vb), "i"(off) : "memory")
#define TRRDV(dst, addr) asm volatile("ds_read_b64_tr_b16 %0, %1" : "=&v"(dst) : "v"(addr) : "memory")
__device__ __forceinline__ void qkt(f32x16& p0, f32x16& p1, const LAS unsigned char* Kb, int r32, int hi, const bf16x8* qr) {
    p0 = f32x16{}; p1 = f32x16{};
    const LAS unsigned char* kb[4];
#pragma unroll
    for (int dd = 0; dd < 4; ++dd) kb[dd] = Kb + KSWZ(r32, (dd * 16 + hi * 8) * 2);
#pragma unroll
    for (int d0 = 0; d0 < 8; ++d0) { const LAS unsigned char* a = kb[d0 & 3] + (d0 >> 2) * 128;
        const bf16x8 b0 = *(const LAS bf16x8*)a; const bf16x8 b1 = *(const LAS bf16x8*)(a + 32 * 256);
        p0 = __builtin_amdgcn_mfma_f32_32x32x16_bf16(b0, qr[d0], p0, 0, 0, 0);
        p1 = __builtin_amdgcn_mfma_f32_32x32x16_bf16(b1, qr[d0], p1, 0, 0, 0); }
}
template <int VOFF>
__device__ __forceinline__ void pv_tile(f32x16* o, int vb, bf16x8 pa0, bf16x8 pa1, bf16x8 pa2, bf16x8 pa3) {
#define PV_D0(d0) do { s16x4 l0, l1, l2, l3, h0, h1, h2, h3; constexpr int b_ = VOFF + v_rd_off(d0, 0, 0); \
        TRRD(l0, vb, b_); TRRD(h0, vb, b_ + 2048); TRRD(l1, vb, b_ + 4096); TRRD(h1, vb, b_ + 6144); TRRD(l2, vb, b_ + 8192); TRRD(h2, vb, b_ + 10240); TRRD(l3, vb, b_ + 12288); TRRD(h3, vb, b_ + 14336); \
        asm volatile("s_waitcnt lgkmcnt(0)" ::: "memory"); SBAR(); \
        o[d0] = __builtin_amdgcn_mfma_f32_32x32x16_bf16(pa0, (bf16x8){l0[0], l0[1], l0[2], l0[3], h0[0], h0[1], h0[2], h0[3]}, o[d0], 0, 0, 0); \
        o[d0] = __builtin_amdgcn_mfma_f32_32x32x16_bf16(pa1, (bf16x8){l1[0], l1[1], l1[2], l1[3], h1[0], h1[1], h1[2], h1[3]}, o[d0], 0, 0, 0); \
        o[d0] = __builtin_amdgcn_mfma_f32_32x32x16_bf16(pa2, (bf16x8){l2[0], l2[1], l2[2], l2[3], h2[0], h2[1], h2[2], h2[3]}, o[d0], 0, 0, 0); \
        o[d0] = __builtin_amdgcn_mfma_f32_32x32x16_bf16(pa3, (bf16x8){l3[0], l3[1], l3[2], l3[3], h3[0], h3[1], h3[2], h3[3]}, o[d0], 0, 0, 0); } while (0)
    PV_D0(0); PV_D0(1); PV_D0(2); PV_D0(3);
#undef PV_D0
}
__device__ __forceinline__ void pack_p(const f32x16& p0, const f32x16& p1, bf16x8& pa0, bf16x8& pa1, bf16x8& pa2, bf16x8& pa3) {
#define PK4(P, B_, OUT) do { const unsigned a0 = cvt_pk_bf16(P[B_+0], P[B_+1]), a1 = cvt_pk_bf16(P[B_+2], P[B_+3]); \
        const unsigned b0 = cvt_pk_bf16(P[B_+4], P[B_+5]), b1 = cvt_pk_bf16(P[B_+6], P[B_+7]); \
        auto r0 = __builtin_amdgcn_permlane32_swap(a0, b0, false, false); auto r1 = __builtin_amdgcn_permlane32_swap(a1, b1, false, false); \
        u32x4 w = {r0[0], r1[0], r0[1], r1[1]}; OUT = __builtin_bit_cast(bf16x8, w); } while (0)
    PK4(p0, 0, pa0); PK4(p0, 8, pa1); PK4(p1, 0, pa2); PK4(p1, 8, pa3);
#undef PK4
}
}

__device__ __forceinline__ float ret_log2g(int h) { return log2f(1.0f - exp2f(-5.0f - (float)h)); }
__device__ __forceinline__ void p_ret_kv(const Args& a, Frame& F) {
    using namespace att;
    const bf16_t* RK = (const bf16_t*)(a.ws + WS_RK); const bf16_t* RV = (const bf16_t*)(a.ws + WS_RV); bf16_t* KVT = (bf16_t*)((unsigned char*)a.out + DO_KVT);
    LAS unsigned char* Kl = F.lds; LAS unsigned char* Vl = F.lds + 16384;
    const int tid = F.tid, lane = F.lane, wid = F.wave, r32 = lane & 31, hi = lane >> 5;
    const int sr = tid >> 4, sc = (tid & 15) * 8;
    const int a0 = wid >> 1, dp = (wid & 1) * 2;
    const int vbK = (int)(uintptr_t)Kl + v_rd_base(lane), vbV = (int)(uintptr_t)Vl + v_rd_base(lane);
    for (int item = F.vcu; item < NB * 8 * 64; item += F.G) {
        const int bh = item >> 6, n = item & 63, h = bh & 7;
        const float lg = ret_log2g(h);
        const size_t rowbase = ((size_t)bh * SEQ + (size_t)n * 64) * 128;
#pragma unroll
        for (int i = 0; i < 2; ++i) { const int t = sr + 32 * i;
            const u32x4 kq = *(const u32x4*)(RK + rowbase + (size_t)t * 128 + sc); const u32x4 vq = *(const u32x4*)(RV + rowbase + (size_t)t * 128 + sc);
            const float w = exp2f((float)(63 - t) * lg);
            float kf[8]; kf[0] = bf2f((unsigned short)(kq.x & 0xffff)) * w; kf[1] = bf2f((unsigned short)(kq.x >> 16)) * w; kf[2] = bf2f((unsigned short)(kq.y & 0xffff)) * w; kf[3] = bf2f((unsigned short)(kq.y >> 16)) * w;
            kf[4] = bf2f((unsigned short)(kq.z & 0xffff)) * w; kf[5] = bf2f((unsigned short)(kq.z >> 16)) * w; kf[6] = bf2f((unsigned short)(kq.w & 0xffff)) * w; kf[7] = bf2f((unsigned short)(kq.w >> 16)) * w;
            *(LAS u32x4*)(Kl + v_st(t, sc)) = pack8f(kf); *(LAS u32x4*)(Vl + v_st(t, sc)) = vq; }
        __syncthreads();
        f32x16 acc[2] = {};
#pragma unroll
        for (int ks = 0; ks < 4; ++ks) {
            s16x4 al, ah, b0l, b0h, b1l, b1h;
            TRRDV(al, vbK + v_rd_off(a0, ks, 0)); TRRDV(ah, vbK + v_rd_off(a0, ks, 1));
            TRRDV(b0l, vbV + v_rd_off(dp, ks, 0)); TRRDV(b0h, vbV + v_rd_off(dp, ks, 1));
            TRRDV(b1l, vbV + v_rd_off(dp + 1, ks, 0)); TRRDV(b1h, vbV + v_rd_off(dp + 1, ks, 1));
            asm volatile("s_waitcnt lgkmcnt(0)" ::: "memory"); SBAR();
            const bf16x8 af = (bf16x8){al[0], al[1], al[2], al[3], ah[0], ah[1], ah[2], ah[3]};
            acc[0] = __builtin_amdgcn_mfma_f32_32x32x16_bf16(af, (bf16x8){b0l[0], b0l[1], b0l[2], b0l[3], b0h[0], b0h[1], b0h[2], b0h[3]}, acc[0], 0, 0, 0);
            acc[1] = __builtin_amdgcn_mfma_f32_32x32x16_bf16(af, (bf16x8){b1l[0], b1l[1], b1l[2], b1l[3], b1h[0], b1h[1], b1h[2], b1h[3]}, acc[1], 0, 0, 0);
        }
        bf16_t* dst = KVT + (size_t)item * 16384;
#pragma unroll
        for (int e = 0; e < 2; ++e)
#pragma unroll
            for (int g = 0; g < 4; ++g) { u32x2 w; w.x = cvt_pk_bf16(acc[e][4 * g], acc[e][4 * g + 1]); w.y = cvt_pk_bf16(acc[e][4 * g + 2], acc[e][4 * g + 3]);
                *(u32x2*)(dst + (size_t)(32 * (dp + e) + r32) * 128 + 32 * a0 + 8 * g + 4 * hi) = w; }
        __syncthreads();
    }
}
__device__ __forceinline__ void p_ret_scan(const Args& a, Frame& F) {
    bf16_t* KVT = (bf16_t*)((unsigned char*)a.out + DO_KVT);
    for (int idx = F.vcu * NTHREADS + F.tid; idx < 32 * 2048; idx += F.G * NTHREADS) {
        const int bh = idx >> 11, e8 = idx & 2047, h = bh & 7;
        const float dec = exp2f(64.0f * ret_log2g(h));
        float st[8] = {0.f, 0.f, 0.f, 0.f, 0.f, 0.f, 0.f, 0.f};
        u32x4* p = (u32x4*)(KVT + (size_t)bh * 64 * 16384 + (size_t)e8 * 8);
#pragma unroll 4
        for (int n = 0; n < 64; ++n) {
            const u32x4 kv = p[(size_t)n * 2048];
            p[(size_t)n * 2048] = pack8f(st);
            st[0] = st[0] * dec + bf2f((unsigned short)(kv.x & 0xffff)); st[1] = st[1] * dec + bf2f((unsigned short)(kv.x >> 16));
            st[2] = st[2] * dec + bf2f((unsigned short)(kv.y & 0xffff)); st[3] = st[3] * dec + bf2f((unsigned short)(kv.y >> 16));
            st[4] = st[4] * dec + bf2f((unsigned short)(kv.z & 0xffff)); st[5] = st[5] * dec + bf2f((unsigned short)(kv.z >> 16));
            st[6] = st[6] * dec + bf2f((unsigned short)(kv.w & 0xffff)); st[7] = st[7] * dec + bf2f((unsigned short)(kv.w >> 16));
        }
    }
}
__device__ __forceinline__ void p_ret_out(const Args& a, Frame& F) {
    using namespace att;
    const bf16_t* RQ = (const bf16_t*)(a.ws + WS_RQ); const bf16_t* RK = (const bf16_t*)(a.ws + WS_RK); const bf16_t* RV = (const bf16_t*)(a.ws + WS_RV);
    const bf16_t* RZ = (const bf16_t*)(a.ws + WS_RZ); const bf16_t* KVT = (const bf16_t*)((const unsigned char*)a.out + DO_KVT); bf16_t* BO = (bf16_t*)(a.ws + WS_BO);
    const int tid = F.tid, lane = F.lane, wid = F.wave, r32 = lane & 31, hi = lane >> 5;
    const int pr = wid >> 1, qblk = wid & 1, lt = tid & 127;
    LAS unsigned char* Kl = F.lds + pr * 32768; LAS unsigned char* Vl = Kl + 16384;
    const int vb = (int)(uintptr_t)Vl + v_rd_base(lane);
    for (int it0 = F.vcu * 4; it0 < NB * 8 * 64; it0 += F.G * 4) {
        const int item = it0 + pr, bh = item >> 6, n = item & 63, h = bh & 7, b = bh >> 3;
        const float lg = ret_log2g(h);
        const size_t rowbase = ((size_t)bh * SEQ + (size_t)n * 64) * 128;
#pragma unroll
        for (int i = 0; i < 8; ++i) { const int c = lt + 128 * i, t = c >> 4, sc = (c & 15) * 8;
            *(LAS u32x4*)(Kl + KSWZ(t, sc * 2)) = *(const u32x4*)(RK + rowbase + (size_t)t * 128 + sc);
            *(LAS u32x4*)(Vl + v_st(t, sc)) = *(const u32x4*)(RV + rowbase + (size_t)t * 128 + sc); }
        bf16x8 qr[8];
#pragma unroll
        for (int d0 = 0; d0 < 8; ++d0) qr[d0] = *(const bf16x8*)(RQ + rowbase + (size_t)(32 * qblk + r32) * 128 + d0 * 16 + hi * 8);
        __syncthreads();
        f32x16 p0, p1;
        qkt(p0, p1, Kl, r32, hi, qr);
        const int iq = 32 * qblk + r32;
#pragma unroll
        for (int r = 0; r < 16; ++r) { const int j0 = crow(r, hi), j1 = j0 + 32;
            const int e0 = (iq > j0 ? iq - j0 : j0 - iq) - iq - 1, e1 = (iq > j1 ? iq - j1 : j1 - iq) - iq - 1;
            p0[r] *= exp2f((float)e0 * lg); p1[r] *= exp2f((float)e1 * lg); }
        bf16x8 pa0, pa1, pa2, pa3;
        pack_p(p0, p1, pa0, pa1, pa2, pa3);
        f32x16 o[4] = {};
        SBAR();
        pv_tile<0>(o, vb, pa0, pa1, pa2, pa3);
        const bf16_t* ST = KVT + (size_t)item * 16384;
#pragma unroll
        for (int d0 = 0; d0 < 4; ++d0)
#pragma unroll
            for (int kk = 0; kk < 8; ++kk) { const bf16x8 sf = *(const bf16x8*)(ST + (size_t)(32 * d0 + r32) * 128 + 16 * kk + 8 * hi);
                o[d0] = __builtin_amdgcn_mfma_f32_32x32x16_bf16(qr[kk], sf, o[d0], 0, 0, 0); }
        float gain[4];
#pragma unroll
        for (int d0 = 0; d0 < 4; ++d0) gain[d0] = a.gn_gain[h * 128 + 32 * d0 + r32];
#pragma unroll
        for (int r = 0; r < 16; ++r) { const int il = 32 * qblk + crow(r, hi); const float fs = exp2f((float)(il + 1) * lg);
            float y0 = o[0][r] * fs, y1 = o[1][r] * fs, y2 = o[2][r] * fs, y3 = o[3][r] * fs;
            float s1 = (y0 + y1) + (y2 + y3), s2 = (y0 * y0 + y1 * y1) + (y2 * y2 + y3 * y3);
#pragma unroll
            for (int k = 1; k < 32; k <<= 1) { s1 += __shfl_xor(s1, k); s2 += __shfl_xor(s2, k); }
            const float mu = s1 * (1.0f / 128.0f); const float var = fmaxf(s2 * (1.0f / 128.0f) - mu * mu, 0.f); const float rs = 1.0f / sqrtf(var + EPS);
            const size_t m = (size_t)b * SEQ + (size_t)n * 64 + il;
            const bf16_t* rz = RZ + m * 1024 + h * 128 + r32; bf16_t* bo = BO + m * 1024 + h * 128 + r32;
            const float v0 = (y0 - mu) * rs * gain[0] * bf2f(rz[0]), v1 = (y1 - mu) * rs * gain[1] * bf2f(rz[32]), v2 = (y2 - mu) * rs * gain[2] * bf2f(rz[64]), v3 = (y3 - mu) * rs * gain[3] * bf2f(rz[96]);
            const float n0 = __shfl_xor(v0, 1), n1 = __shfl_xor(v1, 1), n2 = __shfl_xor(v2, 1), n3 = __shfl_xor(v3, 1);
            if ((r32 & 1) == 0) { *(unsigned*)(bo) = cvt_pk_bf16(v0, n0); *(unsigned*)(bo + 32) = cvt_pk_bf16(v1, n1); *(unsigned*)(bo + 64) = cvt_pk_bf16(v2, n2); *(unsigned*)(bo + 96) = cvt_pk_bf16(v3, n3); }
        }
        __syncthreads();
    }
}

__device__ __forceinline__ void p_index(const Args& a, Frame& F) {
    using namespace att;
    const bf16_t* IQ = (const bf16_t*)((const unsigned char*)a.out + DO_IQ); const bf16_t* IK = (const bf16_t*)(a.ws + WS_IK); const float* IW = (const float*)(a.ws + WS_IW);
    unsigned* MASK = (unsigned*)(a.ws + WS_MASK);
    constexpr int NBIN = 1024, CAP = 256;
    const int tid = F.tid, lane = F.lane, wid = F.wave, r32 = lane & 31, hi = lane >> 5, pq = wid >> 1, e = wid & 1;
    LAS unsigned char* KS = F.lds;
    LAS unsigned* hist = (LAS unsigned*)(F.lds + 65536) + pq * 2 * NBIN;
    LAS float* part = (LAS float*)(F.lds + 98304) + pq * 8;
    LAS int* misc = (LAS int*)(F.lds + 98816) + pq * 16; LAS float* miscf = (LAS float*)(F.lds + 98816) + pq * 16;
    LAS float* cand = (LAS float*)(F.lds + 99072) + pq * 2 * CAP;
    const float NINF = -__builtin_inff(), PINF = __builtin_inff();
    int boff[4];
#pragma unroll
    for (int ks = 0; ks < 4; ++ks) boff[ks] = e * 4096 + r32 * 128 + (((2 * ks + hi) ^ (r32 & 7)) << 4);
    const unsigned sgo = (unsigned)((tid >> 3) * 64 + (((tid & 7) ^ ((tid >> 3) & 7)) * 8)) * 2u;
    for (int round = 0; round * F.G < 2048; ++round) {
        const int j = round * F.G + ((round & 1) ? F.G - 1 - F.vcu : F.vcu);
        if (j >= 2048) continue;
        const int c = 63 - (j >> 5), sub = j & 31, b = sub >> 3, pg = sub & 7;
        const int m0 = b * SEQ + 64 * c, ntile = 2 * (c + 1), ngrp = (ntile + 7) >> 3, ntzh = 4 * ((c >> 2) + 1);
        const bool need_sel = c >= 4;
        const int p = pg * 4 + pq;
        const int qrow = m0 + 2 * p + hi;
        bf16x8 af[4];
        { const int aq_ = (r32 >> 2) & 1, ah_ = (r32 & 3) + 4 * (r32 >> 3);
#pragma unroll
          for (int ks = 0; ks < 4; ++ks) af[ks] = *(const bf16x8*)(IQ + (size_t)(m0 + 2 * p + aq_) * 1024 + ah_ * 64 + 16 * ks + 8 * hi); }
        float wq[16];
#pragma unroll
        for (int q4 = 0; q4 < 4; ++q4) { const f32x4 w4 = *(const f32x4*)(IW + (size_t)qrow * 16 + 4 * q4); wq[4 * q4] = w4[0]; wq[4 * q4 + 1] = w4[1]; wq[4 * q4 + 2] = w4[2]; wq[4 * q4 + 3] = w4[3]; }
        const unsigned char* ikb = (const unsigned char*)(IK + (size_t)b * SEQ * 64);
#pragma unroll
        for (int i = 0; i < 4; ++i) __builtin_amdgcn_global_load_lds((const unsigned*)(ikb + sgo + i * 8192), (LAS unsigned*)(KS + wid * 1024 + i * 8192), 16, 0, 0);
        __syncthreads();
        float v[64];
        int lim_v = ntile - e; asm volatile("" : "+v"(lim_v));
#pragma unroll
        for (int g = 0; g < 16; ++g) {
            if (g < ngrp) {
                if (g + 1 < ngrp) { unsigned so_ = sgo; asm volatile("" : "+v"(so_));
                    const unsigned char* gb = ikb + (size_t)(g + 1) * 32768; LAS unsigned char* kn = KS + ((g + 1) & 1) * 32768 + wid * 1024;
#pragma unroll
                    for (int i = 0; i < 4; ++i) __builtin_amdgcn_global_load_lds((const unsigned*)(gb + so_ + i * 8192), (LAS unsigned*)(kn + i * 8192), 16, 0, 0); }
                const LAS unsigned char* kb = KS + (g & 1) * 32768;
#pragma unroll
                for (int i = 0; i < 4; ++i) {
                    f32x16 cc = {};
#pragma unroll
                    for (int ks = 0; ks < 4; ++ks) cc = __builtin_amdgcn_mfma_f32_32x32x16_bf16(af[ks], *(const LAS bf16x8*)(kb + i * 8192 + boff[ks]), cc, 0, 0, 0);
                    float idx = 0.f;
#pragma unroll
                    for (int r = 0; r < 16; ++r) idx += fmaxf(cc[r], 0.f) * wq[r];
                    v[g * 4 + i] = (g * 8 + 2 * i < lim_v) ? idx : NINF;
                    if (i & 1) __builtin_amdgcn_sched_barrier(0);
                }
                __syncthreads();
            } else {
#pragma unroll
                for (int i = 0; i < 4; ++i) v[g * 4 + i] = NINF;
            }
        }
        float T = NINF; int bstar = -1; bool ovf = false; float mn = 0.f, scale = 0.f;
        if (need_sel) {
            int lane_s = lane; asm volatile("" : "+v"(lane_s));
            const int r32s = lane_s & 31, his = lane_s >> 5;
            float lmn = PINF, lmx = NINF;
#pragma unroll
            for (int tt = 0; tt < 64; ++tt) if (tt <= c) { lmx = fmaxf(lmx, v[tt]); lmn = fminf(lmn, v[tt] == NINF ? PINF : v[tt]); }
#pragma unroll
            for (int k = 1; k < 32; k <<= 1) { const int pa = (lane_s ^ k) << 2; lmx = fmaxf(lmx, __builtin_bit_cast(float, __builtin_amdgcn_ds_bpermute(pa, __builtin_bit_cast(int, lmx)))); lmn = fminf(lmn, __builtin_bit_cast(float, __builtin_amdgcn_ds_bpermute(pa, __builtin_bit_cast(int, lmn)))); }
            if (r32s == 0) { part[(e * 2 + his) * 2] = lmn; part[(e * 2 + his) * 2 + 1] = lmx; }
#pragma unroll
            for (int k = 0; k < 4; ++k) *(LAS u32x4*)(F.lds + 65536 + (wid * 64 + lane_s + 512 * k) * 16) = (u32x4){0u, 0u, 0u, 0u};
            if (tid < 8) ((LAS int*)(F.lds + 98816))[(tid >> 1) * 16 + 4 + (tid & 1)] = 0;
            __syncthreads();
            mn = fminf(part[his * 2], part[(2 + his) * 2]); const float mx = fmaxf(part[his * 2 + 1], part[(2 + his) * 2 + 1]);
            scale = (mx > mn) ? (float)NBIN / (mx - mn) : 0.f;
#pragma unroll
            for (int tt = 0; tt < 64; ++tt) { if (tt <= c) if (v[tt] != NINF) { int bin = (int)((v[tt] - mn) * scale); bin = bin > NBIN - 1 ? NBIN - 1 : (bin < 0 ? 0 : bin);
                __hip_atomic_fetch_add(hist + his * NBIN + bin, 1u, __ATOMIC_RELAXED, __HIP_MEMORY_SCOPE_WORKGROUP); }
                if ((tt & 7) == 7) __builtin_amdgcn_sched_barrier(0); }
            __syncthreads();
            { unsigned cnt[16]; unsigned sum = 0;
#pragma unroll
              for (int k = 0; k < 4; ++k) { const u32x4 w = *(const LAS u32x4*)(hist + e * NBIN + 16 * lane_s + 4 * k); cnt[4 * k] = w.x; cnt[4 * k + 1] = w.y; cnt[4 * k + 2] = w.z; cnt[4 * k + 3] = w.w; }
#pragma unroll
              for (int k = 0; k < 16; ++k) sum += cnt[k];
              unsigned suf = sum;
#pragma unroll
              for (int k = 1; k < 64; k <<= 1) { const unsigned o = (unsigned)__builtin_amdgcn_ds_bpermute(((lane_s + k) & 63) << 2, (int)suf); if (lane_s + k < 64) suf += o; }
              const unsigned above = suf - sum;
              if (above < 256u && suf >= 256u) { unsigned run = above; int bs = 16 * lane_s; unsigned ca = above; bool found = false;
#pragma unroll
                  for (int k = 15; k >= 0; --k) { if (!found) { if (run + cnt[k] >= 256u) { bs = 16 * lane_s + k; ca = run; found = true; } else run += cnt[k]; } }
                  misc[e] = bs; misc[2 + e] = (int)ca; }
            }
            __syncthreads();
            bstar = misc[his];
            asm volatile("" : "+v"(mn), "+v"(scale));
#pragma unroll
            for (int tt = 0; tt < 64; ++tt) { if (tt <= c) if (v[tt] != NINF) { int bin = (int)((v[tt] - mn) * scale); bin = bin > NBIN - 1 ? NBIN - 1 : (bin < 0 ? 0 : bin);
                if (bin == bstar) { const int pos = __hip_atomic_fetch_add(misc + 4 + his, 1, __ATOMIC_RELAXED, __HIP_MEMORY_SCOPE_WORKGROUP); if (pos < CAP) cand[his * CAP + pos] = v[tt]; } }
                if ((tt & 7) == 7) __builtin_amdgcn_sched_barrier(0); }
            __syncthreads();
            { const int n = misc[4 + e], kk = 256 - misc[2 + e];
              if (n <= CAP) {
                  float ci[4]; int rk[4];
#pragma unroll
                  for (int k = 0; k < 4; ++k) { const int i = lane_s + 64 * k; ci[k] = i < n ? cand[e * CAP + i] : NINF; rk[k] = 0; }
                  for (int jj = 0; jj < n; ++jj) { const float cj = cand[e * CAP + jj];
#pragma unroll
                      for (int k = 0; k < 4; ++k) rk[k] += (cj > ci[k] || (cj == ci[k] && jj < lane_s + 64 * k)) ? 1 : 0; }
#pragma unroll
                  for (int k = 0; k < 4; ++k) if (lane_s + 64 * k < n && rk[k] == kk - 1) miscf[6 + e] = ci[k];
              } else if (lane_s == 0) miscf[6 + e] = NINF;
              if (lane_s == 0) misc[8 + e] = n > CAP ? 1 : 0; }
            __syncthreads();
            T = miscf[6 + his]; ovf = misc[8 + his] != 0;
            asm volatile("" : "+v"(mn), "+v"(scale));
        }
#pragma unroll
        for (int tt = 0; tt < 64; ++tt) if (tt < ntzh) { const int t = e + 2 * tt;
            bool sel = v[tt] != NINF;
            if (need_sel && sel) { if (ovf) { int bin = (int)((v[tt] - mn) * scale); bin = bin > NBIN - 1 ? NBIN - 1 : (bin < 0 ? 0 : bin); sel = bin >= bstar; } else sel = v[tt] >= T; }
            const unsigned long long bal = __ballot(sel);
            if (r32 == 0) MASK[(size_t)qrow * 128 + t] = hi ? (unsigned)(bal >> 32) : (unsigned)bal;
            if ((tt & 7) == 7) __builtin_amdgcn_sched_barrier(0); }
    }
}

__device__ __forceinline__ int t5_bucket(int rel) {
    const int n = rel < 0 ? -rel : rel; int bkt;
    if (n < 8) bkt = n; else { int k = (31 - __builtin_clz((unsigned)(n * n))) - 6; bkt = 8 + k; if (bkt > 15) bkt = 15; }
    return bkt + (rel > 0 ? 16 : 0);
}
__device__ __forceinline__ void attn_unit(const Args& a, Frame& F, int b, int h, int qb) {
    using namespace att;
    LAS unsigned char* Kl = F.lds; LAS unsigned char* Vl = F.lds + 32768;
    int tid = threadIdx.x; asm volatile("" : "+v"(tid));
    const int lane = tid & 63, wid = __builtin_amdgcn_readfirstlane(tid >> 6), r32 = lane & 31, hi = lane >> 5;
    LAS float* wsf = (LAS float*)(F.lds + 65536) + wid * 64; LAS float* BT = (LAS float*)(F.lds + 65536 + 2048);
    constexpr float LOG2E = 1.4426950408889634f, C2 = 0.08838834764831845f * LOG2E;
    const float NINF = -__builtin_inff();
    if (tid < 256) { const int rel = tid - 192; BT[tid] = (a.rel_bias[t5_bucket(rel) * 8 + h] - a.rel_bias[15 * 8 + h]) * LOG2E; }
    const size_t hb = ((size_t)(b * 8 + h) * SEQ) * 128;
    const bf16_t* AQh = (const bf16_t*)((const unsigned char*)a.out + DO_AQ) + hb; const bf16_t* AKh = (const bf16_t*)(a.ws + WS_AK) + hb; const bf16_t* AVh = (const bf16_t*)(a.ws + WS_AV) + hb;
    const int qpos = 256 * qb + 32 * wid + r32, cw = 4 * qb + (wid >> 1);
    const unsigned* MKb = (const unsigned*)(a.ws + WS_MASK) + (size_t)(b * SEQ + 256 * qb) * 128;
    const unsigned mko = (unsigned)(32 * wid + r32) * 128u;
    bf16x8 qr[8];
    { const unsigned qo = (unsigned)qpos * 128u + hi * 8u;
#pragma unroll
      for (int d0 = 0; d0 < 8; ++d0) qr[d0] = *(const bf16x8*)(AQh + qo + d0 * 16); }
    const int sr = tid >> 4, sc = (tid & 15) * 8, kws = KSWZ(sr, sc * 2), vs0 = v_st(sr, sc), vs1 = v_st(32 + sr, sc);
    const unsigned so = (unsigned)sr * 128u + sc;
    const int vb = (int)(uintptr_t)Vl + v_rd_base(lane);
    const int NT = 4 * (qb + 1);
    u32x4 k0, k1, v0, v1; u32x2 mw, mwn;
    { k0 = *(const u32x4*)(AKh + so); k1 = *(const u32x4*)(AKh + so + 32 * 128); v0 = *(const u32x4*)(AVh + so); v1 = *(const u32x4*)(AVh + so + 32 * 128);
      mw = *(const u32x2*)(MKb + mko);
      *(LAS u32x4*)(Kl + kws) = k0; *(LAS u32x4*)(Kl + kws + 32 * 256) = k1; *(LAS u32x4*)(Vl + vs0) = v0; *(LAS u32x4*)(Vl + vs1) = v1; }
    __syncthreads();
    float m_run = -1e30f, l_run = 0.f; f32x16 o[4] = {};
    mwn = mw;
#pragma unroll 1
    for (int t = 0; t < NT; ++t) {
        const int buf = t & 1;
        if (t + 1 < NT) { const bf16_t* kp = AKh + (size_t)(t + 1) * 8192; const bf16_t* vp = AVh + (size_t)(t + 1) * 8192;
            k0 = *(const u32x4*)(kp + so); k1 = *(const u32x4*)(kp + so + 32 * 128); v0 = *(const u32x4*)(vp + so); v1 = *(const u32x4*)(vp + so + 32 * 128);
            mwn = *(const u32x2*)(MKb + 2 * (t + 1) + mko); }
        f32x16 p0, p1;
        qkt(p0, p1, Kl + buf * 16384, r32, hi, qr);
        const unsigned w0s = mw.x >> (4 * hi), w1s = mw.y >> (4 * hi);
        const bool near = t >= cw - 2;
        const int relb = 64 * t + 4 * hi - qpos + 192;
        float tmax = NINF;
#pragma unroll
        for (int r = 0; r < 16; ++r) { const int bp = (r & 3) + 8 * (r >> 2);
            float z0 = p0[r] * C2, z1 = p1[r] * C2;
            if (near) { int i0 = relb + bp, i1 = i0 + 32; i0 = i0 < 0 ? 0 : (i0 > 255 ? 255 : i0); i1 = i1 < 0 ? 0 : (i1 > 255 ? 255 : i1); z0 += BT[i0]; z1 += BT[i1]; }
            z0 = ((w0s >> bp) & 1u) ? z0 : NINF; z1 = ((w1s >> bp) & 1u) ? z1 : NINF;
            p0[r] = z0; p1[r] = z1; tmax = fmaxf(tmax, fmaxf(z0, z1)); }
        tmax = fmaxf(tmax, __shfl_xor(tmax, 32));
        const float m_new = fmaxf(m_run, tmax), alpha = __builtin_amdgcn_exp2f(m_run - m_new); m_run = m_new;
        float rs = 0.f;
#pragma unroll
        for (int r = 0; r < 16; ++r) { p0[r] = __builtin_amdgcn_exp2f(p0[r] - m_new); p1[r] = __builtin_amdgcn_exp2f(p1[r] - m_new); rs += p0[r] + p1[r]; }
        rs += __shfl_xor(rs, 32);
        l_run = l_run * alpha + rs;
        if (__any(alpha < 1.f)) { if (hi == 0) wsf[r32] = alpha; LDS_WAIT();
#pragma unroll
            for (int d_ = 0; d_ < 4; ++d_)
#pragma unroll
                for (int r = 0; r < 16; ++r) o[d_][r] *= wsf[crow(r, hi)]; }
        bf16x8 pa0, pa1, pa2, pa3;
        pack_p(p0, p1, pa0, pa1, pa2, pa3);
        SBAR();
        if (buf == 0) pv_tile<0>(o, vb, pa0, pa1, pa2, pa3); else pv_tile<16384>(o, vb, pa0, pa1, pa2, pa3);
        if (t + 1 < NT) { LAS unsigned char* Kn = Kl + (buf ^ 1) * 16384; LAS unsigned char* Vn = Vl + (buf ^ 1) * 16384;
            *(LAS u32x4*)(Kn + kws) = k0; *(LAS u32x4*)(Kn + kws + 32 * 256) = k1; *(LAS u32x4*)(Vn + vs0) = v0; *(LAS u32x4*)(Vn + vs1) = v1; }
        mw = mwn;
        __syncthreads();
    }
    if (hi == 0) wsf[32 + r32] = l_run; LDS_WAIT();
    { int r32e = r32, hie = hi; asm volatile("" : "+v"(r32e), "+v"(hie));
      const size_t ub = ((size_t)b * SEQ + 256 * qb + 32 * wid) * 1024 + h * 128;
      const bf16_t* AZu = (const bf16_t*)(a.ws + WS_AZ) + ub; bf16_t* AOu = (bf16_t*)((unsigned char*)a.out + DO_AO) + ub;
#pragma unroll
      for (int r = 0; r < 16; ++r) { const float rl = 1.0f / wsf[32 + crow(r, hie)];
        const unsigned eo = (unsigned)crow(r, hie) * 1024u + r32e;
        const float x0 = o[0][r] * rl * bf2f(AZu[eo]), x1 = o[1][r] * rl * bf2f(AZu[eo + 32]), x2 = o[2][r] * rl * bf2f(AZu[eo + 64]), x3 = o[3][r] * rl * bf2f(AZu[eo + 96]);
        const float n0 = __shfl_xor(x0, 1), n1 = __shfl_xor(x1, 1), n2 = __shfl_xor(x2, 1), n3 = __shfl_xor(x3, 1);
        if ((r32e & 1) == 0) { *(unsigned*)(AOu + eo) = cvt_pk_bf16(x0, n0); *(unsigned*)(AOu + eo + 32) = cvt_pk_bf16(x1, n1); *(unsigned*)(AOu + eo + 64) = cvt_pk_bf16(x2, n2); *(unsigned*)(AOu + eo + 96) = cvt_pk_bf16(x3, n3); } } }
    __syncthreads();
}
__device__ __forceinline__ void p_attn(const Args& a, Frame& F) {
    for (int u2 = F.vcu; u2 < 256; u2 += F.G) { const int bh = u2 >> 3, s = u2 & 7;
        for (int pass = 0; pass < 2; ++pass) attn_unit(a, F, bh >> 3, bh & 7, pass ? 15 - s : s); }
}

typedef __attribute__((address_space(1))) unsigned gu32;
#define XB_TMO      128
#define XB_XCNT(j)  (256  + 64 * (j))
#define XB_XSUB(j)  (1280 + 64 * (j))
#define XB_XGEN(j)  (2304 + 64 * (j))
#define XB_TOP      3328
#define XB_TOPGEN   3392
#define XCD_BAR_WORDS 3456
#define XB_SPIN_CAP (1u << 20)
__device__ __forceinline__ unsigned xb_ld(unsigned* p)              { return __hip_atomic_load(p, __ATOMIC_RELAXED, __HIP_MEMORY_SCOPE_AGENT); }
__device__ __forceinline__ unsigned xb_add(unsigned* p, unsigned v) { return __hip_atomic_fetch_add(p, v, __ATOMIC_RELAXED, __HIP_MEMORY_SCOPE_AGENT); }
__device__ __forceinline__ unsigned xb_xcc_id() { return (unsigned)__builtin_amdgcn_s_getreg((3 << 11) | 20) & 0xFu; }
#define XB_SPIN(cond, bar) do { unsigned _sp = 0; while (cond) { __builtin_amdgcn_s_sleep(1); \
    if ((++_sp & 255u) == 0u) { if (xb_ld(&(bar)[XB_TMO])) break; if (_sp > XB_SPIN_CAP) { atomicAdd(&(bar)[XB_TMO], 1u); break; } } } } while (0)
struct XcdBarrier { unsigned* bar; unsigned x; volatile LAS unsigned* st; };
__device__ __forceinline__ XcdBarrier xcd_barrier_post(unsigned* bar, volatile LAS unsigned* st) {
    XcdBarrier b; b.bar = bar; b.x = xb_xcc_id(); b.st = st;
    if (threadIdx.x == 0) (void)xb_add(&bar[XB_XCNT(b.x)], 1u);
    return b;
}
__device__ __forceinline__ void xcd_barrier_complete(unsigned* bar, unsigned x, unsigned& nloc, unsigned& nx) {
    const unsigned G = gridDim.x * gridDim.y * gridDim.z;
    unsigned sum, cnt, mine, sp = 0u;
    for (;;) {
        sum = 0u; cnt = 0u; mine = 0u;
#pragma unroll
        for (unsigned j = 0; j < 16; ++j) { const unsigned c = xb_ld(&bar[XB_XCNT(j)]); sum += c; cnt += (c > 0u) ? 1u : 0u; mine = (j == x) ? c : mine; }
        if (sum == G) break;
        __builtin_amdgcn_s_sleep(1);
        if ((++sp & 255u) == 0u) { if (xb_ld(&bar[XB_TMO])) break; if (sp > XB_SPIN_CAP) { atomicAdd(&bar[XB_TMO], 1u); break; } }
    }
    nloc = mine > 0u ? mine : 1u; nx = cnt > 0u ? cnt : 1u;
}
__device__ __forceinline__ void xcd_barrier(const XcdBarrier& b) {
    asm volatile("s_waitcnt vmcnt(0)" ::: "memory");
    __syncthreads();
    if (threadIdx.x == 0) {
        unsigned* bar = b.bar;
        __builtin_amdgcn_s_waitcnt(0);
        unsigned nloc = b.st[0], nx = b.st[1];
        if (nloc == 0u) { xcd_barrier_complete(bar, b.x, nloc, nx); b.st[0] = nloc; b.st[1] = nx; }
        const unsigned old = xb_add(&bar[XB_XSUB(b.x)], 1u);
        const unsigned gen = old / nloc;
        if (old + 1u == (gen + 1u) * nloc) {
            __builtin_amdgcn_fence(__ATOMIC_RELEASE, "agent");
            asm volatile("s_waitcnt vmcnt(0)" ::: "memory");
            const unsigned og = xb_add(&bar[XB_TOP], 1u);
            const unsigned tg = og / nx;
            if (og + 1u == (tg + 1u) * nx) xb_add(&bar[XB_TOPGEN], 1u);
            else XB_SPIN(xb_ld(&bar[XB_TOPGEN]) == tg, bar);
            __builtin_amdgcn_fence(__ATOMIC_ACQUIRE, "agent");
            xb_add(&bar[XB_XGEN(b.x)], 1u);
            asm volatile("s_waitcnt vmcnt(0)" ::: "memory");
        } else {
            XB_SPIN(xb_ld(&bar[XB_XGEN(b.x)]) == gen, bar);
            __builtin_amdgcn_fence(__ATOMIC_ACQUIRE, "agent");
            asm volatile("s_waitcnt vmcnt(0)" ::: "memory");
        }
    }
    __syncthreads();
}

constexpr int NPHASES = 9;
constexpr int LDS_MISC = 139264;
constexpr size_t CTL_ZERO_BYTES = 65536;
__global__ void __launch_bounds__(NTHREADS, 2) fwd_kernel(Args args) {
    extern __shared__ __attribute__((aligned(16))) unsigned char lds_raw[];
    cg::grid_group grid = cg::this_grid();
    Frame F;
    F.lds = (LAS unsigned char*)lds_raw;
    frame_ids(F);
    F.G = gridDim.x; { const int bx = blockIdx.x; F.vcu = (F.G % 8 == 0) ? (bx % 8) * (F.G / 8) + bx / 8 : bx; }
    const int lo = args.ph_lo, hi = args.ph_hi;
    unsigned char* ws = args.ws;
    volatile LAS unsigned* MISC = (volatile LAS unsigned*)(F.lds + LDS_MISC);
    if (threadIdx.x < 16) MISC[threadIdx.x] = 0u;
    __syncthreads();
    XcdBarrier bar = xcd_barrier_post((unsigned*)(ws + WS_CTL) + 1024, MISC + 8);
#define IN(k) (lo <= (k) && (k) < hi)
#define SEAM_CG(k) do { if (IN(k) && IN((k) + 1)) { __threadfence(); grid.sync(); } } while (0)
#define SEAM(k) do { if (IN(k) && IN((k) + 1)) { xcd_barrier(bar); } } while (0)
    if (IN(0)) { frame_ids(F); p0_prologue(args, F); }
    SEAM_CG(0);
    if (IN(1)) {
        pg8::Gemm g{(const bf16_t*)((unsigned char*)args.out + DO_H), (const bf16_t*)(ws + WS_WIN), MTOK, NWIN_PAD, DM}; pg8::StaticOrder S; S.init(MTOK, NWIN_PAD, F.G, (int)blockIdx.x);
        EpiProj E{ws, (unsigned char*)args.out};
        pg8::gemm_phase<EpiProj, pg8::StaticOrder, true>(F.lds, g, S, E);
    }
    SEAM(1);
    if (IN(2)) { frame_ids(F); p_ret_kv(args, F); __syncthreads(); frame_ids(F); p_index(args, F); }
    SEAM(2);
    if (IN(3)) { frame_ids(F); p_ret_scan(args, F); __syncthreads(); frame_ids(F); p_attn(args, F); }
    SEAM(3);
    if (IN(4)) {
        frame_ids(F); p_ret_out(args, F); __syncthreads();
        pg8::Gemm g{(const bf16_t*)((unsigned char*)args.out + DO_AO), (const bf16_t*)(ws + WS_WA), MTOK, DM, 1024}; pg8::StaticOrder S; S.init(MTOK, DM, F.G, (int)blockIdx.x);
        EpiMerge<false> E{nullptr, (const bf16_t*)(ws + WS_GA), (bf16_t*)(ws + WS_T)};
        pg8::gemm_phase<EpiMerge<false>, pg8::StaticOrder, true>(F.lds, g, S, E);
    }
    SEAM(4);
    if (IN(5)) {
        pg8::Gemm g{(const bf16_t*)(ws + WS_BO), (const bf16_t*)(ws + WS_WB), MTOK, DM, 1024}; pg8::StaticOrder S; S.init(MTOK, DM, F.G, (int)blockIdx.x);
        EpiMerge<true> E{(const bf16_t*)(ws + WS_T), (const bf16_t*)(ws + WS_GB), (bf16_t*)(ws + WS_MG)};
        pg8::gemm_phase<EpiMerge<true>, pg8::StaticOrder, true>(F.lds, g, S, E);
    }
    SEAM(5);
    if (IN(6)) {
        { pg8::Gemm g{(const bf16_t*)(ws + WS_MG), (const bf16_t*)(ws + WS_WO), MTOK, DM, DM}; pg8::StaticOrder S; S.init(MTOK, DM, F.G, (int)blockIdx.x);
          EpiResid E{args.x, args.out, (bf16_t*)(ws + WS_RB)};
          pg8::gemm_phase<EpiResid, pg8::StaticOrder, true>(F.lds, g, S, E); }
        { pg8::Gemm g{(const bf16_t*)(ws + WS_PB), (const bf16_t*)(ws + WS_WPLE), MTOK, DM, PLE}; pg8::StaticOrder S; S.init(MTOK, DM, F.G, (int)blockIdx.x);
          EpiPlainBf16<DM> E{(bf16_t*)(ws + WS_U)};
          pg8::gemm_phase<EpiPlainBf16<DM>, pg8::StaticOrder, true>(F.lds, g, S, E); }
    }
    SEAM(6);
    if (IN(7)) {
        pg8::Gemm g{(const bf16_t*)(ws + WS_RB), (const bf16_t*)(ws + WS_WPG), MTOK, DM, DM}; pg8::StaticOrder S; S.init(MTOK, DM, F.G, (int)blockIdx.x);
        EpiGate E{args.out, (const bf16_t*)(ws + WS_U), args.out};
        pg8::gemm_phase<EpiGate, pg8::StaticOrder, true>(F.lds, g, S, E);
    }
    SEAM(7);
    if (IN(8)) { frame_ids(F); p_final_norm(args, F); }
#undef IN
#undef SEAM
#undef SEAM_CG
}

#ifndef ONE_LAUNCH
#define ONE_LAUNCH 1
#endif
extern "C" void kernel_launch(void* const* d_in, const int* in_sizes, int n_in, void* d_out, int out_size, void* d_ws, size_t ws_size, hipStream_t stream) {
    static int grid = 0;
    if (grid == 0) {
        int dev = 0, cus = 0, per_cu = 0;
        (void)hipGetDevice(&dev);
        if (hipDeviceGetAttribute(&cus, hipDeviceAttributeMultiprocessorCount, dev) != hipSuccess || cus <= 0) cus = 256;
        (void)hipFuncSetAttribute((const void*)fwd_kernel, hipFuncAttributeMaxDynamicSharedMemorySize, LDS_BYTES);
        if (hipOccupancyMaxActiveBlocksPerMultiprocessor(&per_cu, (const void*)fwd_kernel, NTHREADS, LDS_BYTES) != hipSuccess || per_cu < 1) per_cu = 1;
        (void)hipGetLastError();
        grid = cus * 1;
        if (ws_size < WS_END) fprintf(stderr, "kernel_launch: workspace too small (%zu < %zu)\n", ws_size, (size_t)WS_END);
    }
    (void)hipMemsetAsync((char*)d_ws + WS_CTL, 0, CTL_ZERO_BYTES, stream);
    Args a{};
    a.x = (const float*)d_in[0]; a.p = (const float*)d_in[1]; a.pos = (const int*)d_in[2]; a.w_in = (const float*)d_in[3]; a.norm_gain = (const float*)d_in[4];
    a.w_a = (const float*)d_in[5]; a.w_b = (const float*)d_in[6]; a.w_o = (const float*)d_in[7]; a.gn_gain = (const float*)d_in[8]; a.w_ple = (const float*)d_in[9];
    a.w_pg = (const float*)d_in[10]; a.rel_bias = (const float*)d_in[11]; a.final_gain = (const float*)d_in[12];
    a.out = (float*)d_out; a.ws = (unsigned char*)d_ws; a.coop = 1; a.pad = 0;
#ifdef PROBE_SPLIT
    for (int li = 0; li < 2; ++li) { a.ph_lo = li ? PROBE_SPLIT : 0; a.ph_hi = li ? NPHASES : PROBE_SPLIT + 1;
      void* kargs[] = {&a}; hipError_t e = hipLaunchCooperativeKernel((const void*)fwd_kernel, dim3(grid), dim3(NTHREADS), kargs, LDS_BYTES, stream);
      if (e != hipSuccess) fprintf(stderr, "cooperative launch failed: %s (grid %d)\n", hipGetErrorString(e), grid);
      if (li == 0) (void)hipMemsetAsync((char*)d_ws + WS_CTL, 0, CTL_ZERO_BYTES, stream); }
#elif ONE_LAUNCH
    a.ph_lo = 0; a.ph_hi = NPHASES;
    { void* kargs[] = {&a}; hipError_t e = hipLaunchCooperativeKernel((const void*)fwd_kernel, dim3(grid), dim3(NTHREADS), kargs, LDS_BYTES, stream);
      if (e != hipSuccess) fprintf(stderr, "cooperative launch failed: %s (grid %d)\n", hipGetErrorString(e), grid); }
#else
    for (int ph = 0; ph < NPHASES; ++ph) {
        a.ph_lo = ph; a.ph_hi = ph + 1;
        void* kargs[] = {&a}; hipError_t e = hipLaunchCooperativeKernel((const void*)fwd_kernel, dim3(grid), dim3(NTHREADS), kargs, LDS_BYTES, stream);
        if (e != hipSuccess) fprintf(stderr, "cooperative launch %d failed: %s (grid %d)\n", ph, hipGetErrorString(e), grid);
    }
#endif
}
```

```cpp
#include <hip/hip_runtime.h>
#include <hip/hip_cooperative_groups.h>
#include <cstdio>
#include <cstdint>
namespace cg = cooperative_groups;

#define LAS __attribute__((address_space(3)))
typedef unsigned short bf16_t;
typedef short bf16x8 __attribute__((ext_vector_type(8)));
typedef float f32x4 __attribute__((ext_vector_type(4)));
typedef float f32x2 __attribute__((ext_vector_type(2)));
typedef unsigned u32x4 __attribute__((ext_vector_type(4)));
typedef unsigned u32x2 __attribute__((ext_vector_type(2)));

constexpr int DM = 2048, NB = 4, SEQ = 4096, MTOK = NB * SEQ, CHUNK = 64, PLE = 256;
constexpr int NWIN = 13392, NWIN_PAD = 13568;
constexpr float EPS = 1e-6f;

constexpr size_t MiB = 1u << 20;
constexpr size_t WS_CTL = 0;
constexpr size_t WS_WIN = 1 * MiB;
constexpr size_t WS_WA = 54 * MiB;
constexpr size_t WS_WB = 58 * MiB;
constexpr size_t WS_WO = 62 * MiB;
constexpr size_t WS_WPG = 70 * MiB;
constexpr size_t WS_WPLE = 78 * MiB;
constexpr size_t WS_PB = 79 * MiB;
constexpr size_t WS_ROPE = 87 * MiB;
constexpr size_t WS_IK = 95 * MiB;
constexpr size_t WS_IW = 97 * MiB;
constexpr size_t WS_MASK = 98 * MiB;
constexpr size_t WS_AK = 106 * MiB;
constexpr size_t WS_AV = 138 * MiB;
constexpr size_t WS_AZ = 170 * MiB;
constexpr size_t WS_RQ = 202 * MiB;
constexpr size_t WS_RK = 234 * MiB;
constexpr size_t WS_RV = 266 * MiB;
constexpr size_t WS_RZ = 298 * MiB;
constexpr size_t WS_GA = 330 * MiB;
constexpr size_t WS_GB = 394 * MiB;
constexpr size_t WS_BO = 458 * MiB;
constexpr size_t WS_END = 490 * MiB;
constexpr size_t DO_H = 0, DO_KVT = 0, DO_IQ = 64 * MiB, DO_AQ = 96 * MiB, DO_AO = DO_IQ;
constexpr size_t WS_T = WS_AK, WS_MG = WS_RK, WS_RB = WS_GA, WS_U = WS_GB;

typedef __bf16 bf16x2_t __attribute__((ext_vector_type(2)));
__device__ __forceinline__ unsigned cvt_pk_bf16(float lo, float hi) { f32x2 v = {lo, hi}; bf16x2_t b = __builtin_convertvector(v, bf16x2_t); return __builtin_bit_cast(unsigned, b); }
__device__ __forceinline__ unsigned f2bf(float f) { unsigned u = __builtin_bit_cast(unsigned, f); return (u + 0x7fffu + ((u >> 16) & 1u)) >> 16; }
__device__ __forceinline__ unsigned pk2(float lo, float hi) { return f2bf(lo) | (f2bf(hi) << 16); }
__device__ __forceinline__ float bf2f(unsigned short h) { return __builtin_bit_cast(float, (unsigned)h << 16); }
__device__ __forceinline__ float sigmoidf_(float z) { return __builtin_amdgcn_rcpf(1.0f + __builtin_amdgcn_exp2f(-1.4426950408889634f * z)); }
__device__ __forceinline__ float siluf_(float z) { return z * __builtin_amdgcn_rcpf(1.0f + __builtin_amdgcn_exp2f(-1.4426950408889634f * z)); }
__device__ __forceinline__ float wave_sum(float v) {
#pragma unroll
    for (int o = 1; o < 64; o <<= 1) v += __shfl_xor(v, o);
    return v;
}
#define LDS_WAIT() asm volatile("s_waitcnt lgkmcnt(0)" ::: "memory")

namespace pg8 {
constexpr int BM = 256, BK = 64, HALF = 128, HTB = HALF * BK * 2, STAGE_BYTES = 8 * HTB, NXCD = 8, WGM = 8;
__host__ __device__ __forceinline__ int lds_byte(int r, int c) { const int st = (r >> 4) * 2 + (c >> 5), rr = r & 15, cc = c & 31, ob = rr * 64 + cc * 2; return st * 1024 + (ob ^ (((ob >> 9) & 1) << 5)); }
__host__ __device__ __forceinline__ void stage_rc(int b, int& R, int& C) { const int st = b / 1024, sb = b % 1024, swz = sb ^ (((sb >> 9) & 1) << 5); R = (st >> 1) * 16 + swz / 64; C = (st & 1) * 32 + (swz % 64) / 2; }
__host__ __device__ __forceinline__ int perm32(int rho) { const int n = rho >> 4, i = rho & 15; return 8 * (i >> 2) + 4 * n + (i & 3); }
struct Unit { int pm, pn; };
struct Gemm { const bf16_t* A; const bf16_t* Bt; int M, N, K; };
struct StaticOrder {
    int nM, nN, nwg, G, c;
    __host__ __device__ void init(int M, int N, int G_, int c_) { nM = M / BM; nN = N / BM; nwg = nM * nN; G = G_; c = c_; }
    __host__ __device__ bool next(int i, Unit& u) const {
        const long L = (long)i * G + c; if (L >= nwg) return false;
        int wgid = (int)L; { const int q = nwg / NXCD, r = nwg % NXCD, xcd = wgid % NXCD, off = wgid / NXCD; wgid = (xcd < r ? xcd * (q + 1) : r * (q + 1) + (xcd - r) * q) + off; }
        const int nig = WGM * nN, gid = wgid / nig, fm = gid * WGM, gsz = (nM - fm) < WGM ? (nM - fm) : WGM;
        u.pm = fm + ((wgid % nig) % gsz); u.pn = (wgid % nig) / gsz; return true;
    }
    __device__ __forceinline__ void a_ready(const Unit&) const {}
    __device__ __forceinline__ void done(const Unit&) const {}
};

template <class Epi, class Sched, bool ALIGN_EPI = true>
__device__ __forceinline__ void gemm_phase(LAS unsigned char* lds, const Gemm g, const Sched& S, const Epi& E) {
    const int tid = threadIdx.x, wid = __builtin_amdgcn_readfirstlane(tid >> 6), lane = tid & 63, wr = wid >> 2, wc = wid & 3, fr = lane & 15, fq = lane >> 4;
    const int K = g.K, nt = K / BK;
    unsigned voffA[2], voffB[2];
#pragma unroll
    for (int i = 0; i < 2; ++i) { int R, C; stage_rc(tid * 16 + i * 8192, R, C); const int Rb = Epi::PERM ? ((R & ~31) + perm32(R & 31)) : R;
        voffA[i] = (unsigned)(R * K + C) * 2u; voffB[i] = (unsigned)(Rb * K + C) * 2u; }
    const size_t kstep = (size_t)(BK * 2);
    const size_t hstep = (size_t)HALF * K * 2;
    const size_t tstep = 2 * hstep;
    const unsigned ldsw = (unsigned)wid * 1024u;
    const int aoff = lds_byte(wr * 64 + fr, fq * 8), boff = lds_byte(wc * 32 + fr, fq * 8);
#define PG8_SA(b, h) (((b) * 2 + (h)) * HTB)
#define PG8_SB(b, h) ((4 + (b) * 2 + (h)) * HTB)
#define PG8_STAGE(bufoff, gbase, voff) do { _Pragma("unroll") for (int _i = 0; _i < 2; ++_i) \
        __builtin_amdgcn_global_load_lds((const unsigned*)((const char*)(gbase) + (voff)[_i]), (LAS unsigned*)(lds + (bufoff) + ldsw + _i * 8192), 16, 0, 0); } while (0)
#define PG8_LDA(dst, b, h) do { _Pragma("unroll") for (int m = 0; m < 4; ++m) _Pragma("unroll") for (int k = 0; k < 2; ++k) dst[m][k] = *(const LAS bf16x8*)(lds + PG8_SA(b, h) + aoff + m * 2048 + k * 1024); } while (0)
#define PG8_LDB(dst, b, h) do { _Pragma("unroll") for (int n = 0; n < 2; ++n) _Pragma("unroll") for (int k = 0; k < 2; ++k) dst[n][k] = *(const LAS bf16x8*)(lds + PG8_SB(b, h) + boff + n * 2048 + k * 1024); } while (0)
#define PG8_MMA(ai, bj, At, Bt) do { __builtin_amdgcn_s_setprio(1); _Pragma("unroll") for (int m = 0; m < 4; ++m) _Pragma("unroll") for (int n = 0; n < 2; ++n) _Pragma("unroll") for (int k = 0; k < 2; ++k) \
        acc[ai][bj][m][n] = __builtin_amdgcn_mfma_f32_16x16x32_bf16(Bt[n][k], At[m][k], acc[ai][bj][m][n], 0, 0, 0); __builtin_amdgcn_s_setprio(0); } while (0)
#define PG8_WAIT_V(n) asm volatile("s_waitcnt vmcnt(" #n ")" ::: "memory")
#define PG8_WAIT_L(n) asm volatile("s_waitcnt lgkmcnt(" #n ")" ::: "memory")
#define PG8_BAR __builtin_amdgcn_s_barrier()
#define PG8_SCHED __builtin_amdgcn_sched_barrier(0)
    Unit cur, nxt; int ui = 0;
    if (!S.next(0, cur)) return;
    f32x4 acc[2][2][4][2];
#pragma unroll
    for (int a = 0; a < 2; ++a)
#pragma unroll
        for (int b = 0; b < 2; ++b)
#pragma unroll
            for (int m = 0; m < 4; ++m)
#pragma unroll
                for (int n = 0; n < 2; ++n) acc[a][b][m][n] = (f32x4){0.f, 0.f, 0.f, 0.f};
    bf16x8 At[4][2], B0[2][2], B1[2][2];
    const char* cA = (const char*)g.A + (size_t)cur.pm * tstep; const char* cB = (const char*)g.Bt + (size_t)cur.pn * tstep;
    S.a_ready(cur);
    PG8_STAGE(PG8_SB(0, 0), cB, voffB); PG8_STAGE(PG8_SB(0, 1), cB + hstep, voffB); PG8_STAGE(PG8_SA(0, 0), cA, voffA); PG8_STAGE(PG8_SA(0, 1), cA + hstep, voffA);
    if (wr == 1) PG8_BAR;
    PG8_WAIT_V(2); PG8_BAR;
    PG8_STAGE(PG8_SB(1, 0), cB + kstep, voffB); PG8_STAGE(PG8_SA(1, 0), cA + kstep, voffA); PG8_STAGE(PG8_SB(1, 1), cB + hstep + kstep, voffB);
    PG8_WAIT_V(6); PG8_BAR;
    for (;;) {
        const bool has_next = S.next(ui + 1, nxt);
        const char* nA = has_next ? (const char*)g.A + (size_t)nxt.pm * tstep : cA; const char* nB = has_next ? (const char*)g.Bt + (size_t)nxt.pn * tstep : cB;
#pragma unroll 1
        for (int t = 0; t < nt; t += 2) {
            const bool last = (t == nt - 2);
            const char* a1 = cA + (size_t)(t + 1) * kstep;
            const char* a2 = last ? nA : cA + (size_t)(t + 2) * kstep; const char* b2 = last ? nB : cB + (size_t)(t + 2) * kstep;
            const char* a3 = a2 + kstep; const char* b3 = b2 + kstep;
            if (last && has_next) S.a_ready(nxt);
            PG8_LDB(B0, 0, 0); PG8_LDB(B1, 0, 1); PG8_SCHED; PG8_LDA(At, 0, 0); PG8_STAGE(PG8_SA(1, 1), a1 + hstep, voffA);
            PG8_WAIT_V(8); PG8_WAIT_L(0); PG8_BAR; PG8_MMA(0, 0, At, B0); PG8_MMA(0, 1, At, B1); PG8_BAR; PG8_SCHED;
            PG8_LDA(At, 0, 1); PG8_STAGE(PG8_SB(0, 0), b2, voffB); PG8_STAGE(PG8_SB(0, 1), b2 + hstep, voffB); PG8_STAGE(PG8_SA(0, 0), a2, voffA);
            PG8_WAIT_V(8); PG8_WAIT_L(0); PG8_BAR; PG8_MMA(1, 0, At, B0); PG8_MMA(1, 1, At, B1); PG8_BAR; PG8_SCHED;
            PG8_LDB(B0, 1, 0); PG8_LDB(B1, 1, 1); PG8_SCHED; PG8_LDA(At, 1, 0); PG8_STAGE(PG8_SA(0, 1), a2 + hstep, voffA);
            PG8_WAIT_V(8); PG8_WAIT_L(0); PG8_BAR; PG8_MMA(0, 0, At, B0); PG8_MMA(0, 1, At, B1); PG8_BAR; PG8_SCHED;
            PG8_LDA(At, 1, 1); PG8_STAGE(PG8_SB(1, 0), b3, voffB); PG8_STAGE(PG8_SB(1, 1), b3 + hstep, voffB); PG8_STAGE(PG8_SA(1, 0), a3, voffA);
            PG8_WAIT_V(8); PG8_WAIT_L(0); PG8_BAR; PG8_MMA(1, 0, At, B0); PG8_MMA(1, 1, At, B1); PG8_BAR; PG8_SCHED;
        }
        if constexpr (ALIGN_EPI) { if (wr == 0) PG8_BAR; }
        E(acc, cur, wr, wc, fr, fq);
        if (!has_next) break;
#pragma unroll
        for (int a = 0; a < 2; ++a)
#pragma unroll
            for (int b = 0; b < 2; ++b)
#pragma unroll
                for (int m = 0; m < 4; ++m)
#pragma unroll
                    for (int n = 0; n < 2; ++n) acc[a][b][m][n] = (f32x4){0.f, 0.f, 0.f, 0.f};
        cur = nxt; cA = nA; cB = nB; ++ui;
        if constexpr (ALIGN_EPI) { if (wr == 1) PG8_BAR; }
    }
    PG8_WAIT_V(0);
    if constexpr (!ALIGN_EPI) { if (wr == 0) PG8_BAR; }
    PG8_BAR;
#undef PG8_SA
#undef PG8_SB
#undef PG8_STAGE
#undef PG8_LDA
#undef PG8_LDB
#undef PG8_MMA
#undef PG8_WAIT_V
#undef PG8_WAIT_L
#undef PG8_BAR
#undef PG8_SCHED
}
}

typedef f32x4 AccT[2][2][4][2];
template <class Fn> __device__ __forceinline__ void epi_foreach(const AccT& acc, const pg8::Unit& u, int wr, int wc, int fr, int fq, Fn&& f) {
    asm volatile("" : "+v"(fr), "+v"(fq));
#pragma unroll
    for (int ai = 0; ai < 2; ++ai)
#pragma unroll
        for (int m = 0; m < 4; ++m)
#pragma unroll
            for (int bj = 0; bj < 2; ++bj) {
                f(u.pm * 256 + ai * 128 + wr * 64 + m * 16 + fr, u.pn * 256 + bj * 128 + wc * 32 + 8 * fq, acc[ai][bj][m][0], acc[ai][bj][m][1]);
                asm volatile("" ::: "memory"); }
}

template <int ldc> struct EpiPlainBf16 {
    static constexpr bool PERM = true;
    bf16_t* O;
    __device__ __forceinline__ void operator()(const AccT& acc, const pg8::Unit& u, int wr, int wc, int fr, int fq) const {
        epi_foreach(acc, u, wr, wc, fr, fq, [&](int row, int col, f32x4 v0, f32x4 v1) {
            u32x4 w; w.x = cvt_pk_bf16(v0[0], v0[1]); w.y = cvt_pk_bf16(v0[2], v0[3]); w.z = cvt_pk_bf16(v1[0], v1[1]); w.w = cvt_pk_bf16(v1[2], v1[3]);
            *(u32x4*)(O + (size_t)row * ldc + col) = w; });
    }
};
struct EpiGate {
    static constexpr bool PERM = true;
    const float* R; const bf16_t* U; float* O;
    __device__ __forceinline__ void operator()(const AccT& acc, const pg8::Unit& u, int wr, int wc, int fr, int fq) const {
        epi_foreach(acc, u, wr, wc, fr, fq, [&](int row, int col, f32x4 v0, f32x4 v1) {
            const size_t off = (size_t)row * DM + col;
            const f32x4 r0 = *(const f32x4*)(R + off), r1 = *(const f32x4*)(R + off + 4);
            const u32x4 uu = *(const u32x4*)(U + off);
            f32x4 o0, o1;
            o0[0] = r0[0] + bf2f((unsigned short)(uu.x & 0xffff)) * sigmoidf_(v0[0]); o0[1] = r0[1] + bf2f((unsigned short)(uu.x >> 16)) * sigmoidf_(v0[1]);
            o0[2] = r0[2] + bf2f((unsigned short)(uu.y & 0xffff)) * sigmoidf_(v0[2]); o0[3] = r0[3] + bf2f((unsigned short)(uu.y >> 16)) * sigmoidf_(v0[3]);
            o1[0] = r1[0] + bf2f((unsigned short)(uu.z & 0xffff)) * sigmoidf_(v1[0]); o1[1] = r1[1] + bf2f((unsigned short)(uu.z >> 16)) * sigmoidf_(v1[1]);
            o1[2] = r1[2] + bf2f((unsigned short)(uu.w & 0xffff)) * sigmoidf_(v1[2]); o1[3] = r1[3] + bf2f((unsigned short)(uu.w >> 16)) * sigmoidf_(v1[3]);
            *(f32x4*)(O + off) = o0; *(f32x4*)(O + off + 4) = o1; });
    }
};

template <bool HAS_T> struct EpiMerge {
    static constexpr bool PERM = true;
    const bf16_t* T; const bf16_t* Gt; bf16_t* O;
    __device__ __forceinline__ void operator()(const AccT& acc, const pg8::Unit& u, int wr, int wc, int fr, int fq) const {
        epi_foreach(acc, u, wr, wc, fr, fq, [&](int row, int col, f32x4 v0, f32x4 v1) {
            const size_t off = (size_t)row * DM + col;
            const u32x4 gg = *(const u32x4*)(Gt + off);
            float o[8];
            o[0] = bf2f((unsigned short)(gg.x & 0xffff)) * v0[0]; o[1] = bf2f((unsigned short)(gg.x >> 16)) * v0[1];
            o[2] = bf2f((unsigned short)(gg.y & 0xffff)) * v0[2]; o[3] = bf2f((unsigned short)(gg.y >> 16)) * v0[3];
            o[4] = bf2f((unsigned short)(gg.z & 0xffff)) * v1[0]; o[5] = bf2f((unsigned short)(gg.z >> 16)) * v1[1];
            o[6] = bf2f((unsigned short)(gg.w & 0xffff)) * v1[2]; o[7] = bf2f((unsigned short)(gg.w >> 16)) * v1[3];
            if constexpr (HAS_T) { const u32x4 tt = *(const u32x4*)(T + off);
                o[0] += bf2f((unsigned short)(tt.x & 0xffff)); o[1] += bf2f((unsigned short)(tt.x >> 16)); o[2] += bf2f((unsigned short)(tt.y & 0xffff)); o[3] += bf2f((unsigned short)(tt.y >> 16));
                o[4] += bf2f((unsigned short)(tt.z & 0xffff)); o[5] += bf2f((unsigned short)(tt.z >> 16)); o[6] += bf2f((unsigned short)(tt.w & 0xffff)); o[7] += bf2f((unsigned short)(tt.w >> 16)); }
            u32x4 w; w.x = cvt_pk_bf16(o[0], o[1]); w.y = cvt_pk_bf16(o[2], o[3]); w.z = cvt_pk_bf16(o[4], o[5]); w.w = cvt_pk_bf16(o[6], o[7]);
            *(u32x4*)(O + off) = w; });
    }
};
struct EpiResid {
    static constexpr bool PERM = true;
    const float* X; float* O32; bf16_t* O16;
    __device__ __forceinline__ void operator()(const AccT& acc, const pg8::Unit& u, int wr, int wc, int fr, int fq) const {
        epi_foreach(acc, u, wr, wc, fr, fq, [&](int row, int col, f32x4 v0, f32x4 v1) {
            const size_t off = (size_t)row * DM + col;
            const f32x4 r0 = *(const f32x4*)(X + off) + v0, r1 = *(const f32x4*)(X + off + 4) + v1;
            *(f32x4*)(O32 + off) = r0; *(f32x4*)(O32 + off + 4) = r1;
            u32x4 w; w.x = cvt_pk_bf16(r0[0], r0[1]); w.y = cvt_pk_bf16(r0[2], r0[3]); w.z = cvt_pk_bf16(r1[0], r1[1]); w.w = cvt_pk_bf16(r1[2], r1[3]);
            *(u32x4*)(O16 + off) = w; });
    }
};
__device__ __forceinline__ size_t hm_off(int row, int hh, int d) { return ((size_t)(row & ~4095) * 8 + (size_t)hh * 4096 + (size_t)(row & 4095)) * 128 + d; }
__device__ __forceinline__ u32x4 pack8f(const float* o) { u32x4 w; w.x = cvt_pk_bf16(o[0], o[1]); w.y = cvt_pk_bf16(o[2], o[3]); w.z = cvt_pk_bf16(o[4], o[5]); w.w = cvt_pk_bf16(o[6], o[7]); return w; }
struct EpiProj {
    static constexpr bool PERM = true;
    unsigned char* ws; unsigned char* dout;
    __device__ __forceinline__ void operator()(const AccT& acc, const pg8::Unit& u, int wr, int wc, int fr, int fq) const {
        const int pn = u.pn;
        if (pn < 12 || (pn >= 29 && pn < 33)) {
            bf16_t* base; int tl;
            if (pn < 4) { base = (bf16_t*)(dout + DO_AQ); tl = pn; } else if (pn < 8) { base = (bf16_t*)(ws + WS_AK); tl = pn - 4; }
            else if (pn < 12) { base = (bf16_t*)(ws + WS_AV); tl = pn - 8; } else { base = (bf16_t*)(ws + WS_RV); tl = pn - 29; }
            epi_foreach(acc, u, wr, wc, fr, fq, [&](int row, int col, f32x4 v0, f32x4 v1) {
                const int colt = col & 255; const float o[8] = {v0[0], v0[1], v0[2], v0[3], v1[0], v1[1], v1[2], v1[3]};
                *(u32x4*)(base + hm_off(row, 2 * tl + (colt >> 7), colt & 127)) = pack8f(o); });
        } else if (pn == 20) {
            asm volatile("" : "+v"(fr), "+v"(fq));
            if (wc == 0) {
                bf16_t* IK = (bf16_t*)(ws + WS_IK);
#pragma unroll
                for (int ai = 0; ai < 2; ++ai)
#pragma unroll
                    for (int m = 0; m < 4; ++m) {
                        const int row = u.pm * 256 + ai * 128 + wr * 64 + m * 16 + fr;
                        float x[16];
#pragma unroll
                        for (int j = 0; j < 4; ++j) { x[j] = acc[ai][0][m][0][j]; x[4 + j] = acc[ai][0][m][1][j]; x[8 + j] = acc[ai][1][m][0][j]; x[12 + j] = acc[ai][1][m][1][j]; }
                        float sum = 0.f;
#pragma unroll
                        for (int j = 0; j < 16; ++j) sum += x[j];
                        sum += __shfl_xor(sum, 16); sum += __shfl_xor(sum, 32);
                        const float mu = sum * (1.0f / 64.0f); float q = 0.f;
#pragma unroll
                        for (int j = 0; j < 16; ++j) { x[j] -= mu; q += x[j] * x[j]; }
                        q += __shfl_xor(q, 16); q += __shfl_xor(q, 32);
                        const float rs = 1.0f / sqrtf(q * (1.0f / 64.0f) + EPS);
#pragma unroll
                        for (int j = 0; j < 16; ++j) x[j] *= rs;
                        *(u32x4*)(IK + (size_t)row * 64 + 8 * fq) = pack8f(x); *(u32x4*)(IK + (size_t)row * 64 + 32 + 8 * fq) = pack8f(x + 8);
                        asm volatile("" ::: "memory");
                    }
            } else if (wc == 1) {
                float* IW = (float*)(ws + WS_IW);
                if (fq < 2) {
#pragma unroll
                    for (int ai = 0; ai < 2; ++ai)
#pragma unroll
                        for (int m = 0; m < 4; ++m) {
                            const int row = u.pm * 256 + ai * 128 + wr * 64 + m * 16 + fr;
                            *(f32x4*)(IW + (size_t)row * 16 + 8 * fq) = acc[ai][0][m][0] * 0.25f; *(f32x4*)(IW + (size_t)row * 16 + 8 * fq + 4) = acc[ai][0][m][1] * 0.25f;
                        }
                }
            }
        } else if (pn >= 21 && pn < 29) {
            asm volatile("" : "+v"(fr), "+v"(fq));
            const bool isk = pn >= 25; const int tl = isk ? pn - 25 : pn - 21; const float sc = isk ? 0.08838834764831845f : 1.0f;
            bf16_t* base = (bf16_t*)(ws + (isk ? WS_RK : WS_RQ)); const f32x4* rope = (const f32x4*)(ws + WS_ROPE);
            const int hh = 2 * tl + (wc >> 1), d0 = 32 * (wc & 1) + 8 * fq;
#pragma unroll
            for (int ai = 0; ai < 2; ++ai)
#pragma unroll
                for (int m = 0; m < 4; ++m) {
                    const int row = u.pm * 256 + ai * 128 + wr * 64 + m * 16 + fr;
                    const f32x4* rp = rope + ((size_t)row * 64 + d0) / 2;
                    float x1[8], x2[8], y1[8], y2[8];
#pragma unroll
                    for (int j = 0; j < 4; ++j) { x1[j] = acc[ai][0][m][0][j]; x1[4 + j] = acc[ai][0][m][1][j]; x2[j] = acc[ai][1][m][0][j]; x2[4 + j] = acc[ai][1][m][1][j]; }
#pragma unroll
                    for (int jj = 0; jj < 4; ++jj) { const f32x4 cs = rp[jj];
                        y1[2 * jj] = (x1[2 * jj] * cs[0] - x2[2 * jj] * cs[1]) * sc; y2[2 * jj] = (x1[2 * jj] * cs[1] + x2[2 * jj] * cs[0]) * sc;
                        y1[2 * jj + 1] = (x1[2 * jj + 1] * cs[2] - x2[2 * jj + 1] * cs[3]) * sc; y2[2 * jj + 1] = (x1[2 * jj + 1] * cs[3] + x2[2 * jj + 1] * cs[2]) * sc; }
                    const size_t o = hm_off(row, hh, d0);
                    *(u32x4*)(base + o) = pack8f(y1); *(u32x4*)(base + o + 64) = pack8f(y2);
                    asm volatile("" ::: "memory");
                }
        } else {
            bf16_t* base; int ld, c0, act;
            if (pn < 16) { base = (bf16_t*)(ws + WS_AZ); ld = 1024; c0 = (pn - 12) * 256; act = 0; }
            else if (pn < 20) { base = (bf16_t*)(dout + DO_IQ); ld = 1024; c0 = (pn - 16) * 256; act = 1; }
            else if (pn < 37) { base = (bf16_t*)(ws + WS_RZ); ld = 1024; c0 = (pn - 33) * 256; act = 0; }
            else if (pn < 45) { base = (bf16_t*)(ws + WS_GA); ld = 2048; c0 = (pn - 37) * 256; act = 2; }
            else { base = (bf16_t*)(ws + WS_GB); ld = 2048; c0 = (pn - 45) * 256; act = 2; }
            epi_foreach(acc, u, wr, wc, fr, fq, [&](int row, int col, f32x4 v0, f32x4 v1) {
                float o[8] = {v0[0], v0[1], v0[2], v0[3], v1[0], v1[1], v1[2], v1[3]};
#pragma unroll
                for (int j = 0; j < 8; ++j) o[j] = act == 0 ? siluf_(o[j]) : (act == 1 ? o[j] * 0.125f : sigmoidf_(o[j]));
                *(u32x4*)(base + (size_t)row * ld + c0 + (col & 255)) = pack8f(o); });
        }
    }
};

constexpr int NWAVES = 8, NTHREADS = 512;
constexpr int LDS_BYTES = 147456;
struct Args {
    const float* x; const float* p; const int* pos; const float* w_in; const float* norm_gain; const float* w_a; const float* w_b; const float* w_o;
    const float* gn_gain; const float* w_ple; const float* w_pg; const float* rel_bias; const float* final_gain;
    float* out; unsigned char* ws; int ph_lo, ph_hi; int coop, pad;
};
struct Frame { LAS unsigned char* lds; int tid, lane, wave, G, vcu; };
__device__ __forceinline__ void frame_ids(Frame& F) { int t = threadIdx.x; asm volatile("" : "+v"(t)); F.tid = t; F.lane = t & 63; F.wave = __builtin_amdgcn_readfirstlane(t >> 6); }

__device__ __forceinline__ void transpose_item64(const float* W, int K, int N, int src_c0, int cnt, bf16_t* WT, int dst_r0, int k0, int lane) {
    const bool ok = src_c0 >= 0 && lane < cnt;
    const float* src = W + (size_t)k0 * N + (ok ? src_c0 + lane : 0);
    bf16_t* dst = WT + (size_t)(dst_r0 + lane) * K + k0;
#pragma unroll
    for (int h = 0; h < 2; ++h) {
        float x[32];
#pragma unroll
        for (int kk = 0; kk < 32; ++kk) x[kk] = ok ? src[(size_t)(32 * h + kk) * N] : 0.f;
#pragma unroll
        for (int c8 = 0; c8 < 4; ++c8) { u32x4 o; o.x = pk2(x[8 * c8], x[8 * c8 + 1]); o.y = pk2(x[8 * c8 + 2], x[8 * c8 + 3]); o.z = pk2(x[8 * c8 + 4], x[8 * c8 + 5]); o.w = pk2(x[8 * c8 + 6], x[8 * c8 + 7]);
            *(u32x4*)(dst + 32 * h + 8 * c8) = o; }
    }
}
__device__ __forceinline__ int win_src(int blk, int& cnt) {
    const int tile = blk >> 3, sb = blk & 7; cnt = 32;
    if (tile < 20) return tile * 256 + 32 * sb;
    if (tile == 20) { if (sb == 0) return 5120; if (sb == 4) return 5152; if (sb == 1) { cnt = 16; return 5184; } return -1; }
    if (tile < 29) { const int rk = tile >= 25, tl = rk ? tile - 25 : tile - 21, bj = sb >> 2, wc = sb & 3;
        return (rk ? 6224 : 5200) + (2 * tl + (wc >> 1)) * 128 + bj * 64 + 32 * (wc & 1); }
    if (tile < 37) return 7248 + (tile - 29) * 256 + 32 * sb;
    return 9296 + (tile - 37) * 256 + 32 * sb;
}
__device__ __forceinline__ void p0_prologue(const Args& a, Frame& F) {
    const int gw = F.vcu * NWAVES + F.wave, NGW = F.G * NWAVES;
    unsigned char* ws = a.ws;
    constexpr int KB_IN = DM / 64;
    constexpr int I_IN = KB_IN * (NWIN_PAD / 64);
    constexpr int I_A = (1024 / 64) * (DM / 64);
    constexpr int I_O = (DM / 64) * (DM / 64);
    constexpr int I_PLE = (PLE / 64) * (DM / 64);
    constexpr int NITEMS = I_IN + 2 * I_A + 2 * I_O + I_PLE;
    for (int it = gw; it < NITEMS; it += NGW) {
        int r = it;
        if (r < I_IN) { const int blk64 = r / KB_IN, kb = r % KB_IN; int cnt; const int src = win_src(blk64 * 2 + (F.lane >> 5), cnt);
            const int l5 = F.lane & 31; const bool ok = src >= 0 && l5 < cnt;
            const float* sp = a.w_in + (size_t)(kb * 64) * NWIN + (ok ? src + l5 : 0);
            bf16_t* dp = (bf16_t*)(ws + WS_WIN) + (size_t)(blk64 * 64 + F.lane) * DM + kb * 64;
#pragma unroll
            for (int h = 0; h < 2; ++h) { float x[32];
#pragma unroll
                for (int kk = 0; kk < 32; ++kk) x[kk] = ok ? sp[(size_t)(32 * h + kk) * NWIN] : 0.f;
#pragma unroll
                for (int c8 = 0; c8 < 4; ++c8) { u32x4 o; o.x = pk2(x[8 * c8], x[8 * c8 + 1]); o.y = pk2(x[8 * c8 + 2], x[8 * c8 + 3]); o.z = pk2(x[8 * c8 + 4], x[8 * c8 + 5]); o.w = pk2(x[8 * c8 + 6], x[8 * c8 + 7]);
                    *(u32x4*)(dp + 32 * h + 8 * c8) = o; } }
            continue; } r -= I_IN;
        if (r < I_A) { const int blk = r / 16, kb = r % 16; transpose_item64(a.w_a, 1024, DM, blk * 64, 64, (bf16_t*)(ws + WS_WA), blk * 64, kb * 64, F.lane); continue; } r -= I_A;
        if (r < I_A) { const int blk = r / 16, kb = r % 16; transpose_item64(a.w_b, 1024, DM, blk * 64, 64, (bf16_t*)(ws + WS_WB), blk * 64, kb * 64, F.lane); continue; } r -= I_A;
        if (r < I_O) { const int blk = r / 32, kb = r % 32; transpose_item64(a.w_o, DM, DM, blk * 64, 64, (bf16_t*)(ws + WS_WO), blk * 64, kb * 64, F.lane); continue; } r -= I_O;
        if (r < I_O) { const int blk = r / 32, kb = r % 32; transpose_item64(a.w_pg, DM, DM, blk * 64, 64, (bf16_t*)(ws + WS_WPG), blk * 64, kb * 64, F.lane); continue; } r -= I_O;
        { const int blk = r / 4, kb = r % 4; transpose_item64(a.w_ple, PLE, DM, blk * 64, 64, (bf16_t*)(ws + WS_WPLE), blk * 64, kb * 64, F.lane); }
    }
    bf16_t* H = (bf16_t*)((unsigned char*)a.out + DO_H); bf16_t* PB = (bf16_t*)(ws + WS_PB);
    for (int m = gw; m < MTOK; m += NGW) {
        const f32x4* xr = (const f32x4*)(a.x + (size_t)m * DM) + F.lane; const f32x4* gr = (const f32x4*)a.norm_gain + F.lane;
        f32x4 v[8]; float s = 0.f;
#pragma unroll
        for (int j = 0; j < 8; ++j) v[j] = xr[64 * j];
        const f32x4 pv = *((const f32x4*)(a.p + (size_t)m * PLE) + F.lane);
#pragma unroll
        for (int j = 0; j < 8; ++j) s += (v[j][0] * v[j][0] + v[j][1] * v[j][1]) + (v[j][2] * v[j][2] + v[j][3] * v[j][3]);
        const float rstd = 1.0f / sqrtf(wave_sum(s) * (1.0f / DM) + EPS);
        u32x2* o8 = (u32x2*)(H + (size_t)m * DM) + F.lane;
#pragma unroll
        for (int j = 0; j < 8; ++j) { const f32x4 g = gr[64 * j]; u32x2 w; w.x = pk2(v[j][0] * rstd * g[0], v[j][1] * rstd * g[1]); w.y = pk2(v[j][2] * rstd * g[2], v[j][3] * rstd * g[3]); o8[64 * j] = w; }
        u32x2 w; w.x = pk2(pv[0], pv[1]); w.y = pk2(pv[2], pv[3]); *((u32x2*)(PB + (size_t)m * PLE) + F.lane) = w;
    }
    f32x2* rope = (f32x2*)(ws + WS_ROPE);
    for (int e = (F.vcu * NTHREADS + F.tid); e < MTOK * 64; e += F.G * NTHREADS) {
        const int m = e >> 6, i = e & 63;
        const float invf = exp2f(-(float)i * (1.0f / 64.0f) * 13.287712379549449f);
        const float ang = (float)a.pos[m] * invf;
        float sn, cs; sincosf(ang, &sn, &cs);
        rope[e] = (f32x2){cs, sn};
    }
}
__device__ __forceinline__ void p_final_norm(const Args& a, Frame& F) {
    const int gw = F.vcu * NWAVES + F.wave, NGW = F.G * NWAVES;
    for (int m = gw; m < MTOK; m += NGW) {
        f32x4* xr = (f32x4*)(a.out + (size_t)m * DM) + F.lane; const f32x4* gr = (const f32x4*)a.final_gain + F.lane;
        f32x4 v[8]; float s = 0.f;
#pragma unroll
        for (int j = 0; j < 8; ++j) { v[j] = xr[64 * j]; s += (v[j][0] * v[j][0] + v[j][1] * v[j][1]) + (v[j][2] * v[j][2] + v[j][3] * v[j][3]); }
        const float rstd = 1.0f / sqrtf(wave_sum(s) * (1.0f / DM) + EPS);
#pragma unroll
        for (int j = 0; j < 8; ++j) { const f32x4 g = gr[64 * j]; xr[64 * j] = (f32x4){v[j][0] * rstd * g[0], v[j][1] * rstd * g[1], v[j][2] * rstd * g[2], v[j][3] * rstd * g[3]}; }
    }
}

namespace att {
typedef short s16x4 __attribute__((ext_vector_type(4)));
typedef float f32x16 __attribute__((ext_vector_type(16)));
#define KSWZ(row, colB) ((row) * 256 + ((colB) ^ (((row) & 7) << 4)))
#define SBAR() __builtin_amdgcn_sched_barrier(0)
__device__ __forceinline__ int v_st(int k, int c) { const int kk = (k & ~0xC) | ((k & 4) << 1) | ((k & 8) >> 1); return ((kk >> 3) * 4 + (c >> 5)) * 512 + ((kk & 7) * 32 + (c & 31)) * 2; }
__device__ __forceinline__ int v_rd_base(int lane) { return ((lane & 3) << 3) | (((lane >> 2) & 3) << 6) | (((lane >> 4) & 1) << 5) | (((lane >> 5) & 1) << 8); }
constexpr int v_rd_off(int d0, int ks, int half) { return d0 * 512 + ks * 4096 + half * 2048; }
__device__ __forceinline__ int crow(int r, int hi) { return (r & 3) + 8 * (r >> 2) + 4 * hi; }
#define TRRD(dst, vb, off) asm volatile("ds_read_b64_tr_b16 %0, %1 offset:%2" : "=&v"(dst) : "v"(vb), "i"(off) : "memory")
#define TRRDV(dst, addr) asm volatile("ds_read_b64_tr_b16 %0, %1" : "=&v"(dst) : "v"(addr) : "memory")
__device__ __forceinline__ void qkt(f32x16& p0, f32x16& p1, const LAS unsigned char* Kb, int r32, int hi, const bf16x8* qr) {
    p0 = f32x16{}; p1 = f32x16{};
    const LAS unsigned char* kb[4];
#pragma unroll
    for (int dd = 0; dd < 4; ++dd) kb[dd] = Kb + KSWZ(r32, (dd * 16 + hi * 8) * 2);
#pragma unroll
    for (int d0 = 0; d0 < 8; ++d0) { const LAS unsigned char* a = kb[d0 & 3] + (d0 >> 2) * 128;
        const bf16x8 b0 = *(const LAS bf16x8*)a; const bf16x8 b1 = *(const LAS bf16x8*)(a + 32 * 256);
        p0 = __builtin_amdgcn_mfma_f32_32x32x16_bf16(b0, qr[d0], p0, 0, 0, 0);
        p1 = __builtin_amdgcn_mfma_f32_32x32x16_bf16(b1, qr[d0], p1, 0, 0, 0); }
}
template <int VOFF>
__device__ __forceinline__ void pv_tile(f32x16* o, int vb, bf16x8 pa0, bf16x8 pa1, bf16x8 pa2, bf16x8 pa3) {
#define PV_D0(d0) do { s16x4 l0, l1, l2, l3, h0, h1, h2, h3; constexpr int b_ = VOFF + v_rd_off(d0, 0, 0); \
        TRRD(l0, vb, b_); TRRD(h0, vb, b_ + 2048); TRRD(l1, vb, b_ + 4096); TRRD(h1, vb, b_ + 6144); TRRD(l2, vb, b_ + 8192); TRRD(h2, vb, b_ + 10240); TRRD(l3, vb, b_ + 12288); TRRD(h3, vb, b_ + 14336); \
        asm volatile("s_waitcnt lgkmcnt(0)" ::: "memory"); SBAR(); \
        o[d0] = __builtin_amdgcn_mfma_f32_32x32x16_bf16(pa0, (bf16x8){l0[0], l0[1], l0[2], l0[3], h0[0], h0[1], h0[2], h0[3]}, o[d0], 0, 0, 0); \
        o[d0] = __builtin_amdgcn_mfma_f32_32x32x16_bf16(pa1, (bf16x8){l1[0], l1[1], l1[2], l1[3], h1[0], h1[1], h1[2], h1[3]}, o[d0], 0, 0, 0); \
        o[d0] = __builtin_amdgcn_mfma_f32_32x32x16_bf16(pa2, (bf16x8){l2[0], l2[1], l2[2], l2[3], h2[0], h2[1], h2[2], h2[3]}, o[d0], 0, 0, 0); \
        o[d0] = __builtin_amdgcn_mfma_f32_32x32x16_bf16(pa3, (bf16x8){l3[0], l3[1], l3[2], l3[3], h3[0], h3[1], h3[2], h3[3]}, o[d0], 0, 0, 0); } while (0)
    PV_D0(0); PV_D0(1); PV_D0(2); PV_D0(3);
#undef PV_D0
}
__device__ __forceinline__ void pack_p(const f32x16& p0, const f32x16& p1, bf16x8& pa0, bf16x8& pa1, bf16x8& pa2, bf16x8& pa3) {
#define PK4(P, B_, OUT) do { const unsigned a0 = cvt_pk_bf16(P[B_+0], P[B_+1]), a1 = cvt_pk_bf16(P[B_+2], P[B_+3]); \
        const unsigned b0 = cvt_pk_bf16(P[B_+4], P[B_+5]), b1 = cvt_pk_bf16(P[B_+6], P[B_+7]); \
        auto r0 = __builtin_amdgcn_permlane32_swap(a0, b0, false, false); auto r1 = __builtin_amdgcn_permlane32_swap(a1, b1, false, false); \
        u32x4 w = {r0[0], r1[0], r0[1], r1[1]}; OUT = __builtin_bit_cast(bf16x8, w); } while (0)
    PK4(p0, 0, pa0); PK4(p0, 8, pa1); PK4(p1, 0, pa2); PK4(p1, 8, pa3);
#undef PK4
}
}

__device__ __forceinline__ float ret_log2g(int h) { return log2f(1.0f - exp2f(-5.0f - (float)h)); }
__device__ __forceinline__ void p_ret_kv(const Args& a, Frame& F) {
    using namespace att;
    const bf16_t* RK = (const bf16_t*)(a.ws + WS_RK); const bf16_t* RV = (const bf16_t*)(a.ws + WS_RV); bf16_t* KVT = (bf16_t*)((unsigned char*)a.out + DO_KVT);
    LAS unsigned char* Kl = F.lds; LAS unsigned char* Vl = F.lds + 16384;
    const int tid = F.tid, lane = F.lane, wid = F.wave, r32 = lane & 31, hi = lane >> 5;
    const int sr = tid >> 4, sc = (tid & 15) * 8;
    const int a0 = wid >> 1, dp = (wid & 1) * 2;
    const int vbK = (int)(uintptr_t)Kl + v_rd_base(lane), vbV = (int)(uintptr_t)Vl + v_rd_base(lane);
    for (int item = F.vcu; item < NB * 8 * 64; item += F.G) {
        const int bh = item >> 6, n = item & 63, h = bh & 7;
        const float lg = ret_log2g(h);
        const size_t rowbase = ((size_t)bh * SEQ + (size_t)n * 64) * 128;
#pragma unroll
        for (int i = 0; i < 2; ++i) { const int t = sr + 32 * i;
            const u32x4 kq = *(const u32x4*)(RK + rowbase + (size_t)t * 128 + sc); const u32x4 vq = *(const u32x4*)(RV + rowbase + (size_t)t * 128 + sc);
            const float w = exp2f((float)(63 - t) * lg);
            float kf[8]; kf[0] = bf2f((unsigned short)(kq.x & 0xffff)) * w; kf[1] = bf2f((unsigned short)(kq.x >> 16)) * w; kf[2] = bf2f((unsigned short)(kq.y & 0xffff)) * w; kf[3] = bf2f((unsigned short)(kq.y >> 16)) * w;
            kf[4] = bf2f((unsigned short)(kq.z & 0xffff)) * w; kf[5] = bf2f((unsigned short)(kq.z >> 16)) * w; kf[6] = bf2f((unsigned short)(kq.w & 0xffff)) * w; kf[7] = bf2f((unsigned short)(kq.w >> 16)) * w;
            *(LAS u32x4*)(Kl + v_st(t, sc)) = pack8f(kf); *(LAS u32x4*)(Vl + v_st(t, sc)) = vq; }
        __syncthreads();
        f32x16 acc[2] = {};
#pragma unroll
        for (int ks = 0; ks < 4; ++ks) {
            s16x4 al, ah, b0l, b0h, b1l, b1h;
            TRRDV(al, vbK + v_rd_off(a0, ks, 0)); TRRDV(ah, vbK + v_rd_off(a0, ks, 1));
            TRRDV(b0l, vbV + v_rd_off(dp, ks, 0)); TRRDV(b0h, vbV + v_rd_off(dp, ks, 1));
            TRRDV(b1l, vbV + v_rd_off(dp + 1, ks, 0)); TRRDV(b1h, vbV + v_rd_off(dp + 1, ks, 1));
            asm volatile("s_waitcnt lgkmcnt(0)" ::: "memory"); SBAR();
            const bf16x8 af = (bf16x8){al[0], al[1], al[2], al[3], ah[0], ah[1], ah[2], ah[3]};
            acc[0] = __builtin_amdgcn_mfma_f32_32x32x16_bf16(af, (bf16x8){b0l[0], b0l[1], b0l[2], b0l[3], b0h[0], b0h[1], b0h[2], b0h[3]}, acc[0], 0, 0, 0);
            acc[1] = __builtin_amdgcn_mfma_f32_32x32x16_bf16(af, (bf16x8){b1l[0], b1l[1], b1l[2], b1l[3], b1h[0], b1h[1], b1h[2], b1h[3]}, acc[1], 0, 0, 0);
        }
        bf16_t* dst = KVT + (size_t)item * 16384;
#pragma unroll
        for (int e = 0; e < 2; ++e)
#pragma unroll
            for (int g = 0; g < 4; ++g) { u32x2 w; w.x = cvt_pk_bf16(acc[e][4 * g], acc[e][4 * g + 1]); w.y = cvt_pk_bf16(acc[e][4 * g + 2], acc[e][4 * g + 3]);
                *(u32x2*)(dst + (size_t)(32 * (dp + e) + r32) * 128 + 32 * a0 + 8 * g + 4 * hi) = w; }
        __syncthreads();
    }
}
__device__ __forceinline__ void p_ret_scan(const Args& a, Frame& F) {
    bf16_t* KVT = (bf16_t*)((unsigned char*)a.out + DO_KVT);
    for (int idx = F.vcu * NTHREADS + F.tid; idx < 32 * 2048; idx += F.G * NTHREADS) {
        const int bh = idx >> 11, e8 = idx & 2047, h = bh & 7;
        const float dec = exp2f(64.0f * ret_log2g(h));
        float st[8] = {0.f, 0.f, 0.f, 0.f, 0.f, 0.f, 0.f, 0.f};
        u32x4* p = (u32x4*)(KVT + (size_t)bh * 64 * 16384 + (size_t)e8 * 8);
#pragma unroll 4
        for (int n = 0; n < 64; ++n) {
            const u32x4 kv = p[(size_t)n * 2048];
            p[(size_t)n * 2048] = pack8f(st);
            st[0] = st[0] * dec + bf2f((unsigned short)(kv.x & 0xffff)); st[1] = st[1] * dec + bf2f((unsigned short)(kv.x >> 16));
            st[2] = st[2] * dec + bf2f((unsigned short)(kv.y & 0xffff)); st[3] = st[3] * dec + bf2f((unsigned short)(kv.y >> 16));
            st[4] = st[4] * dec + bf2f((unsigned short)(kv.z & 0xffff)); st[5] = st[5] * dec + bf2f((unsigned short)(kv.z >> 16));
            st[6] = st[6] * dec + bf2f((unsigned short)(kv.w & 0xffff)); st[7] = st[7] * dec + bf2f((unsigned short)(kv.w >> 16));
        }
    }
}
__device__ __forceinline__ void p_ret_out(const Args& a, Frame& F) {
    using namespace att;
    const bf16_t* RQ = (const bf16_t*)(a.ws + WS_RQ); const bf16_t* RK = (const bf16_t*)(a.ws + WS_RK); const bf16_t* RV = (const bf16_t*)(a.ws + WS_RV);
    const bf16_t* RZ = (const bf16_t*)(a.ws + WS_RZ); const bf16_t* KVT = (const bf16_t*)((const unsigned char*)a.out + DO_KVT); bf16_t* BO = (bf16_t*)(a.ws + WS_BO);
    const int tid = F.tid, lane = F.lane, wid = F.wave, r32 = lane & 31, hi = lane >> 5;
    const int pr = wid >> 1, qblk = wid & 1, lt = tid & 127;
    LAS unsigned char* Kl = F.lds + pr * 32768; LAS unsigned char* Vl = Kl + 16384;
    const int vb = (int)(uintptr_t)Vl + v_rd_base(lane);
    for (int it0 = F.vcu * 4; it0 < NB * 8 * 64; it0 += F.G * 4) {
        const int item = it0 + pr, bh = item >> 6, n = item & 63, h = bh & 7, b = bh >> 3;
        const float lg = ret_log2g(h);
        const size_t rowbase = ((size_t)bh * SEQ + (size_t)n * 64) * 128;
#pragma unroll
        for (int i = 0; i < 8; ++i) { const int c = lt + 128 * i, t = c >> 4, sc = (c & 15) * 8;
            *(LAS u32x4*)(Kl + KSWZ(t, sc * 2)) = *(const u32x4*)(RK + rowbase + (size_t)t * 128 + sc);
            *(LAS u32x4*)(Vl + v_st(t, sc)) = *(const u32x4*)(RV + rowbase + (size_t)t * 128 + sc); }
        bf16x8 qr[8];
#pragma unroll
        for (int d0 = 0; d0 < 8; ++d0) qr[d0] = *(const bf16x8*)(RQ + rowbase + (size_t)(32 * qblk + r32) * 128 + d0 * 16 + hi * 8);
        __syncthreads();
        f32x16 p0, p1;
        qkt(p0, p1, Kl, r32, hi, qr);
        const int iq = 32 * qblk + r32;
#pragma unroll
        for (int r = 0; r < 16; ++r) { const int j0 = crow(r, hi), j1 = j0 + 32;
            const int e0 = (iq > j0 ? iq - j0 : j0 - iq) - iq - 1, e1 = (iq > j1 ? iq - j1 : j1 - iq) - iq - 1;
            p0[r] *= exp2f((float)e0 * lg); p1[r] *= exp2f((float)e1 * lg); }
        bf16x8 pa0, pa1, pa2, pa3;
        pack_p(p0, p1, pa0, pa1, pa2, pa3);
        f32x16 o[4] = {};
        SBAR();
        pv_tile<0>(o, vb, pa0, pa1, pa2, pa3);
        const bf16_t* ST = KVT + (size_t)item * 16384;
#pragma unroll
        for (int d0 = 0; d0 < 4; ++d0)
#pragma unroll
            for (int kk = 0; kk < 8; ++kk) { const bf16x8 sf = *(const bf16x8*)(ST + (size_t)(32 * d0 + r32) * 128 + 16 * kk + 8 * hi);
                o[d0] = __builtin_amdgcn_mfma_f32_32x32x16_bf16(qr[kk], sf, o[d0], 0, 0, 0); }
        float gain[4];
#pragma unroll
        for (int d0 = 0; d0 < 4; ++d0) gain[d0] = a.gn_gain[h * 128 + 32 * d0 + r32];
#pragma unroll
        for (int r = 0; r < 16; ++r) { const int il = 32 * qblk + crow(r, hi); const float fs = exp2f((float)(il + 1) * lg);
            float y0 = o[0][r] * fs, y1 = o[1][r] * fs, y2 = o[2][r] * fs, y3 = o[3][r] * fs;
            float s1 = (y0 + y1) + (y2 + y3), s2 = (y0 * y0 + y1 * y1) + (y2 * y2 + y3 * y3);
#pragma unroll
            for (int k = 1; k < 32; k <<= 1) { s1 += __shfl_xor(s1, k); s2 += __shfl_xor(s2, k); }
            const float mu = s1 * (1.0f / 128.0f); const float var = fmaxf(s2 * (1.0f / 128.0f) - mu * mu, 0.f); const float rs = 1.0f / sqrtf(var + EPS);
            const size_t m = (size_t)b * SEQ + (size_t)n * 64 + il;
            const bf16_t* rz = RZ + m * 1024 + h * 128 + r32; bf16_t* bo = BO + m * 1024 + h * 128 + r32;
            const float v0 = (y0 - mu) * rs * gain[0] * bf2f(rz[0]), v1 = (y1 - mu) * rs * gain[1] * bf2f(rz[32]), v2 = (y2 - mu) * rs * gain[2] * bf2f(rz[64]), v3 = (y3 - mu) * rs * gain[3] * bf2f(rz[96]);
            const float n0 = __shfl_xor(v0, 1), n1 = __shfl_xor(v1, 1), n2 = __shfl_xor(v2, 1), n3 = __shfl_xor(v3, 1);
            if ((r32 & 1) == 0) { *(unsigned*)(bo) = cvt_pk_bf16(v0, n0); *(unsigned*)(bo + 32) = cvt_pk_bf16(v1, n1); *(unsigned*)(bo + 64) = cvt_pk_bf16(v2, n2); *(unsigned*)(bo + 96) = cvt_pk_bf16(v3, n3); }
        }
        __syncthreads();
    }
}

__device__ __forceinline__ void p_index(const Args& a, Frame& F) {
    using namespace att;
    const bf16_t* IQ = (const bf16_t*)((const unsigned char*)a.out + DO_IQ); const bf16_t* IK = (const bf16_t*)(a.ws + WS_IK); const float* IW = (const float*)(a.ws + WS_IW);
    unsigned* MASK = (unsigned*)(a.ws + WS_MASK);
    constexpr int NBIN = 1024, CAP = 256;
    const int tid = F.tid, lane = F.lane, wid = F.wave, r32 = lane & 31, hi = lane >> 5, pq = wid >> 1, e = wid & 1;
    LAS unsigned char* KS = F.lds;
    LAS unsigned* hist = (LAS unsigned*)(F.lds + 65536) + pq * 2 * NBIN;
    LAS float* part = (LAS float*)(F.lds + 98304) + pq * 8;
    LAS int* misc = (LAS int*)(F.lds + 98816) + pq * 16; LAS float* miscf = (LAS float*)(F.lds + 98816) + pq * 16;
    LAS float* cand = (LAS float*)(F.lds + 99072) + pq * 2 * CAP;
    const float NINF = -__builtin_inff(), PINF = __builtin_inff();
    int boff[4];
#pragma unroll
    for (int ks = 0; ks < 4; ++ks) boff[ks] = e * 4096 + r32 * 128 + (((2 * ks + hi) ^ (r32 & 7)) << 4);
    const unsigned sgo = (unsigned)((tid >> 3) * 64 + (((tid & 7) ^ ((tid >> 3) & 7)) * 8)) * 2u;
    for (int round = 0; round * F.G < 2048; ++round) {
        const int j = round * F.G + ((round & 1) ? F.G - 1 - F.vcu : F.vcu);
        if (j >= 2048) continue;
        const int c = 63 - (j >> 5), sub = j & 31, b = sub >> 3, pg = sub & 7;
        const int m0 = b * SEQ + 64 * c, ntile = 2 * (c + 1), ngrp = (ntile + 7) >> 3, ntzh = 4 * ((c >> 2) + 1);
        const bool need_sel = c >= 4;
        const int p = pg * 4 + pq;
        const int qrow = m0 + 2 * p + hi;
        bf16x8 af[4];
        { const int aq_ = (r32 >> 2) & 1, ah_ = (r32 & 3) + 4 * (r32 >> 3);
#pragma unroll
          for (int ks = 0; ks < 4; ++ks) af[ks] = *(const bf16x8*)(IQ + (size_t)(m0 + 2 * p + aq_) * 1024 + ah_ * 64 + 16 * ks + 8 * hi); }
        float wq[16];
#pragma unroll
        for (int q4 = 0; q4 < 4; ++q4) { const f32x4 w4 = *(const f32x4*)(IW + (size_t)qrow * 16 + 4 * q4); wq[4 * q4] = w4[0]; wq[4 * q4 + 1] = w4[1]; wq[4 * q4 + 2] = w4[2]; wq[4 * q4 + 3] = w4[3]; }
        const unsigned char* ikb = (const unsigned char*)(IK + (size_t)b * SEQ * 64);
#pragma unroll
        for (int i = 0; i < 4; ++i) __builtin_amdgcn_global_load_lds((const unsigned*)(ikb + sgo + i * 8192), (LAS unsigned*)(KS + wid * 1024 + i * 8192), 16, 0, 0);
        __syncthreads();
        float v[64];
        int lim_v = ntile - e; asm volatile("" : "+v"(lim_v));
#pragma unroll
        for (int g = 0; g < 16; ++g) {
            if (g < ngrp) {
                if (g + 1 < ngrp) { unsigned so_ = sgo; asm volatile("" : "+v"(so_));
                    const unsigned char* gb = ikb + (size_t)(g + 1) * 32768; LAS unsigned char* kn = KS + ((g + 1) & 1) * 32768 + wid * 1024;
#pragma unroll
                    for (int i = 0; i < 4; ++i) __builtin_amdgcn_global_load_lds((const unsigned*)(gb + so_ + i * 8192), (LAS unsigned*)(kn + i * 8192), 16, 0, 0); }
                const LAS unsigned char* kb = KS + (g & 1) * 32768;
#pragma unroll
                for (int i = 0; i < 4; ++i) {
                    f32x16 cc = {};
#pragma unroll
                    for (int ks = 0; ks < 4; ++ks) cc = __builtin_amdgcn_mfma_f32_32x32x16_bf16(af[ks], *(const LAS bf16x8*)(kb + i * 8192 + boff[ks]), cc, 0, 0, 0);
                    float idx = 0.f;
#pragma unroll
                    for (int r = 0; r < 16; ++r) idx += fmaxf(cc[r], 0.f) * wq[r];
                    v[g * 4 + i] = (g * 8 + 2 * i < lim_v) ? idx : NINF;
                    if (i & 1) __builtin_amdgcn_sched_barrier(0);
                }
                __syncthreads();
            } else {
#pragma unroll
                for (int i = 0; i < 4; ++i) v[g * 4 + i] = NINF;
            }
        }
        float T = NINF; int bstar = -1; bool ovf = false; float mn = 0.f, scale = 0.f;
        if (need_sel) {
            int lane_s = lane; asm volatile("" : "+v"(lane_s));
            const int r32s = lane_s & 31, his = lane_s >> 5;
            float lmn = PINF, lmx = NINF;
#pragma unroll
            for (int tt = 0; tt < 64; ++tt) if (tt <= c) { lmx = fmaxf(lmx, v[tt]); lmn = fminf(lmn, v[tt] == NINF ? PINF : v[tt]); }
#pragma unroll
            for (int k = 1; k < 32; k <<= 1) { const int pa = (lane_s ^ k) << 2; lmx = fmaxf(lmx, __builtin_bit_cast(float, __builtin_amdgcn_ds_bpermute(pa, __builtin_bit_cast(int, lmx)))); lmn = fminf(lmn, __builtin_bit_cast(float, __builtin_amdgcn_ds_bpermute(pa, __builtin_bit_cast(int, lmn)))); }
            if (r32s == 0) { part[(e * 2 + his) * 2] = lmn; part[(e * 2 + his) * 2 + 1] = lmx; }
#pragma unroll
            for (int k = 0; k < 4; ++k) *(LAS u32x4*)(F.lds + 65536 + (wid * 64 + lane_s + 512 * k) * 16) = (u32x4){0u, 0u, 0u, 0u};
            if (tid < 8) ((LAS int*)(F.lds + 98816))[(tid >> 1) * 16 + 4 + (tid & 1)] = 0;
            __syncthreads();
            mn = fminf(part[his * 2], part[(2 + his) * 2]); const float mx = fmaxf(part[his * 2 + 1], part[(2 + his) * 2 + 1]);
            scale = (mx > mn) ? (float)NBIN / (mx - mn) : 0.f;
#pragma unroll
            for (int tt = 0; tt < 64; ++tt) { if (tt <= c) if (v[tt] != NINF) { int bin = (int)((v[tt] - mn) * scale); bin = bin > NBIN - 1 ? NBIN - 1 : (bin < 0 ? 0 : bin);
                __hip_atomic_fetch_add(hist + his * NBIN + bin, 1u, __ATOMIC_RELAXED, __HIP_MEMORY_SCOPE_WORKGROUP); }
                if ((tt & 7) == 7) __builtin_amdgcn_sched_barrier(0); }
            __syncthreads();
            { unsigned cnt[16]; unsigned sum = 0;
#pragma unroll
              for (int k = 0; k < 4; ++k) { const u32x4 w = *(const LAS u32x4*)(hist + e * NBIN + 16 * lane_s + 4 * k); cnt[4 * k] = w.x; cnt[4 * k + 1] = w.y; cnt[4 * k + 2] = w.z; cnt[4 * k + 3] = w.w; }
#pragma unroll
              for (int k = 0; k < 16; ++k) sum += cnt[k];
              unsigned suf = sum;
#pragma unroll
              for (int k = 1; k < 64; k <<= 1) { const unsigned o = (unsigned)__builtin_amdgcn_ds_bpermute(((lane_s + k) & 63) << 2, (int)suf); if (lane_s + k < 64) suf += o; }
              const unsigned above = suf - sum;
              if (above < 256u && suf >= 256u) { unsigned run = above; int bs = 16 * lane_s; unsigned ca = above; bool found = false;
#pragma unroll
                  for (int k = 15; k >= 0; --k) { if (!found) { if (run + cnt[k] >= 256u) { bs = 16 * lane_s + k; ca = run; found = true; } else run += cnt[k]; } }
                  misc[e] = bs; misc[2 + e] = (int)ca; }
            }
            __syncthreads();
            bstar = misc[his];
            asm volatile("" : "+v"(mn), "+v"(scale));
#pragma unroll
            for (int tt = 0; tt < 64; ++tt) { if (tt <= c) if (v[tt] != NINF) { int bin = (int)((v[tt] - mn) * scale); bin = bin > NBIN - 1 ? NBIN - 1 : (bin < 0 ? 0 : bin);
                if (bin == bstar) { const int pos = __hip_atomic_fetch_add(misc + 4 + his, 1, __ATOMIC_RELAXED, __HIP_MEMORY_SCOPE_WORKGROUP); if (pos < CAP) cand[his * CAP + pos] = v[tt]; } }
                if ((tt & 7) == 7) __builtin_amdgcn_sched_barrier(0); }
            __syncthreads();
            { const int n = misc[4 + e], kk = 256 - misc[2 + e];
              if (n <= CAP) {
                  float ci[4]; int rk[4];
#pragma unroll
                  for (int k = 0; k < 4; ++k) { const int i = lane_s + 64 * k; ci[k] = i < n ? cand[e * CAP + i] : NINF; rk[k] = 0; }
                  for (int jj = 0; jj < n; ++jj) { const float cj = cand[e * CAP + jj];
#pragma unroll
                      for (int k = 0; k < 4; ++k) rk[k] += (cj > ci[k] || (cj == ci[k] && jj < lane_s + 64 * k)) ? 1 : 0; }
#pragma unroll
                  for (int k = 0; k < 4; ++k) if (lane_s + 64 * k < n && rk[k] == kk - 1) miscf[6 + e] = ci[k];
              } else if (lane_s == 0) miscf[6 + e] = NINF;
              if (lane_s == 0) misc[8 + e] = n > CAP ? 1 : 0; }
            __syncthreads();
            T = miscf[6 + his]; ovf = misc[8 + his] != 0;
            asm volatile("" : "+v"(mn), "+v"(scale));
        }
#pragma unroll
        for (int tt = 0; tt < 64; ++tt) if (tt < ntzh) { const int t = e + 2 * tt;
            bool sel = v[tt] != NINF;
            if (need_sel && sel) { if (ovf) { int bin = (int)((v[tt] - mn) * scale); bin = bin > NBIN - 1 ? NBIN - 1 : (bin < 0 ? 0 : bin); sel = bin >= bstar; } else sel = v[tt] >= T; }
            const unsigned long long bal = __ballot(sel);
            if (r32 == 0) MASK[(size_t)qrow * 128 + t] = hi ? (unsigned)(bal >> 32) : (unsigned)bal;
            if ((tt & 7) == 7) __builtin_amdgcn_sched_barrier(0); }
    }
}

__device__ __forceinline__ int t5_bucket(int rel) {
    const int n = rel < 0 ? -rel : rel; int bkt;
    if (n < 8) bkt = n; else { int k = (31 - __builtin_clz((unsigned)(n * n))) - 6; bkt = 8 + k; if (bkt > 15) bkt = 15; }
    return bkt + (rel > 0 ? 16 : 0);
}
__device__ __forceinline__ void attn_partialSM(att::f32x16& p0, att::f32x16& p1, float& m_reg, float& mn, float& alpha) {
    constexpr float SCALE = 0.08838834764831845f, THR = 8.f, C2 = 1.4426950408889634f * SCALE;
    float pmax = p0[0];
#pragma unroll
    for (int r = 1; r < 16; ++r) pmax = fmaxf(pmax, p0[r]);
#pragma unroll
    for (int r = 0; r < 16; ++r) pmax = fmaxf(pmax, p1[r]);
    { auto rr = __builtin_amdgcn_permlane32_swap(__float_as_uint(pmax), __float_as_uint(pmax), false, false); pmax = fmaxf(__uint_as_float(rr[0]), __uint_as_float(rr[1])); }
    if (__builtin_expect(__all((pmax - m_reg) * SCALE <= THR), 1)) { mn = m_reg; alpha = 1.f; }
    else { mn = fmaxf(m_reg, pmax); alpha = __builtin_amdgcn_exp2f((m_reg - mn) * C2); m_reg = mn; }
    const float mnL = -mn * C2;
#pragma unroll
    for (int r = 0; r < 16; ++r) p0[r] = fmaf(p0[r], C2, mnL);
#pragma unroll
    for (int r = 0; r < 16; ++r) p1[r] = fmaf(p1[r], C2, mnL);
#pragma unroll
    for (int r = 0; r < 16; ++r) p0[r] = __builtin_amdgcn_exp2f(p0[r]);
}
__device__ __forceinline__ void attn_finishSM(att::f32x16& p0, att::f32x16& p1, float alpha, float& l_reg, bf16x8& pa0, bf16x8& pa1, bf16x8& pa2, bf16x8& pa3) {
#pragma unroll
    for (int r = 0; r < 16; ++r) p1[r] = __builtin_amdgcn_exp2f(p1[r]);
    float ps = 0;
#pragma unroll
    for (int r = 0; r < 16; ++r) ps += p0[r];
#pragma unroll
    for (int r = 0; r < 16; ++r) ps += p1[r];
    { auto rr = __builtin_amdgcn_permlane32_swap(__float_as_uint(ps), __float_as_uint(ps), false, false); ps = __uint_as_float(rr[0]) + __uint_as_float(rr[1]); }
    l_reg = l_reg * alpha + ps;
    att::pack_p(p0, p1, pa0, pa1, pa2, pa3);
}
__device__ __forceinline__ void attn_unit(const Args& a, Frame& F, int b, int h, int qb) {
    using namespace att;
    LAS unsigned char* V_lds = F.lds; LAS unsigned char* K_lds = F.lds + 32768;
    int tid = threadIdx.x; asm volatile("" : "+v"(tid));
    const int lane = tid & 63, wid = __builtin_amdgcn_readfirstlane(tid >> 6), r32 = lane & 31, hi = lane >> 5;
    LAS float* wsf = (LAS float*)(F.lds + 65536) + wid * 64; LAS float* BT = (LAS float*)(F.lds + 65536 + 2048);
    LAS float* li_l = wsf; LAS float* al_l = wsf + 32;
    constexpr float SQD = 11.313708498984761f;
    const float NINF = -__builtin_inff();
    if (tid < 256) { const int rel = tid - 192; BT[tid] = (a.rel_bias[t5_bucket(rel) * 8 + h] - a.rel_bias[15 * 8 + h]) * SQD; }
    const size_t hb = ((size_t)(b * 8 + h) * SEQ) * 128;
    const bf16_t* AQh = (const bf16_t*)((const unsigned char*)a.out + DO_AQ) + hb; const bf16_t* AKh = (const bf16_t*)(a.ws + WS_AK) + hb; const bf16_t* AVh = (const bf16_t*)(a.ws + WS_AV) + hb;
    const int qpos = 256 * qb + 32 * wid + r32, cw = 4 * qb + (wid >> 1);
    const unsigned* MKb = (const unsigned*)(a.ws + WS_MASK) + (size_t)(b * SEQ + 256 * qb) * 128;
    const unsigned mko = (unsigned)(32 * wid + r32) * 128u;
    bf16x8 qr[8];
    { const unsigned qo = (unsigned)qpos * 128u + hi * 8u;
#pragma unroll
      for (int d0 = 0; d0 < 8; ++d0) qr[d0] = *(const bf16x8*)(AQh + qo + d0 * 16); }
    const int sr = tid >> 4, sc = (tid & 15) * 8, kws = KSWZ(sr, sc * 2), vst0 = v_st(sr, sc), vst1 = v_st(32 + sr, sc);
    const unsigned so = (unsigned)sr * 128u + sc;
    const int vb0 = (int)(uintptr_t)V_lds + v_rd_base(lane);
    const int NT = 4 * (qb + 1);
    u32x4 st_k0, st_k1, st_v0, st_v1; u32x2 mwA, mwB;
#define SLOAD(t_) do { const bf16_t* kp_ = AKh + (size_t)(t_) * 8192; const bf16_t* vp_ = AVh + (size_t)(t_) * 8192; \
        st_v0 = *(const u32x4*)(vp_ + so); st_v1 = *(const u32x4*)(vp_ + so + 32 * 128); st_k0 = *(const u32x4*)(kp_ + so); st_k1 = *(const u32x4*)(kp_ + so + 32 * 128); } while (0)
#define SWRITE(bf) do { *(LAS u32x4*)(V_lds + (bf) * 16384 + vst0) = st_v0; *(LAS u32x4*)(V_lds + (bf) * 16384 + vst1) = st_v1; \
        *(LAS u32x4*)(K_lds + (bf) * 16384 + kws) = st_k0; *(LAS u32x4*)(K_lds + (bf) * 16384 + kws + 32 * 256) = st_k1; } while (0)
#define MLOAD(t_) (*(const u32x2*)(MKb + 2 * (t_) + mko))
#define VMW() asm volatile("s_waitcnt vmcnt(0)" ::: "memory")
#define MASKB(P0_, P1_, MW_, t_) do { const unsigned w0s_ = (MW_).x >> (4 * hi), w1s_ = (MW_).y >> (4 * hi); \
        if ((t_) >= cw - 2) { const int relb_ = 64 * (t_) + 4 * hi - qpos + 192; \
            _Pragma("unroll") for (int r = 0; r < 16; ++r) { const int bp_ = (r & 3) + 8 * (r >> 2); int i0_ = relb_ + bp_, i1_ = i0_ + 32; \
                i0_ = i0_ < 0 ? 0 : (i0_ > 255 ? 255 : i0_); i1_ = i1_ < 0 ? 0 : (i1_ > 255 ? 255 : i1_); P0_[r] += BT[i0_]; P1_[r] += BT[i1_]; } } \
        _Pragma("unroll") for (int r = 0; r < 16; ++r) { const int bp_ = (r & 3) + 8 * (r >> 2); \
            P0_[r] = ((w0s_ >> bp_) & 1u) ? P0_[r] : NINF; P1_[r] = ((w1s_ >> bp_) & 1u) ? P1_[r] : NINF; } } while (0)
#define RESC(al_) do { if (__any((al_) < 1.f)) { if (hi == 0) al_l[r32] = (al_); asm volatile("s_waitcnt lgkmcnt(0)" ::: "memory"); \
        _Pragma("unroll") for (int d_ = 0; d_ < 4; ++d_) _Pragma("unroll") for (int r = 0; r < 16; ++r) o[d_][r] *= al_l[crow(r, hi)]; } } while (0)
    float m_reg = -1e30f, l_reg = 0; f32x16 o[4] = {};
    f32x16 pA0, pA1, pB0, pB1; float mnA, mnB, alA, alB; bf16x8 pa0, pa1, pa2, pa3;
    SLOAD(0); mwA = MLOAD(0); VMW(); SWRITE(0);
    __syncthreads();
    SLOAD(1); mwB = MLOAD(1);
    SBAR(); qkt(pA0, pA1, K_lds, r32, hi, qr);
    MASKB(pA0, pA1, mwA, 0); attn_partialSM(pA0, pA1, m_reg, mnA, alA);
    VMW(); SWRITE(1);
    __syncthreads();
#define HALF_STEP(PX0, PX1, mnX, alX, MWX, PY0, PY1, alY, MWY, t, KB, VB, SB) do { \
        SBAR(); qkt(PX0, PX1, K_lds + (KB) * 16384, r32, hi, qr); \
        attn_finishSM(PY0, PY1, alY, l_reg, pa0, pa1, pa2, pa3); SBAR(); \
        if ((t) + 1 < NT) { SLOAD((t) + 1); MWY = MLOAD((t) + 1); SBAR(); } \
        pv_tile<(VB) * 16384>(o, vb0, pa0, pa1, pa2, pa3); MASKB(PX0, PX1, MWX, (t)); attn_partialSM(PX0, PX1, m_reg, mnX, alX); \
        __syncthreads(); \
        if ((t) + 1 < NT) { VMW(); SWRITE(SB); } \
        RESC(alX); __syncthreads(); } while (0)
#pragma unroll 1
    for (int t = 1; t + 1 < NT; t += 2) {
        HALF_STEP(pB0, pB1, mnB, alB, mwB, pA0, pA1, alA, mwA, t, 1, 0, 0);
        HALF_STEP(pA0, pA1, mnA, alA, mwA, pB0, pB1, alB, mwB, t + 1, 0, 1, 1);
    }
    SBAR(); qkt(pB0, pB1, K_lds + 16384, r32, hi, qr); SBAR();
    attn_finishSM(pA0, pA1, alA, l_reg, pa0, pa1, pa2, pa3); SBAR();
    pv_tile<0>(o, vb0, pa0, pa1, pa2, pa3);
    MASKB(pB0, pB1, mwB, NT - 1); attn_partialSM(pB0, pB1, m_reg, mnB, alB); RESC(alB);
    attn_finishSM(pB0, pB1, alB, l_reg, pa0, pa1, pa2, pa3); SBAR(); pv_tile<16384>(o, vb0, pa0, pa1, pa2, pa3);
    if (hi == 0) li_l[r32] = l_reg; asm volatile("s_waitcnt lgkmcnt(0)" ::: "memory");
    { int r32e = r32, hie = hi; asm volatile("" : "+v"(r32e), "+v"(hie));
      const size_t ub = ((size_t)b * SEQ + 256 * qb + 32 * wid) * 1024 + h * 128;
      const bf16_t* AZu = (const bf16_t*)(a.ws + WS_AZ) + ub; bf16_t* AOu = (bf16_t*)((unsigned char*)a.out + DO_AO) + ub;
#pragma unroll
      for (int r = 0; r < 16; ++r) { const float rl = __builtin_amdgcn_rcpf(li_l[crow(r, hie)]);
        const unsigned eo = (unsigned)crow(r, hie) * 1024u + r32e;
        const float x0 = o[0][r] * rl * bf2f(AZu[eo]), x1 = o[1][r] * rl * bf2f(AZu[eo + 32]), x2 = o[2][r] * rl * bf2f(AZu[eo + 64]), x3 = o[3][r] * rl * bf2f(AZu[eo + 96]);
        const float n0 = __shfl_xor(x0, 1), n1 = __shfl_xor(x1, 1), n2 = __shfl_xor(x2, 1), n3 = __shfl_xor(x3, 1);
        if ((r32e & 1) == 0) { *(unsigned*)(AOu + eo) = cvt_pk_bf16(x0, n0); *(unsigned*)(AOu + eo + 32) = cvt_pk_bf16(x1, n1); *(unsigned*)(AOu + eo + 64) = cvt_pk_bf16(x2, n2); *(unsigned*)(AOu + eo + 96) = cvt_pk_bf16(x3, n3); } } }
    __syncthreads();
#undef SLOAD
#undef SWRITE
#undef MLOAD
#undef VMW
#undef MASKB
#undef RESC
#undef HALF_STEP
}
__device__ __forceinline__ void p_attn(const Args& a, Frame& F) {
    for (int u2 = F.vcu; u2 < 256; u2 += F.G) { const int bh = u2 >> 3, s = u2 & 7;
        for (int pass = 0; pass < 2; ++pass) attn_unit(a, F, bh >> 3, bh & 7, pass ? 15 - s : s); }
}

typedef __attribute__((address_space(1))) unsigned gu32;
#define XB_TMO      128
#define XB_XCNT(j)  (256  + 64 * (j))
#define XB_XSUB(j)  (1280 + 64 * (j))
#define XB_XGEN(j)  (2304 + 64 * (j))
#define XB_TOP      3328
#define XB_TOPGEN   3392
#define XCD_BAR_WORDS 3456
#define XB_SPIN_CAP (1u << 20)
__device__ __forceinline__ unsigned xb_ld(unsigned* p)              { return __hip_atomic_load(p, __ATOMIC_RELAXED, __HIP_MEMORY_SCOPE_AGENT); }
__device__ __forceinline__ unsigned xb_add(unsigned* p, unsigned v) { return __hip_atomic_fetch_add(p, v, __ATOMIC_RELAXED, __HIP_MEMORY_SCOPE_AGENT); }
__device__ __forceinline__ unsigned xb_xcc_id() { return (unsigned)__builtin_amdgcn_s_getreg((3 << 11) | 20) & 0xFu; }
#define XB_SPIN(cond, bar) do { unsigned _sp = 0; while (cond) { __builtin_amdgcn_s_sleep(1); \
    if ((++_sp & 255u) == 0u) { if (xb_ld(&(bar)[XB_TMO])) break; if (_sp > XB_SPIN_CAP) { atomicAdd(&(bar)[XB_TMO], 1u); break; } } } } while (0)
struct XcdBarrier { unsigned* bar; unsigned x; volatile LAS unsigned* st; };
__device__ __forceinline__ XcdBarrier xcd_barrier_post(unsigned* bar, volatile LAS unsigned* st) {
    XcdBarrier b; b.bar = bar; b.x = xb_xcc_id(); b.st = st;
    if (threadIdx.x == 0) (void)xb_add(&bar[XB_XCNT(b.x)], 1u);
    return b;
}
__device__ __forceinline__ void xcd_barrier_complete(unsigned* bar, unsigned x, unsigned& nloc, unsigned& nx) {
    const unsigned G = gridDim.x * gridDim.y * gridDim.z;
    unsigned sum, cnt, mine, sp = 0u;
    for (;;) {
        sum = 0u; cnt = 0u; mine = 0u;
#pragma unroll
        for (unsigned j = 0; j < 16; ++j) { const unsigned c = xb_ld(&bar[XB_XCNT(j)]); sum += c; cnt += (c > 0u) ? 1u : 0u; mine = (j == x) ? c : mine; }
        if (sum == G) break;
        __builtin_amdgcn_s_sleep(1);
        if ((++sp & 255u) == 0u) { if (xb_ld(&bar[XB_TMO])) break; if (sp > XB_SPIN_CAP) { atomicAdd(&bar[XB_TMO], 1u); break; } }
    }
    nloc = mine > 0u ? mine : 1u; nx = cnt > 0u ? cnt : 1u;
}
__device__ __forceinline__ void xcd_barrier(const XcdBarrier& b) {
    asm volatile("s_waitcnt vmcnt(0)" ::: "memory");
    __syncthreads();
    if (threadIdx.x == 0) {
        unsigned* bar = b.bar;
        __builtin_amdgcn_s_waitcnt(0);
        unsigned nloc = b.st[0], nx = b.st[1];
        if (nloc == 0u) { xcd_barrier_complete(bar, b.x, nloc, nx); b.st[0] = nloc; b.st[1] = nx; }
        const unsigned old = xb_add(&bar[XB_XSUB(b.x)], 1u);
        const unsigned gen = old / nloc;
        if (old + 1u == (gen + 1u) * nloc) {
            __builtin_amdgcn_fence(__ATOMIC_RELEASE, "agent");
            asm volatile("s_waitcnt vmcnt(0)" ::: "memory");
            const unsigned og = xb_add(&bar[XB_TOP], 1u);
            const unsigned tg = og / nx;
            if (og + 1u == (tg + 1u) * nx) xb_add(&bar[XB_TOPGEN], 1u);
            else XB_SPIN(xb_ld(&bar[XB_TOPGEN]) == tg, bar);
            __builtin_amdgcn_fence(__ATOMIC_ACQUIRE, "agent");
            xb_add(&bar[XB_XGEN(b.x)], 1u);
            asm volatile("s_waitcnt vmcnt(0)" ::: "memory");
        } else {
            XB_SPIN(xb_ld(&bar[XB_XGEN(b.x)]) == gen, bar);
            __builtin_amdgcn_fence(__ATOMIC_ACQUIRE, "agent");
            asm volatile("s_waitcnt vmcnt(0)" ::: "memory");
        }
    }
    __syncthreads();
}

constexpr int NPHASES = 9;
constexpr int LDS_MISC = 139264;
constexpr size_t CTL_ZERO_BYTES = 65536;
__global__ void __launch_bounds__(NTHREADS, 2) fwd_kernel(Args args) {
    extern __shared__ __attribute__((aligned(16))) unsigned char lds_raw[];
    cg::grid_group grid = cg::this_grid();
    Frame F;
    F.lds = (LAS unsigned char*)lds_raw;
    frame_ids(F);
    F.G = gridDim.x; { const int bx = blockIdx.x; F.vcu = (F.G % 8 == 0) ? (bx % 8) * (F.G / 8) + bx / 8 : bx; }
    const int lo = args.ph_lo, hi = args.ph_hi;
    unsigned char* ws = args.ws;
    volatile LAS unsigned* MISC = (volatile LAS unsigned*)(F.lds + LDS_MISC);
    if (threadIdx.x < 16) MISC[threadIdx.x] = 0u;
    __syncthreads();
    XcdBarrier bar = xcd_barrier_post((unsigned*)(ws + WS_CTL) + 1024, MISC + 8);
#define IN(k) (lo <= (k) && (k) < hi)
#define SEAM_CG(k) do { if (IN(k) && IN((k) + 1)) { __threadfence(); grid.sync(); } } while (0)
#define SEAM(k) do { if (IN(k) && IN((k) + 1)) { xcd_barrier(bar); } } while (0)
    if (IN(0)) { frame_ids(F); p0_prologue(args, F); }
    SEAM_CG(0);
    if (IN(1)) {
        pg8::Gemm g{(const bf16_t*)((unsigned char*)args.out + DO_H), (const bf16_t*)(ws + WS_WIN), MTOK, NWIN_PAD, DM}; pg8::StaticOrder S; S.init(MTOK, NWIN_PAD, F.G, (int)blockIdx.x);
        EpiProj E{ws, (unsigned char*)args.out};
        pg8::gemm_phase<EpiProj, pg8::StaticOrder, true>(F.lds, g, S, E);
    }
    SEAM(1);
    if (IN(2)) { frame_ids(F); p_ret_kv(args, F); __syncthreads(); frame_ids(F); p_index(args, F); }
    SEAM(2);
    if (IN(3)) { frame_ids(F); p_ret_scan(args, F); __syncthreads(); frame_ids(F); p_attn(args, F); }
    SEAM(3);
    if (IN(4)) {
        frame_ids(F); p_ret_out(args, F); __syncthreads();
        pg8::Gemm g{(const bf16_t*)((unsigned char*)args.out + DO_AO), (const bf16_t*)(ws + WS_WA), MTOK, DM, 1024}; pg8::StaticOrder S; S.init(MTOK, DM, F.G, (int)blockIdx.x);
        EpiMerge<false> E{nullptr, (const bf16_t*)(ws + WS_GA), (bf16_t*)(ws + WS_T)};
        pg8::gemm_phase<EpiMerge<false>, pg8::StaticOrder, true>(F.lds, g, S, E);
    }
    SEAM(4);
    if (IN(5)) {
        pg8::Gemm g{(const bf16_t*)(ws + WS_BO), (const bf16_t*)(ws + WS_WB), MTOK, DM, 1024}; pg8::StaticOrder S; S.init(MTOK, DM, F.G, (int)blockIdx.x);
        EpiMerge<true> E{(const bf16_t*)(ws + WS_T), (const bf16_t*)(ws + WS_GB), (bf16_t*)(ws + WS_MG)};
        pg8::gemm_phase<EpiMerge<true>, pg8::StaticOrder, true>(F.lds, g, S, E);
    }
    SEAM(5);
    if (IN(6)) {
        { pg8::Gemm g{(const bf16_t*)(ws + WS_MG), (const bf16_t*)(ws + WS_WO), MTOK, DM, DM}; pg8::StaticOrder S; S.init(MTOK, DM, F.G, (int)blockIdx.x);
          EpiResid E{args.x, args.out, (bf16_t*)(ws + WS_RB)};
          pg8::gemm_phase<EpiResid, pg8::StaticOrder, true>(F.lds, g, S, E); }
        { pg8::Gemm g{(const bf16_t*)(ws + WS_PB), (const bf16_t*)(ws + WS_WPLE), MTOK, DM, PLE}; pg8::StaticOrder S; S.init(MTOK, DM, F.G, (int)blockIdx.x);
          EpiPlainBf16<DM> E{(bf16_t*)(ws + WS_U)};
          pg8::gemm_phase<EpiPlainBf16<DM>, pg8::StaticOrder, true>(F.lds, g, S, E); }
    }
    SEAM(6);
    if (IN(7)) {
        pg8::Gemm g{(const bf16_t*)(ws + WS_RB), (const bf16_t*)(ws + WS_WPG), MTOK, DM, DM}; pg8::StaticOrder S; S.init(MTOK, DM, F.G, (int)blockIdx.x);
        EpiGate E{args.out, (const bf16_t*)(ws + WS_U), args.out};
        pg8::gemm_phase<EpiGate, pg8::StaticOrder, true>(F.lds, g, S, E);
    }
    SEAM(7);
    if (IN(8)) { frame_ids(F); p_final_norm(args, F); }
#undef IN
#undef SEAM
#undef SEAM_CG
}

#ifndef ONE_LAUNCH
#define ONE_LAUNCH 1
#endif
extern "C" void kernel_launch(void* const* d_in, const int* in_sizes, int n_in, void* d_out, int out_size, void* d_ws, size_t ws_size, hipStream_t stream) {
    static int grid = 0;
    if (grid == 0) {
        int dev = 0, cus = 0, per_cu = 0;
        (void)hipGetDevice(&dev);
        if (hipDeviceGetAttribute(&cus, hipDeviceAttributeMultiprocessorCount, dev) != hipSuccess || cus <= 0) cus = 256;
        (void)hipFuncSetAttribute((const void*)fwd_kernel, hipFuncAttributeMaxDynamicSharedMemorySize, LDS_BYTES);
        if (hipOccupancyMaxActiveBlocksPerMultiprocessor(&per_cu, (const void*)fwd_kernel, NTHREADS, LDS_BYTES) != hipSuccess || per_cu < 1) per_cu = 1;
        (void)hipGetLastError();
        grid = cus * 1;
        if (ws_size < WS_END) fprintf(stderr, "kernel_launch: workspace too small (%zu < %zu)\n", ws_size, (size_t)WS_END);
    }
    (void)hipMemsetAsync((char*)d_ws + WS_CTL, 0, CTL_ZERO_BYTES, stream);
    Args a{};
    a.x = (const float*)d_in[0]; a.p = (const float*)d_in[1]; a.pos = (const int*)d_in[2]; a.w_in = (const float*)d_in[3]; a.norm_gain = (const float*)d_in[4];
    a.w_a = (const float*)d_in[5]; a.w_b = (const float*)d_in[6]; a.w_o = (const float*)d_in[7]; a.gn_gain = (const float*)d_in[8]; a.w_ple = (const float*)d_in[9];
    a.w_pg = (const float*)d_in[10]; a.rel_bias = (const float*)d_in[11]; a.final_gain = (const float*)d_in[12];
    a.out = (float*)d_out; a.ws = (unsigned char*)d_ws; a.coop = 1; a.pad = 0;
#ifdef PROBE_SPLIT
    for (int li = 0; li < 2; ++li) { a.ph_lo = li ? PROBE_SPLIT : 0; a.ph_hi = li ? NPHASES : PROBE_SPLIT + 1;
      void* kargs[] = {&a}; hipError_t e = hipLaunchCooperativeKernel((const void*)fwd_kernel, dim3(grid), dim3(NTHREADS), kargs, LDS_BYTES, stream);
      if (e != hipSuccess) fprintf(stderr, "cooperative launch failed: %s (grid %d)\n", hipGetErrorString(e), grid);
      if (li == 0) (void)hipMemsetAsync((char*)d_ws + WS_CTL, 0, CTL_ZERO_BYTES, stream); }
#elif ONE_LAUNCH
    a.ph_lo = 0; a.ph_hi = NPHASES;
    { void* kargs[] = {&a}; hipError_t e = hipLaunchCooperativeKernel((const void*)fwd_kernel, dim3(grid), dim3(NTHREADS), kargs, LDS_BYTES, stream);
      if (e != hipSuccess) fprintf(stderr, "cooperative launch failed: %s (grid %d)\n", hipGetErrorString(e), grid); }
#else
    for (int ph = 0; ph < NPHASES; ++ph) {
        a.ph_lo = ph; a.ph_hi = ph + 1;
        void* kargs[] = {&a}; hipError_t e = hipLaunchCooperativeKernel((const void*)fwd_kernel, dim3(grid), dim3(NTHREADS), kargs, LDS_BYTES, stream);
        if (e != hipSuccess) fprintf(stderr, "cooperative launch %d failed: %s (grid %d)\n", ph, hipGetErrorString(e), grid);
    }
#endif
}
```
